# Optimizing an MI355X kernel written in HIP

```python
import jax, jax.numpy as jnp
from jax import lax
import numpy as np

D_MODEL = 1024
BATCH = 2
SEQ = 8192
DEPTH = 2

PLE_DIM = 256
D_CONF = D_MODEL // 2
D_SC = D_MODEL // 2
N_GROUPS_CONF = 8
N_GROUPS_SC = 8
CONF_KERNEL = 31
SC_KERNEL = 3
FFN_KERNEL = 3
D_FF = 2816
EPS = 1e-6

W_IN_COLS = 2 * D_CONF + 3 * D_SC + 2 * D_MODEL

kernel_name = "hybrid_conformer_shortconv_gated_merge"


def rmsnorm(x, g):
    xf = x.astype(jnp.float32)
    y = xf * lax.rsqrt(jnp.mean(xf * xf, axis=-1, keepdims=True) + EPS)
    return (y * g.astype(jnp.float32)).astype(x.dtype)


def layernorm(x, g, b):
    xf = x.astype(jnp.float32)
    mu = jnp.mean(xf, axis=-1, keepdims=True)
    var = jnp.mean(jnp.square(xf - mu), axis=-1, keepdims=True)
    y = (xf - mu) * lax.rsqrt(var + EPS)
    return (y * g.astype(jnp.float32) + b.astype(jnp.float32)).astype(x.dtype)


def causal_dwconv(u, w):
    k, c = w.shape
    return lax.conv_general_dilated(
        u, w[:, None, :].astype(u.dtype),
        window_strides=(1,), padding=[(k - 1, 0)],
        dimension_numbers=("NWC", "WIO", "NWC"),
        feature_group_count=c)


def setup_inputs(seed: int = 0) -> dict:
    key = jax.random.key(seed)
    ks = jax.random.split(key, 24)
    f32 = jnp.float32

    def dense(k, shape, fan_in):
        return jax.random.normal(k, shape, f32) * (fan_in ** -0.5)

    def gain(k, shape):
        return 1.0 + 0.05 * jax.random.normal(k, shape, f32)

    def small(k, shape):
        return 0.02 * jax.random.normal(k, shape, f32)

    L = DEPTH
    return {
        "x": jax.random.normal(ks[0], (BATCH, SEQ, D_MODEL), f32),
        "p": jax.random.normal(ks[1], (DEPTH, BATCH, SEQ, PLE_DIM), f32),
        "g_mix": gain(ks[2], (L, D_MODEL)),
        "w_in": dense(ks[3], (L, D_MODEL, W_IN_COLS), D_MODEL),
        "b_gate": small(ks[4], (L, 2 * D_MODEL)),
        "conv_a_w": dense(ks[5], (L, CONF_KERNEL, D_CONF), CONF_KERNEL),
        "conv_a_b": small(ks[6], (L, D_CONF)),
        "ln_a_g": gain(ks[7], (L, D_CONF)),
        "ln_a_b": small(ks[8], (L, D_CONF)),
        "w_a_out": dense(ks[9], (L, D_CONF, D_MODEL), D_CONF),
        "conv_b_w": dense(ks[10], (L, SC_KERNEL, D_SC), SC_KERNEL),
        "w_b_out": dense(ks[11], (L, D_SC, D_MODEL), D_SC),
        "w_o": dense(ks[12], (L, D_MODEL, D_MODEL), D_MODEL),
        "g_ffn": gain(ks[13], (L, D_MODEL)),
        "w_up": dense(ks[14], (L, D_MODEL, 2 * D_FF), D_MODEL),
        "conv_f_w": dense(ks[15], (L, FFN_KERNEL, D_FF), FFN_KERNEL),
        "conv_f_b": small(ks[16], (L, D_FF)),
        "w_down": dense(ks[17], (L, D_FF, D_MODEL), D_FF),
        "g_ple": gain(ks[18], (L, D_MODEL)),
        "w_ple": dense(ks[19], (L, PLE_DIM, D_MODEL), PLE_DIM),
        "w_ple_gate": dense(ks[20], (L, D_MODEL, D_MODEL), D_MODEL),
        "g_final": gain(ks[21], (D_MODEL,)),
    }


def reference(x, p, g_mix, w_in, b_gate, conv_a_w, conv_a_b, ln_a_g, ln_a_b, w_a_out,
              conv_b_w, w_b_out, w_o, g_ffn, w_up, conv_f_w, conv_f_b, w_down,
              g_ple, w_ple, w_ple_gate, g_final):
    o1 = D_CONF
    o2 = o1 + D_CONF
    o3 = o2 + D_SC
    o4 = o3 + D_SC
    o5 = o4 + D_SC
    o6 = o5 + D_MODEL
    for i in range(DEPTH):
        h = rmsnorm(x, g_mix[i])
        z = jnp.einsum("bsd,dn->bsn", h, w_in[i])
        a_val, a_gt = z[..., :o1], z[..., o1:o2]
        sc_b, sc_c, sc_v = z[..., o2:o3], z[..., o3:o4], z[..., o4:o5]
        gate_logits = z[..., o5:] + b_gate[i]
        g_a = jax.nn.sigmoid(gate_logits[..., :D_MODEL])
        g_b = jax.nn.sigmoid(gate_logits[..., D_MODEL:])

        a = a_val * jax.nn.sigmoid(a_gt)
        a = causal_dwconv(a, conv_a_w[i]) + conv_a_b[i]
        a = jax.nn.silu(layernorm(a, ln_a_g[i], ln_a_b[i]))
        y_a = jnp.einsum("bsc,cd->bsd", a, w_a_out[i])

        s = sc_b * causal_dwconv(sc_c * sc_v, conv_b_w[i])
        y_b = jnp.einsum("bsc,cd->bsd", s, w_b_out[i])

        x = x + jnp.einsum("bsd,de->bse", g_a * y_a + g_b * y_b, w_o[i])

        h = rmsnorm(x, g_ffn[i])
        u = jnp.einsum("bsd,df->bsf", h, w_up[i])
        f_gate = causal_dwconv(u[..., :D_FF], conv_f_w[i]) + conv_f_b[i]
        f = jax.nn.gelu(f_gate, approximate=True) * u[..., D_FF:]
        x = x + jnp.einsum("bsf,fd->bsd", f, w_down[i])

        pg = jax.nn.sigmoid(jnp.einsum("bsd,de->bse", rmsnorm(x, g_ple[i]), w_ple_gate[i]))
        x = x + pg * jnp.einsum("bsk,kd->bsd", p[i], w_ple[i])

    return rmsnorm(x, g_final)
```

```cpp
#ifndef EMU
#include <hip/hip_runtime.h>
#include <cstdio>
#include <cstdint>
#define HD __host__ __device__ __forceinline__
#else
#include <cstdio>
#include <cstdint>
#include <cmath>
#include <cstring>
#define HD inline
#endif

#ifndef SEQ_LEN
#define SEQ_LEN 8192
#endif
constexpr int BATCH = 2, SEQ = SEQ_LEN, D = 1024, M = BATCH * SEQ;
constexpr int DC = 512, DSC = 512, NIN = 4608, DFF = 2816, NUP = 2 * DFF, PLE = 256, CKA = 31, NLAYER = 2;
constexpr float EPS = 1e-6f;
constexpr int NQ_UP = (M + 61) / 62;
constexpr int NT_UP = (NQ_UP + 3) / 4;

typedef unsigned short bf16_t;
typedef short bf16x8 __attribute__((ext_vector_type(8)));
typedef float f32x4 __attribute__((ext_vector_type(4)));
typedef float f32x2 __attribute__((ext_vector_type(2)));
typedef unsigned u32x4 __attribute__((ext_vector_type(4)));
typedef unsigned u32x2 __attribute__((ext_vector_type(2)));

HD float bits2f(unsigned u) { return __builtin_bit_cast(float, u); }
HD unsigned f2bits(float f) { return __builtin_bit_cast(unsigned, f); }
HD unsigned f2bf(float f) { unsigned u = f2bits(f); return (u + 0x7fffu + ((u >> 16) & 1u)) >> 16; }
HD unsigned pk2(float lo, float hi) {
#if defined(__HIP_DEVICE_COMPILE__)
    unsigned r; asm volatile("v_cvt_pk_bf16_f32 %0, %1, %2" : "=v"(r) : "v"(lo), "v"(hi)); return r;
#else
    return f2bf(lo) | (f2bf(hi) << 16);
#endif
}
HD float bf_lo(unsigned w) { return bits2f(w << 16); }
HD float bf_hi(unsigned w) { return bits2f(w & 0xffff0000u); }
HD float fexp2(float x) {
#if defined(__HIP_DEVICE_COMPILE__)
    return __builtin_amdgcn_exp2f(x);
#else
    return exp2f(x);
#endif
}
HD float frcp(float x) {
#if defined(__HIP_DEVICE_COMPILE__)
    return __builtin_amdgcn_rcpf(x);
#else
    return 1.0f / x;
#endif
}
HD float frsq(float x) {
#if defined(__HIP_DEVICE_COMPILE__)
    return __builtin_amdgcn_rsqf(x);
#else
    return 1.0f / sqrtf(x);
#endif
}
HD float sigm(float x) { return frcp(1.0f + fexp2(-1.44269504089f * x)); }
HD float gelu_tanh(float x) { const float y = x * (1.5957691216f + 0.0713548163f * x * x); return x * sigm(y); }
HD f32x4 sigm4(f32x4 v) { return (f32x4){sigm(v[0]), sigm(v[1]), sigm(v[2]), sigm(v[3])}; }
HD u32x4 pk8(f32x4 a, f32x4 b) { u32x4 w; w.x = pk2(a[0], a[1]); w.y = pk2(a[2], a[3]); w.z = pk2(b[0], b[1]); w.w = pk2(b[2], b[3]); return w; }
HD u32x2 pk4(f32x4 a) { u32x2 w; w.x = pk2(a[0], a[1]); w.y = pk2(a[2], a[3]); return w; }
HD f32x4 unpk_lo(u32x4 w) { return (f32x4){bf_lo(w.x), bf_hi(w.x), bf_lo(w.y), bf_hi(w.y)}; }
HD f32x4 unpk_hi(u32x4 w) { return (f32x4){bf_lo(w.z), bf_hi(w.z), bf_lo(w.w), bf_hi(w.w)}; }
HD f32x4 unpk4(u32x2 w) { return (f32x4){bf_lo(w.x), bf_hi(w.x), bf_lo(w.y), bf_hi(w.y)}; }
#if defined(__HIP_DEVICE_COMPILE__)
#define CFENCE() asm volatile("" ::: "memory")
#define LAUNDER(x) asm volatile("" : "+v"(x))
#else
#define CFENCE() do {} while (0)
#define LAUNDER(x) do {} while (0)
#endif
HD float hsum4(f32x4 a) { return (a[0] + a[1]) + (a[2] + a[3]); }

HD float row_rs(const float* SS, int g) {
    const f32x4* p = (const f32x4*)(SS + (size_t)g * 16);
    const f32x4 a = p[0], b = p[1], c = p[2], d = p[3];
    const float s = (hsum4(a) + hsum4(b)) + (hsum4(c) + hsum4(d));
    return frsq(s * (1.0f / (float)D) + EPS);
}

HD int win_dst(int s) {
    if (s < 512) return 256 * (s >> 7) + (s & 127);
    if (s < 1024) { const int c = s - 512; return 256 * (c >> 7) + 128 + (c & 127); }
    if (s < 1536) return 2048 + (s - 1024);
    if (s < 2048) { const int c = s - 1536; return 256 * (4 + (c >> 7)) + (c & 127); }
    if (s < 2560) { const int c = s - 2048; return 256 * (4 + (c >> 7)) + 128 + (c & 127); }
    if (s < 3584) { const int c = s - 2560; return 256 * (10 + (c >> 7)) + (c & 127); }
    { const int c = s - 3584; return 256 * (10 + (c >> 7)) + 128 + (c & 127); }
}
HD int wup_dst(int s) { if (s < DFF) return 256 * (s >> 7) + (s & 127); const int c = s - DFF; return 256 * (c >> 7) + 128 + (c & 127); }

constexpr int BM = 256, BK = 64, HALF = 128, HTB = HALF * BK * 2  , STAGE_BYTES = 8 * HTB, NXCD = 8, WGM = 8;
struct Unit { int pm, pn; };
struct Gemm { const bf16_t* A; const bf16_t* Bt; int K; };
struct StaticOrder {
    int nM, nN, nwg, G, c;
    HD void init(int nM_, int nN_, int G_, int c_) { nM = nM_; nN = nN_; nwg = nM * nN; G = G_; c = c_; }
    HD bool next(int i, Unit& u) const {
        const long L = (long)i * G + c; if (L >= nwg) return false;
        int wgid = (int)L; { const int q = nwg / NXCD, r = nwg % NXCD, xcd = wgid % NXCD, off = wgid / NXCD; wgid = (xcd < r ? xcd * (q + 1) : r * (q + 1) + (xcd - r) * q) + off; }
        const int nig = WGM * nN, gid = wgid / nig, fm = gid * WGM, gsz = (nM - fm) < WGM ? (nM - fm) : WGM;
        u.pm = fm + ((wgid % nig) % gsz); u.pn = (wgid % nig) / gsz; return true;
    }
    HD void a_ready(const Unit&) const {}
    HD void done(const Unit&) const {}
};

typedef f32x4 Acc[2][2][4][2];

struct EpiE {
    static constexpr bool PERM = true, AFTER_DRAIN = false, HAS_MID = false; static constexpr int MID_T = -1;
    bf16_t* E;
    template <class Sh> HD void operator()(const Acc& acc, const Unit& u, int wr, int wc, int fr, int fq, const Sh&) const {
        const int cb = u.pn * 256 + wc * 32 + 8 * fq;
#pragma unroll
        for (int ai = 0; ai < 2; ++ai)
#pragma unroll
            for (int m = 0; m < 4; ++m) { const int g = u.pm * 256 + ai * 128 + wr * 64 + m * 16 + fr; bf16_t* rowp = E + (size_t)g * D + cb;
#pragma unroll
                for (int bj = 0; bj < 2; ++bj) *(u32x4*)(rowp + bj * 128) = pk8(acc[ai][bj][m][0], acc[ai][bj][m][1]); }
    }
    template <class Sh> HD void mid(Acc&, const Unit&, int, int, int, int, const Sh&) const {}
};

struct EpiIn {
    static constexpr bool PERM = true, AFTER_DRAIN = false, HAS_MID = false; static constexpr int MID_T = -1;
    const float* SS; const float* bgate; bf16_t *AGLU, *CV, *BS, *GR, *GB;
    template <class Sh> HD void operator()(const Acc& acc, const Unit& u, int wr, int wc, int fr, int fq, const Sh&) const {
        const int cb = wc * 32 + 8 * fq;
        const int pn = u.pn, grow = u.pm * 256 + wr * 64 + fr;
        if (pn < 4) {
#pragma unroll
            for (int ai = 0; ai < 2; ++ai)
#pragma unroll
                for (int m = 0; m < 4; ++m) { const int g = grow + ai * 128 + m * 16; const float rs = row_rs(SS, g);
                    *(u32x4*)(AGLU + (size_t)g * DC + pn * 128 + cb) = pk8((acc[ai][0][m][0] * rs) * sigm4(acc[ai][1][m][0] * rs), (acc[ai][0][m][1] * rs) * sigm4(acc[ai][1][m][1] * rs)); CFENCE(); }
        } else if (pn < 8) {
#pragma unroll
            for (int ai = 0; ai < 2; ++ai)
#pragma unroll
                for (int m = 0; m < 4; ++m) { const int g = grow + ai * 128 + m * 16; const float rs = row_rs(SS, g), r2 = rs * rs;
                    *(u32x4*)(CV + (size_t)g * DSC + (pn - 4) * 128 + cb) = pk8(acc[ai][0][m][0] * acc[ai][1][m][0] * r2, acc[ai][0][m][1] * acc[ai][1][m][1] * r2); CFENCE(); }
        } else if (pn < 10) {
#pragma unroll
            for (int ai = 0; ai < 2; ++ai)
#pragma unroll
                for (int m = 0; m < 4; ++m) { const int g = grow + ai * 128 + m * 16; const float rs = row_rs(SS, g);
                    bf16_t* rowp = BS + (size_t)g * DSC + (pn - 8) * 256 + cb;
                    *(u32x4*)rowp = pk8(acc[ai][0][m][0] * rs, acc[ai][0][m][1] * rs); *(u32x4*)(rowp + 128) = pk8(acc[ai][1][m][0] * rs, acc[ai][1][m][1] * rs); CFENCE(); }
        } else {
            const int t = pn - 10; const float* pa = bgate + t * 128 + cb; const float* pb = bgate + D + t * 128 + cb;
            const f32x4 ba0 = *(const f32x4*)pa, ba1 = *(const f32x4*)(pa + 4), bb0 = *(const f32x4*)pb, bb1 = *(const f32x4*)(pb + 4);
#pragma unroll
            for (int ai = 0; ai < 2; ++ai)
#pragma unroll
                for (int m = 0; m < 4; ++m) { const int g = grow + ai * 128 + m * 16; const float rs = row_rs(SS, g);
                    const size_t o = (size_t)g * D + t * 128 + cb;
                    const f32x4 la0 = acc[ai][0][m][0] * rs + ba0, la1 = acc[ai][0][m][1] * rs + ba1, lb0 = acc[ai][1][m][0] * rs + bb0, lb1 = acc[ai][1][m][1] * rs + bb1;
                    f32x4 r0, r1, g0, g1;
#pragma unroll
                    for (int j = 0; j < 4; ++j) {
                        const float ea0 = fexp2(-1.44269504089f * la0[j]), eb0 = fexp2(-1.44269504089f * lb0[j]), ea1 = fexp2(-1.44269504089f * la1[j]), eb1 = fexp2(-1.44269504089f * lb1[j]);
                        g0[j] = frcp(1.0f + eb0); r0[j] = (1.0f + eb0) * frcp(1.0f + ea0); g1[j] = frcp(1.0f + eb1); r1[j] = (1.0f + eb1) * frcp(1.0f + ea1); }
                    *(u32x4*)(GR + o) = pk8(r0, r1); *(u32x4*)(GB + o) = pk8(g0, g1); CFENCE(); }
        }
    }
    template <class Sh> HD void mid(Acc&, const Unit&, int, int, int, int, const Sh&) const {}
};

struct EpiMerge {
    static constexpr bool PERM = true, AFTER_DRAIN = false, HAS_MID = true; static constexpr int MID_T = 8;
    const bf16_t *GR, *GB; bf16_t* MG;
    template <class Sh> HD void mid(Acc& acc, const Unit& u, int wr, int wc, int fr, int fq, const Sh&) const {
        LAUNDER(fr); LAUNDER(fq);
        const int cb = u.pn * 256 + wc * 32 + 8 * fq;
#pragma unroll
        for (int ai = 0; ai < 2; ++ai)
#pragma unroll
            for (int m = 0; m < 4; ++m) { const int g = u.pm * 256 + ai * 128 + wr * 64 + m * 16 + fr; const bf16_t* rowp = GR + (size_t)g * D + cb;
#pragma unroll
                for (int bj = 0; bj < 2; ++bj) { const u32x4 w = *(const u32x4*)(rowp + bj * 128); acc[ai][bj][m][0] *= unpk_lo(w); acc[ai][bj][m][1] *= unpk_hi(w); CFENCE(); } }
    }
    template <class Sh> HD void operator()(const Acc& acc, const Unit& u, int wr, int wc, int fr, int fq, const Sh&) const {
        const int cb = u.pn * 256 + wc * 32 + 8 * fq;
#pragma unroll
        for (int ai = 0; ai < 2; ++ai)
#pragma unroll
            for (int m = 0; m < 4; ++m) { const int g = u.pm * 256 + ai * 128 + wr * 64 + m * 16 + fr; const size_t o = (size_t)g * D + cb;
#pragma unroll
                for (int bj = 0; bj < 2; ++bj) { const u32x4 w = *(const u32x4*)(GB + o + bj * 128);
                    *(u32x4*)(MG + o + bj * 128) = pk8(acc[ai][bj][m][0] * unpk_lo(w), acc[ai][bj][m][1] * unpk_hi(w)); } CFENCE(); }
    }
};

template <int MODE> struct EpiRes {
    static constexpr bool PERM = false, AFTER_DRAIN = false, HAS_MID = false; static constexpr int MID_T = -1;
    const float* xin; float* xout; bf16_t* xb; float* ssout; const float* ssin; const bf16_t* E;
    template <class Sh> HD void operator()(const Acc& acc, const Unit& u, int wr, int wc, int fr, int fq, const Sh& sh) const {
        const int c4 = u.pn * 256 + wc * 32 + 4 * fq; const int lane = fq * 16 + fr;
#pragma unroll
        for (int ai = 0; ai < 2; ++ai)
#pragma unroll
            for (int m = 0; m < 4; ++m) {
                const int g = u.pm * 256 + ai * 128 + wr * 64 + m * 16 + fr; const size_t o = (size_t)g * D + c4;
                float rs = 1.0f; if (MODE == 1) rs = row_rs(ssin, g);
                float sq = 0.f;
#pragma unroll
                for (int bj = 0; bj < 2; ++bj)
#pragma unroll
                    for (int n = 0; n < 2; ++n) { const size_t oo = o + bj * 128 + n * 16;
                        f32x4 v = acc[ai][bj][m][n];
                        if (MODE == 1) { const f32x4 e = unpk4(*(const u32x2*)(E + oo)); v = sigm4(v * rs) * e; }
                        const f32x4 xn = *(const f32x4*)(xin + oo) + v;
                        *(f32x4*)(xout + oo) = xn; *(u32x2*)(xb + oo) = pk4(xn);
                        sq += (xn[0] * xn[0] + xn[1] * xn[1]) + (xn[2] * xn[2] + xn[3] * xn[3]); }
                sq += sh(sq, lane ^ 16); sq += sh(sq, lane ^ 32);
                if (fq == 0) ssout[(size_t)g * 16 + u.pn * 4 + wc] = sq;
            }
    }
    template <class Sh> HD void mid(Acc&, const Unit&, int, int, int, int, const Sh&) const {}
};

struct EpiUp {
    static constexpr bool PERM = true, AFTER_DRAIN = false, HAS_MID = false; static constexpr int MID_T = -1;
    const float* SS; const float* cw; const float* cb_; bf16_t* F;
    template <class Sh> HD void operator()(const Acc& acc, const Unit& u, int wr, int wc, int fr, int fq, const Sh& sh) const {
        const int ch = u.pn * 128 + wc * 32 + 8 * fq;
        const int lane = fq * 16 + fr;
        const f32x4 w0a = *(const f32x4*)(cw + ch), w0b = *(const f32x4*)(cw + ch + 4), w1a = *(const f32x4*)(cw + DFF + ch), w1b = *(const f32x4*)(cw + DFF + ch + 4);
        const f32x4 w2a = *(const f32x4*)(cw + 2 * DFF + ch), w2b = *(const f32x4*)(cw + 2 * DFF + ch + 4), bia = *(const f32x4*)(cb_ + ch), bib = *(const f32x4*)(cb_ + ch + 4);
        const int s1 = (lane & 48) | ((fr + 15) & 15), s2 = (lane & 48) | ((fr + 14) & 15);
#pragma unroll
        for (int ai = 0; ai < 2; ++ai) {
            const int q = 4 * u.pm + 2 * ai + wr;
            f32x4 pa = {0.f, 0.f, 0.f, 0.f}, pb = pa;
#pragma unroll
            for (int m = 0; m < 4; ++m) {
                const int rho = m * 16 + fr, g = 62 * q - 2 + rho; const int gc = g < 0 ? 0 : (g > M - 1 ? M - 1 : g);
                const float rs = row_rs(SS, gc);
                const f32x4 ga = acc[ai][0][m][0] * rs, gb = acc[ai][0][m][1] * rs, va = acc[ai][1][m][0] * rs, vb = acc[ai][1][m][1] * rs;
                f32x4 t1a, t1b, t2a, t2b;
#pragma unroll
                for (int j = 0; j < 4; ++j) {
                    const float c1a = sh(ga[j], s1), c1b = sh(gb[j], s1), c2a = sh(ga[j], s2), c2b = sh(gb[j], s2);
                    const float p1a = sh(pa[j], s1), p1b = sh(pb[j], s1), p2a = sh(pa[j], s2), p2b = sh(pb[j], s2);
                    t1a[j] = fr >= 1 ? c1a : p1a; t1b[j] = fr >= 1 ? c1b : p1b; t2a[j] = fr >= 2 ? c2a : p2a; t2b[j] = fr >= 2 ? c2b : p2b;
                }
                pa = ga; pb = gb;
                const int t = gc % SEQ;
                if (t < 1) { t1a = (f32x4){0.f, 0.f, 0.f, 0.f}; t1b = t1a; }
                if (t < 2) { t2a = (f32x4){0.f, 0.f, 0.f, 0.f}; t2b = t2a; }
                const f32x4 fa = w2a * ga + w1a * t1a + w0a * t2a + bia, fb = w2b * gb + w1b * t1b + w0b * t2b + bib;
                f32x4 oa, ob;
#pragma unroll
                for (int j = 0; j < 4; ++j) { oa[j] = gelu_tanh(fa[j]) * va[j]; ob[j] = gelu_tanh(fb[j]) * vb[j]; }
                if (rho >= 2 && g < M) *(u32x4*)(F + (size_t)g * DFF + ch) = pk8(oa, ob);
            }
        }
    }
    template <class Sh> HD void mid(Acc&, const Unit&, int, int, int, int, const Sh&) const {}
};

#ifndef EMU
#define PG8_LAS __attribute__((address_space(3)))
#define GAS __attribute__((address_space(1)))
#define LAS __attribute__((address_space(3)))
typedef GAS unsigned gu32;
#define RLX_AGENT __ATOMIC_RELAXED, __HIP_MEMORY_SCOPE_AGENT
#define LDS_WAIT() asm volatile("s_waitcnt lgkmcnt(0)" ::: "memory")
#define VM_WAIT() asm volatile("s_waitcnt vmcnt(0)" ::: "memory")
struct ShflDev { __device__ __forceinline__ float operator()(float v, int src) const { return __shfl(v, src, 64); } };

__host__ __device__ __forceinline__ int lds_byte(int r, int c) { const int st = (r >> 4) * 2 + (c >> 5), rr = r & 15, cc = c & 31, ob = rr * 64 + cc * 2; return st * 1024 + (ob ^ (((ob >> 9) & 1) << 5)); }
__host__ __device__ __forceinline__ void stage_rc(int b, int& R, int& C) { const int st = b / 1024, sb = b % 1024, swz = sb ^ (((sb >> 9) & 1) << 5); R = (st >> 1) * 16 + swz / 64; C = (st & 1) * 32 + (swz % 64) / 2; }
__host__ __device__ __forceinline__ int perm32(int rho) { const int n = rho >> 4, i = rho & 15; return 8 * (i >> 2) + 4 * n + (i & 3); }

template <class Epi, class Sched, bool ALIGN_EPI = false, bool SP2 = false, bool ACHUNK = false>
__device__ __forceinline__ void gemm_phase(PG8_LAS unsigned char* lds, const Gemm g, const Sched& S, const Epi& E) {
    int tid_ = threadIdx.x; asm volatile("" : "+v"(tid_));
    const int tid = tid_, wid = __builtin_amdgcn_readfirstlane(tid >> 6), lane = tid & 63, wr = wid >> 2, wc = wid & 3, fr = lane & 15, fq = lane >> 4;
    int K_ = g.K; asm volatile("" : "+s"(K_));
    const int K = K_, nt = K / BK;
    unsigned voffA[2], voffB[2];
#pragma unroll
    for (int i = 0; i < 2; ++i) { int R, C; stage_rc(tid * 16 + i * 8192, R, C); const int Rb = Epi::PERM ? ((R & ~31) + perm32(R & 31)) : R;
        const int Ra = ACHUNK ? ((R >> 6) * 62 + (R & 63)) : R; voffA[i] = (unsigned)(Ra * K + C) * 2u; voffB[i] = (unsigned)(Rb * K + C) * 2u; }
    const size_t kstep = (size_t)(BK * 2);
    const size_t hstepB = (size_t)HALF * K * 2, hstepA = ACHUNK ? (size_t)124 * K * 2 : hstepB;
    const size_t tstepA = 2 * hstepA, tstepB = 2 * hstepB;
    const unsigned ldsw = (unsigned)wid * 1024u;
    const int aoff = lds_byte(wr * 64 + fr, fq * 8), boff = lds_byte(wc * 32 + fr, fq * 8);
#define PG8_SA(b, h) (((b) * 2 + (h)) * HTB)
#define PG8_SB(b, h) ((4 + (b) * 2 + (h)) * HTB)
#define PG8_STAGE(bufoff, gbase, voff) do { _Pragma("unroll") for (int _i = 0; _i < 2; ++_i) \
        __builtin_amdgcn_global_load_lds((const unsigned*)((const char*)(gbase) + (voff)[_i]), (PG8_LAS unsigned*)(lds + (bufoff) + ldsw + _i * 8192), 16, 0, 0); } while (0)
#define PG8_LDA(dst, b, h) do { _Pragma("unroll") for (int m = 0; m < 4; ++m) _Pragma("unroll") for (int k = 0; k < 2; ++k) dst[m][k] = *(const PG8_LAS bf16x8*)(lds + PG8_SA(b, h) + aoff + m * 2048 + k * 1024); } while (0)
#define PG8_LDB(dst, b, h) do { _Pragma("unroll") for (int n = 0; n < 2; ++n) _Pragma("unroll") for (int k = 0; k < 2; ++k) dst[n][k] = *(const PG8_LAS bf16x8*)(lds + PG8_SB(b, h) + boff + n * 2048 + k * 1024); } while (0)
#define PG8_MMA(ai, bj, At, Bt) do { __builtin_amdgcn_s_setprio(1); _Pragma("unroll") for (int m = 0; m < 4; ++m) _Pragma("unroll") for (int n = 0; n < 2; ++n) _Pragma("unroll") for (int k = 0; k < 2; ++k) \
        acc[ai][bj][m][n] = __builtin_amdgcn_mfma_f32_16x16x32_bf16(Bt[n][k], At[m][k], acc[ai][bj][m][n], 0, 0, 0); __builtin_amdgcn_s_setprio(0); } while (0)
#define PG8_WAIT_V(n) asm volatile("s_waitcnt vmcnt(" #n ")" ::: "memory")
#define PG8_WAIT_L(n) asm volatile("s_waitcnt lgkmcnt(" #n ")" ::: "memory")
#define PG8_BAR __builtin_amdgcn_s_barrier()
#define PG8_SCHED __builtin_amdgcn_sched_barrier(0)
    Unit cur, nxt; int ui = 0;
    if (!S.next(0, cur)) return;
    f32x4 acc[2][2][4][2];
#pragma unroll
    for (int a = 0; a < 2; ++a)
#pragma unroll
        for (int b = 0; b < 2; ++b)
#pragma unroll
            for (int m = 0; m < 4; ++m)
#pragma unroll
                for (int n = 0; n < 2; ++n) acc[a][b][m][n] = (f32x4){0.f, 0.f, 0.f, 0.f};
    bf16x8 At[4][2], B0[2][2], B1[2][2];
    const char* cA = (const char*)g.A + (size_t)cur.pm * tstepA; const char* cB = (const char*)g.Bt + (size_t)cur.pn * tstepB;
    S.a_ready(cur);
    if constexpr (SP2) {
        PG8_STAGE(PG8_SB(0, 0), cB, voffB); PG8_STAGE(PG8_SB(0, 1), cB + hstepB, voffB); PG8_STAGE(PG8_SA(0, 0), cA, voffA); PG8_STAGE(PG8_SA(0, 1), cA + hstepA, voffA);
        if (wr == 1) PG8_BAR;
        PG8_WAIT_V(2); PG8_BAR;
        PG8_STAGE(PG8_SB(1, 0), cB + kstep, voffB); PG8_STAGE(PG8_SA(1, 0), cA + kstep, voffA); PG8_STAGE(PG8_SB(1, 1), cB + hstepB + kstep, voffB);
        PG8_WAIT_V(6); PG8_BAR;
    } else {
        PG8_STAGE(PG8_SB(0, 0), cB, voffB); PG8_STAGE(PG8_SA(0, 0), cA, voffA); PG8_STAGE(PG8_SB(0, 1), cB + hstepB, voffB); PG8_STAGE(PG8_SA(0, 1), cA + hstepA, voffA);
        if (wr == 1) PG8_BAR;
        PG8_WAIT_V(4); PG8_BAR;
        PG8_STAGE(PG8_SB(1, 0), cB + kstep, voffB); PG8_STAGE(PG8_SA(1, 0), cA + kstep, voffA); PG8_STAGE(PG8_SB(1, 1), cB + hstepB + kstep, voffB);
        PG8_WAIT_V(6); PG8_BAR;
    }
    for (;;) {
        const bool has_next = S.next(ui + 1, nxt);
        const char* nA = has_next ? (const char*)g.A + (size_t)nxt.pm * tstepA : cA; const char* nB = has_next ? (const char*)g.Bt + (size_t)nxt.pn * tstepB : cB;
        for (int t = 0; t < nt; t += 2) {
            const bool last = (t == nt - 2);
            if constexpr (Epi::HAS_MID) { if (t == Epi::MID_T) E.mid(acc, cur, wr, wc, fr, fq, ShflDev{}); }
            const char* a1 = cA + (size_t)(t + 1) * kstep;
            const char* a2 = last ? nA : cA + (size_t)(t + 2) * kstep; const char* b2 = last ? nB : cB + (size_t)(t + 2) * kstep;
            const char* a3 = a2 + kstep; const char* b3 = b2 + kstep;
            if (last && has_next) S.a_ready(nxt);
            if constexpr (SP2) {
            PG8_LDB(B0, 0, 0); PG8_LDB(B1, 0, 1); PG8_SCHED; PG8_LDA(At, 0, 0); PG8_STAGE(PG8_SA(1, 1), a1 + hstepA, voffA);
            PG8_WAIT_V(8); PG8_WAIT_L(0); PG8_BAR; PG8_MMA(0, 0, At, B0); PG8_MMA(0, 1, At, B1); PG8_BAR; PG8_SCHED;
            PG8_LDA(At, 0, 1); PG8_STAGE(PG8_SB(0, 0), b2, voffB); PG8_STAGE(PG8_SB(0, 1), b2 + hstepB, voffB); PG8_STAGE(PG8_SA(0, 0), a2, voffA);
            PG8_WAIT_V(8); PG8_WAIT_L(0); PG8_BAR; PG8_MMA(1, 0, At, B0); PG8_MMA(1, 1, At, B1); PG8_BAR; PG8_SCHED;
            PG8_LDB(B0, 1, 0); PG8_LDB(B1, 1, 1); PG8_SCHED; PG8_LDA(At, 1, 0); PG8_STAGE(PG8_SA(0, 1), a2 + hstepA, voffA);
            PG8_WAIT_V(8); PG8_WAIT_L(0); PG8_BAR; PG8_MMA(0, 0, At, B0); PG8_MMA(0, 1, At, B1); PG8_BAR; PG8_SCHED;
            PG8_LDA(At, 1, 1); PG8_STAGE(PG8_SB(1, 0), b3, voffB); PG8_STAGE(PG8_SB(1, 1), b3 + hstepB, voffB); PG8_STAGE(PG8_SA(1, 0), a3, voffA);
            PG8_WAIT_V(8); PG8_WAIT_L(0); PG8_BAR; PG8_MMA(1, 0, At, B0); PG8_MMA(1, 1, At, B1); PG8_BAR; PG8_SCHED;
            } else {
            PG8_LDB(B0, 0, 0); PG8_SCHED; PG8_LDA(At, 0, 0); PG8_STAGE(PG8_SA(1, 1), a1 + hstepA, voffA);
            PG8_WAIT_L(8); PG8_BAR; PG8_WAIT_L(0); PG8_MMA(0, 0, At, B0); PG8_BAR; PG8_SCHED;
            PG8_LDB(B1, 0, 1); PG8_STAGE(PG8_SB(0, 0), b2, voffB);
            PG8_BAR; PG8_WAIT_L(0); PG8_MMA(0, 1, At, B1); PG8_BAR;
            PG8_LDA(At, 0, 1); PG8_STAGE(PG8_SA(0, 0), a2, voffA);
            PG8_BAR; PG8_WAIT_L(0); PG8_MMA(1, 0, At, B0); PG8_BAR; PG8_SCHED;
            PG8_STAGE(PG8_SB(0, 1), b2 + hstepB, voffB);
            PG8_WAIT_V(6); PG8_BAR; PG8_MMA(1, 1, At, B1); PG8_BAR;
            PG8_LDB(B0, 1, 0); PG8_SCHED; PG8_LDA(At, 1, 0); PG8_STAGE(PG8_SA(0, 1), a2 + hstepA, voffA);
            PG8_WAIT_L(8); PG8_BAR; PG8_WAIT_L(0); PG8_MMA(0, 0, At, B0); PG8_BAR; PG8_SCHED;
            PG8_LDB(B1, 1, 1); PG8_STAGE(PG8_SB(1, 0), b3, voffB);
            PG8_BAR; PG8_WAIT_L(0); PG8_MMA(0, 1, At, B1); PG8_BAR;
            PG8_LDA(At, 1, 1); PG8_STAGE(PG8_SA(1, 0), a3, voffA);
            PG8_BAR; PG8_WAIT_L(0); PG8_MMA(1, 0, At, B0); PG8_BAR; PG8_SCHED;
            PG8_STAGE(PG8_SB(1, 1), b3 + hstepB, voffB);
            PG8_WAIT_V(6); PG8_BAR; PG8_MMA(1, 1, At, B1); PG8_BAR;
            }
        }
        if constexpr (ALIGN_EPI) { if (wr == 0) PG8_BAR; }
        if constexpr (!Epi::AFTER_DRAIN) { E(acc, cur, wr, wc, fr, fq, ShflDev{}); S.done(cur); }
        if (!has_next) break;
#pragma unroll
        for (int a = 0; a < 2; ++a)
#pragma unroll
            for (int b = 0; b < 2; ++b)
#pragma unroll
                for (int m = 0; m < 4; ++m)
#pragma unroll
                    for (int n = 0; n < 2; ++n) acc[a][b][m][n] = (f32x4){0.f, 0.f, 0.f, 0.f};
        cur = nxt; cA = nA; cB = nB; ++ui;
        if constexpr (ALIGN_EPI) { if (wr == 1) PG8_BAR; }
    }
    PG8_WAIT_V(0);
    if constexpr (!ALIGN_EPI) { if (wr == 0) PG8_BAR; }
    PG8_BAR;
#undef PG8_SA
#undef PG8_SB
#undef PG8_STAGE
#undef PG8_LDA
#undef PG8_LDB
#undef PG8_MMA
#undef PG8_WAIT_V
#undef PG8_WAIT_L
#undef PG8_BAR
#undef PG8_SCHED
}

constexpr int NWAVES = 8;
#ifndef MK_PER_PHASE
#define MK_PER_PHASE 1
#endif
constexpr int N_PHASES = 8 * NLAYER + 1;

constexpr size_t MiB = 1u << 20;
constexpr size_t WS_CTL = 0, CTL_ZERO_BYTES = 64 * 1024;
constexpr size_t WS_SS0 = 1 * MiB, WS_SS1 = 2 * MiB;
constexpr size_t WS_WB = 3 * MiB;
constexpr size_t WB_WIN = 0, WB_WAB = WB_WIN + (size_t)NIN * D, WB_WO = WB_WAB + (size_t)D * D, WB_WUP = WB_WO + (size_t)D * D, WB_WDN = WB_WUP + (size_t)NUP * D,
                 WB_WPG = WB_WDN + (size_t)D * DFF, WB_WPL = WB_WPG + (size_t)D * D, WB_END = WB_WPL + (size_t)D * PLE;
static_assert(WB_END * 2 == 32 * MiB, "weight copies fill 32 MiB");
constexpr size_t WS_PB = 35 * MiB;
constexpr size_t WS_XB = 44 * MiB;
constexpr size_t WS_ACT = 77 * MiB;
constexpr size_t WS_AGLU = WS_ACT, WS_CV = WS_ACT + 16 * MiB, WS_BS = WS_ACT + 32 * MiB, WS_GR = WS_ACT + 48 * MiB, WS_GB = WS_ACT + 80 * MiB,
                 WS_A2S = WS_ACT + 112 * MiB, WS_E = WS_ACT + 144 * MiB, WS_END = WS_ACT + 176 * MiB;
constexpr size_t WS_MG = WS_AGLU;
constexpr size_t WS_F = WS_ACT;
constexpr size_t WS_XB2 = WS_A2S;
static_assert(WS_END <= 256 * MiB && WS_F + (size_t)M * DFF * 2 <= WS_A2S && WS_XB + (size_t)(M + 256) * D * 2 <= WS_ACT, "d_ws map");
constexpr int CW_BAR = 4096;

constexpr int RING_OFF = 0, RING_BYTES = 131072;
constexpr int LDSCTL_OFF = RING_BYTES, MISC_OFF = LDSCTL_OFF + 320;
constexpr int LDS_BYTES = 147456;
static_assert(MISC_OFF + 128 <= LDS_BYTES, "LDS map");

#define XB_TMO      128
#define XB_XCNT(j)  (256  + 64 * (j))
#define XB_XSUB(j)  (1280 + 64 * (j))
#define XB_XGEN(j)  (2304 + 64 * (j))
#define XB_TOP      3328
#define XB_TOPGEN   3392
#define XCD_BAR_WORDS 3456
#define XB_SPIN_CAP (1u << 18)

__device__ __forceinline__ unsigned xb_ld(unsigned* p)              { return __hip_atomic_load(p, __ATOMIC_RELAXED, __HIP_MEMORY_SCOPE_AGENT); }
__device__ __forceinline__ unsigned xb_add(unsigned* p, unsigned v) { return __hip_atomic_fetch_add(p, v, __ATOMIC_RELAXED, __HIP_MEMORY_SCOPE_AGENT); }
__device__ __forceinline__ unsigned xb_xcc_id() { return (unsigned)__builtin_amdgcn_s_getreg((3 << 11) | 20) & 0xFu; }
#define XB_SPIN(cond, bar) do { unsigned _sp = 0; while (cond) { __builtin_amdgcn_s_sleep(1); \
    if ((++_sp & 255u) == 0u) { if (xb_ld(&(bar)[XB_TMO])) break; if (_sp > XB_SPIN_CAP) { atomicAdd(&(bar)[XB_TMO], 1u); break; } } } } while (0)

struct XcdBarrier {
    unsigned* bar; unsigned x;
    volatile LAS unsigned* st;
};

__device__ __forceinline__ XcdBarrier xcd_barrier_post(unsigned* bar, volatile LAS unsigned* st) {
    XcdBarrier b; b.bar = bar; b.x = xb_xcc_id(); b.st = st;
    if (threadIdx.x == 0) (void)xb_add(&bar[XB_XCNT(b.x)], 1u);
    return b;
}
__device__ __forceinline__ void xcd_barrier_complete(unsigned* bar, unsigned x, unsigned& nloc, unsigned& nx) {
    const unsigned G = gridDim.x * gridDim.y * gridDim.z;
    unsigned sum, cnt, mine, sp = 0u;
    for (;;) {
        sum = 0u; cnt = 0u; mine = 0u;
#pragma unroll
        for (unsigned j = 0; j < 16; ++j) { const unsigned c = xb_ld(&bar[XB_XCNT(j)]); sum += c; cnt += (c > 0u) ? 1u : 0u; mine = (j == x) ? c : mine; }
        if (sum == G) break;
        __builtin_amdgcn_s_sleep(1);
        if ((++sp & 255u) == 0u) { if (xb_ld(&bar[XB_TMO])) break; if (sp > XB_SPIN_CAP) { atomicAdd(&bar[XB_TMO], 1u); break; } }
    }
    nloc = mine > 0u ? mine : 1u; nx = cnt > 0u ? cnt : 1u;
}

__device__ __forceinline__ void xcd_barrier(const XcdBarrier& b) {
    asm volatile("s_waitcnt vmcnt(0)" ::: "memory");
    __syncthreads();
    if (threadIdx.x == 0) {
        unsigned* bar = b.bar;
        __builtin_amdgcn_s_waitcnt(0);
        unsigned nloc = b.st[0], nx = b.st[1];
        if (nloc == 0u) { xcd_barrier_complete(bar, b.x, nloc, nx); b.st[0] = nloc; b.st[1] = nx; }
        const unsigned old = xb_add(&bar[XB_XSUB(b.x)], 1u);
        const unsigned gen = old / nloc;
        if (old + 1u == (gen + 1u) * nloc) {
            __builtin_amdgcn_fence(__ATOMIC_RELEASE, "agent");
            asm volatile("s_waitcnt vmcnt(0)" ::: "memory");
            const unsigned og = xb_add(&bar[XB_TOP], 1u);
            const unsigned tg = og / nx;
            if (og + 1u == (tg + 1u) * nx) xb_add(&bar[XB_TOPGEN], 1u);
            else XB_SPIN(xb_ld(&bar[XB_TOPGEN]) == tg, bar);
            __builtin_amdgcn_fence(__ATOMIC_ACQUIRE, "agent");
            xb_add(&bar[XB_XGEN(b.x)], 1u);
            asm volatile("s_waitcnt vmcnt(0)" ::: "memory");
        } else {
            XB_SPIN(xb_ld(&bar[XB_XGEN(b.x)]) == gen, bar);
            __builtin_amdgcn_fence(__ATOMIC_ACQUIRE, "agent");
            asm volatile("s_waitcnt vmcnt(0)" ::: "memory");
        }
    }
    __syncthreads();
}

struct Frame {
    LAS unsigned char* lds;
    volatile LAS unsigned* MISC;
    gu32* ctl;
    int tid, lane, wave;
    int vcu, G;
    float* out; unsigned char* ws;
};
__device__ __forceinline__ float wave_sum(float v) {
#pragma unroll
    for (int o = 1; o < 64; o <<= 1) v += __shfl_xor(v, o, 64);
    return v;
}

__device__ __forceinline__ void cv_item(const float* W, int N, const float* gk, bf16_t* WT, int ldt, int kofs, int drow, int kb, int nb, LAS float* scr, int lane) {
    const int k0 = 64 * kb, n0 = 32 * nb;
#pragma unroll 8
    for (int i = 0; i < 32; ++i) { const int kk = 2 * i + (lane >> 5); float v = W[(size_t)(k0 + kk) * N + n0 + (lane & 31)]; if (gk) v *= gk[k0 + kk]; scr[kk * 33 + (lane & 31)] = v; }
    LDS_WAIT(); asm volatile("" ::: "memory");
    const int c = lane & 7;
#pragma unroll
    for (int j = 0; j < 4; ++j) { const int n = (lane >> 3) + 8 * j; const LAS float* s = scr + (8 * c) * 33 + n;
        u32x4 o; o.x = pk2(s[0 * 33], s[1 * 33]); o.y = pk2(s[2 * 33], s[3 * 33]); o.z = pk2(s[4 * 33], s[5 * 33]); o.w = pk2(s[6 * 33], s[7 * 33]);
        *(GAS u32x4*)(WT + (size_t)(drow + n) * ldt + kofs + k0 + 8 * c) = o; }
    LDS_WAIT(); asm volatile("" ::: "memory");
}
struct CvPtrs { const float *x, *p, *g_mix, *w_in, *w_a, *w_b, *w_o, *g_ffn, *w_up, *w_dn, *g_ple, *w_pl, *w_pg; };
__device__ __forceinline__ void cv_phase(Frame& F, int layer, const CvPtrs& P) {
    LAS float* scr = (LAS float*)(F.lds + RING_OFF + F.wave * 16384);
    const int gw = F.vcu * NWAVES + F.wave, NGW = F.G * NWAVES;
    bf16_t* WB = (bf16_t*)(F.ws + WS_WB);
    const float* w_in = P.w_in + (size_t)layer * D * NIN;      const float* g_mix = P.g_mix + layer * D;
    const float* w_a = P.w_a + (size_t)layer * DC * D;          const float* w_b = P.w_b + (size_t)layer * DSC * D;
    const float* w_o = P.w_o + (size_t)layer * D * D;           const float* g_ffn = P.g_ffn + layer * D;
    const float* w_up = P.w_up + (size_t)layer * D * NUP;       const float* w_dn = P.w_dn + (size_t)layer * DFF * D;
    const float* g_ple = P.g_ple + layer * D;                   const float* w_pl = P.w_pl + (size_t)layer * PLE * D;
    const float* w_pg = P.w_pg + (size_t)layer * D * D;
    constexpr int I_IN = (D / 64) * (NIN / 32), I_A = (DC / 64) * (D / 32), I_O = (D / 64) * (D / 32), I_UP = (D / 64) * (NUP / 32), I_DN = (DFF / 64) * (D / 32), I_PL = (PLE / 64) * (D / 32);
    constexpr int NITEMS = I_IN + 2 * I_A + I_O + I_UP + I_DN + I_O + I_PL;
    for (int it = gw; it < NITEMS; it += NGW) {
        int r = it;
        if (r < I_IN) { const int nblk = NIN / 32, kb = r / nblk, nb = r % nblk; cv_item(w_in, NIN, g_mix, WB + WB_WIN, D, 0, win_dst(32 * nb), kb, nb, scr, F.lane); continue; } r -= I_IN;
        if (r < I_A)  { const int nblk = D / 32, kb = r / nblk, nb = r % nblk; cv_item(w_a, D, nullptr, WB + WB_WAB, D, 0, 32 * nb, kb, nb, scr, F.lane); continue; } r -= I_A;
        if (r < I_A)  { const int nblk = D / 32, kb = r / nblk, nb = r % nblk; cv_item(w_b, D, nullptr, WB + WB_WAB, D, DC, 32 * nb, kb, nb, scr, F.lane); continue; } r -= I_A;
        if (r < I_O)  { const int nblk = D / 32, kb = r / nblk, nb = r % nblk; cv_item(w_o, D, nullptr, WB + WB_WO, D, 0, 32 * nb, kb, nb, scr, F.lane); continue; } r -= I_O;
        if (r < I_UP) { const int nblk = NUP / 32, kb = r / nblk, nb = r % nblk; cv_item(w_up, NUP, g_ffn, WB + WB_WUP, D, 0, wup_dst(32 * nb), kb, nb, scr, F.lane); continue; } r -= I_UP;
        if (r < I_DN) { const int nblk = D / 32, kb = r / nblk, nb = r % nblk; cv_item(w_dn, D, nullptr, WB + WB_WDN, DFF, 0, 32 * nb, kb, nb, scr, F.lane); continue; } r -= I_DN;
        if (r < I_O)  { const int nblk = D / 32, kb = r / nblk, nb = r % nblk; cv_item(w_pg, D, g_ple, WB + WB_WPG, D, 0, 32 * nb, kb, nb, scr, F.lane); continue; } r -= I_O;
        { const int nblk = D / 32, kb = r / nblk, nb = r % nblk; cv_item(w_pl, D, nullptr, WB + WB_WPL, PLE, 0, 32 * nb, kb, nb, scr, F.lane); }
    }
    { const GAS f32x4* src = (const GAS f32x4*)(P.p + (size_t)layer * M * PLE); GAS u32x2* dst = (GAS u32x2*)(F.ws + WS_PB);
      const int gt = F.vcu * (NWAVES * 64) + F.tid, NT = F.G * NWAVES * 64;
      for (int i = gt; i < M * PLE / 4; i += NT) dst[i] = pk4(src[i]); }
    if (layer == 0) {
        for (int m = gw; m < M; m += NGW) {
            const GAS f32x4* xr = (const GAS f32x4*)(P.x + (size_t)m * D) + F.lane; GAS u32x2* o8 = (GAS u32x2*)(F.ws + WS_XB + (size_t)m * D * 2) + F.lane;
            float s = 0.f;
#pragma unroll
            for (int j = 0; j < 4; ++j) { const f32x4 v = xr[64 * j]; s += (v[0] * v[0] + v[1] * v[1]) + (v[2] * v[2] + v[3] * v[3]); o8[64 * j] = pk4(v); }
            s = wave_sum(s);
            if (F.lane < 16) ((GAS float*)(F.ws + WS_SS0))[(size_t)m * 16 + F.lane] = F.lane == 0 ? s : 0.f;
        }
    }
}

constexpr int CO_R = 16;
template <int S> struct CoStep {
    static __device__ __forceinline__ void run(f32x2 (&acc)[CO_R], const f32x2 (&w)[CKA], const GAS unsigned* src, int g0, int t0, int cw) {
        const int ts = t0 - (CKA - 1) + S; const bool ok = ts >= 0;
        const unsigned wd = src[(size_t)(ok ? g0 - (CKA - 1) + S : g0) * (DC / 2) + cw];
        f32x2 a; a.x = ok ? bf_lo(wd) : 0.f; a.y = ok ? bf_hi(wd) : 0.f;
#pragma unroll
        for (int r = 0; r < CO_R; ++r) { constexpr int dummy = 0; (void)dummy; const int k = S - r; if (k >= 0 && k < CKA) acc[r] += w[k] * a; }
        CoStep<S + 1>::run(acc, w, src, g0, t0, cw);
    }
};
template <> struct CoStep<CO_R + CKA - 1> { static __device__ __forceinline__ void run(f32x2 (&)[CO_R], const f32x2 (&)[CKA], const GAS unsigned*, int, int, int) {} };
__device__ __forceinline__ void co_phase(Frame& F, int layer, const float* cwa_, const float* cba_, const float* lng_, const float* lnb_, const float* cwb_) {
    const int grp = F.tid >> 8, wv = (F.tid >> 6) & 3, c0 = wv * 128 + F.lane * 2;
    const float* cwa = cwa_ + (size_t)layer * CKA * DC; const float* cba = cba_ + layer * DC; const float* lng = lng_ + layer * DC; const float* lnb = lnb_ + layer * DC;
    const float* cwb = cwb_ + (size_t)layer * 3 * DSC;
    const GAS unsigned* AGLU = (const GAS unsigned*)(F.ws + WS_AGLU); const GAS unsigned* CVp = (const GAS unsigned*)(F.ws + WS_CV); const GAS unsigned* BSp = (const GAS unsigned*)(F.ws + WS_BS);
    GAS unsigned* A2S = (GAS unsigned*)(F.ws + WS_A2S);
    LAS f32x2* part = (LAS f32x2*)(F.lds + RING_OFF) + grp * (CO_R * 4);
    f32x2 w[CKA];
#pragma unroll
    for (int k = 0; k < CKA; ++k) w[k] = *(const f32x2*)(cwa + k * DC + c0);
    const f32x2 bias = *(const f32x2*)(cba + c0), lg = *(const f32x2*)(lng + c0), lb = *(const f32x2*)(lnb + c0);
    const f32x2 wb0 = *(const f32x2*)(cwb + c0), wb1 = *(const f32x2*)(cwb + DSC + c0), wb2 = *(const f32x2*)(cwb + 2 * DSC + c0);
    constexpr int NITEM = M / CO_R;
    const int ngrp = 2 * F.G;
    for (int it0 = 0; it0 < NITEM; it0 += ngrp) {
        const int it = it0 + F.vcu * 2 + grp; const bool live = it < NITEM;
        const int g0 = (live ? it : 0) * CO_R, t0 = g0 % SEQ;
        f32x2 acc[CO_R];
#pragma unroll
        for (int r = 0; r < CO_R; ++r) acc[r] = bias;
        CoStep<0>::run(acc, w, AGLU, g0, t0, c0 >> 1);
#pragma unroll
        for (int r = 0; r < CO_R; ++r) {
            float s1 = acc[r].x + acc[r].y, s2 = acc[r].x * acc[r].x + acc[r].y * acc[r].y;
            s1 = wave_sum(s1); s2 = wave_sum(s2);
            if (F.lane == 0) part[r * 4 + wv] = (f32x2){s1, s2};
        }
        __syncthreads();
#pragma unroll
        for (int r = 0; r < CO_R; ++r) {
            const f32x2 p0 = part[r * 4 + 0], p1 = part[r * 4 + 1], p2 = part[r * 4 + 2], p3 = part[r * 4 + 3];
            const float mean = ((p0.x + p1.x) + (p2.x + p3.x)) * (1.0f / DC), ex2 = ((p0.y + p1.y) + (p2.y + p3.y)) * (1.0f / DC);
            const float var = fmaxf(ex2 - mean * mean, 0.f), rstd = frsq(var + EPS);
            float y0 = (acc[r].x - mean) * rstd * lg.x + lb.x, y1 = (acc[r].y - mean) * rstd * lg.y + lb.y;
            y0 = y0 * sigm(y0); y1 = y1 * sigm(y1);
            if (live) A2S[(size_t)(g0 + r) * (D / 2) + (c0 >> 1)] = pk2(y0, y1);
        }
        {
            f32x2 c2 = {0.f, 0.f}, c1 = {0.f, 0.f};
            if (t0 >= 2) { const unsigned wd = CVp[(size_t)(g0 - 2) * (DSC / 2) + (c0 >> 1)]; c2 = (f32x2){bf_lo(wd), bf_hi(wd)}; }
            if (t0 >= 1) { const unsigned wd = CVp[(size_t)(g0 - 1) * (DSC / 2) + (c0 >> 1)]; c1 = (f32x2){bf_lo(wd), bf_hi(wd)}; }
#pragma unroll 8
            for (int r = 0; r < CO_R; ++r) {
                const unsigned wc_ = CVp[(size_t)(g0 + r) * (DSC / 2) + (c0 >> 1)], wb_ = BSp[(size_t)(g0 + r) * (DSC / 2) + (c0 >> 1)];
                const f32x2 c = {bf_lo(wc_), bf_hi(wc_)}, b = {bf_lo(wb_), bf_hi(wb_)};
                const f32x2 o = b * (wb0 * c2 + wb1 * c1 + wb2 * c);
                if (live) A2S[(size_t)(g0 + r) * (D / 2) + (DC >> 1) + (c0 >> 1)] = pk2(o.x, o.y);
                c2 = c1; c1 = c;
            }
        }
        __syncthreads();
    }
}

__device__ __forceinline__ void final_phase(Frame& F, const float* g_final) {
    const int gw = F.vcu * NWAVES + F.wave, NGW = F.G * NWAVES;
    const float* SS = (const float*)(F.ws + ((NLAYER & 1) ? WS_SS1 : WS_SS0));
    const f32x4* gf = (const f32x4*)g_final + F.lane;
    f32x4 gv[4];
#pragma unroll
    for (int j = 0; j < 4; ++j) gv[j] = gf[64 * j];
    for (int m = gw; m < M; m += NGW) {
        const float rs = row_rs(SS, m);
        GAS f32x4* xr = (GAS f32x4*)(F.out + (size_t)m * D) + F.lane;
#pragma unroll
        for (int j = 0; j < 4; ++j) xr[64 * j] = xr[64 * j] * rs * gv[j];
    }
}

struct Args { const float* in[22]; float* out; unsigned char* ws; int ph_lo, ph_hi, li, pad; };
__global__ void __launch_bounds__(NWAVES * 64, 2) fwd_kernel(Args args) {
    extern __shared__ __attribute__((aligned(16))) unsigned char lds[];
    Frame F;
    F.lds = (LAS unsigned char*)lds;
    F.MISC = (volatile LAS unsigned*)(F.lds + MISC_OFF);
    F.tid = threadIdx.x; F.lane = F.tid & 63; F.wave = __builtin_amdgcn_readfirstlane(F.tid >> 6);
    F.G = gridDim.x; { const int bx = blockIdx.x; F.vcu = (F.G % 8 == 0) ? (bx % 8) * (F.G / 8) + bx / 8 : bx; }
    unsigned char* ws = args.ws; F.ws = ws; F.out = args.out;
    F.ctl = (gu32*)(ws + WS_CTL);
    for (int u = F.tid; u < (LDS_BYTES - LDSCTL_OFF) / 4; u += NWAVES * 64) ((LAS unsigned*)(F.lds + LDSCTL_OFF))[u] = 0u;
    __syncthreads();
    XcdBarrier bar; bar.bar = (unsigned*)(F.ctl + CW_BAR); bar.x = 0; bar.st = nullptr;
    if (!MK_PER_PHASE) bar = xcd_barrier_post((unsigned*)(F.ctl + CW_BAR), F.MISC + 8);

    bf16_t* WB = (bf16_t*)(ws + WS_WB);
    const int lo = args.ph_lo, hi = args.ph_hi;
    for (int p = lo; p < hi; ++p) {
        const int layer = p >> 3, k = p & 7;
        { int tv = threadIdx.x; asm volatile("" : "+v"(tv)); F.tid = tv; F.lane = tv & 63; F.wave = __builtin_amdgcn_readfirstlane(tv >> 6); }
        float* SSa = (float*)(ws + ((layer & 1) ? WS_SS1 : WS_SS0));
        float* SSb = (float*)(ws + ((layer & 1) ? WS_SS0 : WS_SS1));
#ifndef PHMASK
#define PHMASK 0x1ff
#endif
        if (p == N_PHASES - 1) { if (PHMASK & 0x100) final_phase(F, args.in[21]); }
        else if (k == 0) { if (PHMASK & 1) { const CvPtrs P{args.in[0], args.in[1], args.in[2], args.in[3], args.in[9], args.in[11], args.in[12], args.in[13], args.in[14], args.in[17], args.in[18], args.in[19], args.in[20]}; cv_phase(F, layer, P); } }
        else if (k == 1) { if (PHMASK & 2) {
#ifndef NO_EG
            {
                Gemm g{(const bf16_t*)(ws + WS_PB), WB + WB_WPL, PLE}; StaticOrder S; S.init(M / BM, D / BM, F.G, (int)blockIdx.x);
                EpiE E{(bf16_t*)(ws + WS_E)};
                gemm_phase<EpiE, StaticOrder, false, true, false>(F.lds + RING_OFF, g, S, E);
            }
#endif
#ifndef NO_IN
            {
                Gemm g{(const bf16_t*)(ws + (layer == 0 ? WS_XB : WS_XB2)), WB + WB_WIN, D}; StaticOrder S; S.init(M / BM, NIN / BM, F.G, (int)blockIdx.x);
                EpiIn E{SSa, args.in[4] + (size_t)layer * 2 * D, (bf16_t*)(ws + WS_AGLU), (bf16_t*)(ws + WS_CV), (bf16_t*)(ws + WS_BS), (bf16_t*)(ws + WS_GR), (bf16_t*)(ws + WS_GB)};
                gemm_phase<EpiIn, StaticOrder, true, true, false>(F.lds + RING_OFF, g, S, E);
            }
#endif
        } }
        else if (k == 2) { if (PHMASK & 4) co_phase(F, layer, args.in[5], args.in[6], args.in[7], args.in[8], args.in[10]); }
        else if (k == 3) { if (PHMASK & 8) {
            Gemm g{(const bf16_t*)(ws + WS_A2S), WB + WB_WAB, D}; StaticOrder S; S.init(M / BM, D / BM, F.G, (int)blockIdx.x);
            EpiMerge E{(const bf16_t*)(ws + WS_GR), (const bf16_t*)(ws + WS_GB), (bf16_t*)(ws + WS_MG)};
            gemm_phase<EpiMerge, StaticOrder, false, true, false>(F.lds + RING_OFF, g, S, E);
        } }
        else if (k == 4) { if (PHMASK & 16) {
            Gemm g{(const bf16_t*)(ws + WS_MG), WB + WB_WO, D}; StaticOrder S; S.init(M / BM, D / BM, F.G, (int)blockIdx.x);
            EpiRes<0> E{layer == 0 ? args.in[0] : (const float*)F.out, F.out, (bf16_t*)(ws + WS_XB), SSb, nullptr, nullptr};
            gemm_phase<EpiRes<0>, StaticOrder, false, true, false>(F.lds + RING_OFF, g, S, E);
        } }
        else if (k == 5) { if (PHMASK & 32) {
            Gemm g{(const bf16_t*)(ws + WS_XB) - 2 * D, WB + WB_WUP, D}; StaticOrder S; S.init(NT_UP, NUP / BM, F.G, (int)blockIdx.x);
            EpiUp E{SSb, args.in[15] + (size_t)layer * 3 * DFF, args.in[16] + (size_t)layer * DFF, (bf16_t*)(ws + WS_F)};
            gemm_phase<EpiUp, StaticOrder, true, true, true>(F.lds + RING_OFF, g, S, E);
        } }
        else if (k == 6) { if (PHMASK & 64) {
            Gemm g{(const bf16_t*)(ws + WS_F), WB + WB_WDN, DFF}; StaticOrder S; S.init(M / BM, D / BM, F.G, (int)blockIdx.x);
            EpiRes<0> E{(const float*)F.out, F.out, (bf16_t*)(ws + WS_XB), SSa, nullptr, nullptr};
            gemm_phase<EpiRes<0>, StaticOrder, false, true, false>(F.lds + RING_OFF, g, S, E);
        } }
        else { if (PHMASK & 128) {
            Gemm g{(const bf16_t*)(ws + WS_XB), WB + WB_WPG, D}; StaticOrder S; S.init(M / BM, D / BM, F.G, (int)blockIdx.x);
            EpiRes<1> E{(const float*)F.out, F.out, (bf16_t*)(ws + WS_XB2), SSb, SSa, (const bf16_t*)(ws + WS_E)};
            gemm_phase<EpiRes<1>, StaticOrder, false, true, false>(F.lds + RING_OFF, g, S, E);
        } }
        if (p + 1 < hi) xcd_barrier(bar);
    }
}

extern "C" void kernel_launch(void* const* d_in, const int* in_sizes, int n_in, void* d_out, int out_size, void* d_ws, size_t ws_size, hipStream_t stream) {
    static int grid = 0;
    if (grid == 0) {
        if (n_in != 22 || in_sizes[0] != M * D || out_size != M * D || ws_size < WS_END) { fprintf(stderr, "kernel_launch: built for 22 inputs, x and out of %d floats, >= %zu bytes of workspace; got n_in %d, in0 %d, out %d, ws %zu; nothing launched\n", M * D, (size_t)WS_END, n_in, n_in > 0 ? in_sizes[0] : -1, out_size, ws_size); grid = -1; return; }
        int dev = 0, cus = 0, per_cu = 0;
        if (hipGetDevice(&dev) != hipSuccess || hipDeviceGetAttribute(&cus, hipDeviceAttributeMultiprocessorCount, dev) != hipSuccess) { fprintf(stderr, "kernel_launch: hipGetDevice / hipDeviceGetAttribute failed; nothing launched\n"); grid = -1; return; }
        if (hipFuncSetAttribute((const void*)fwd_kernel, hipFuncAttributeMaxDynamicSharedMemorySize, LDS_BYTES) != hipSuccess) { fprintf(stderr, "kernel_launch: hipFuncSetAttribute failed\n"); grid = -1; return; }
        if (hipOccupancyMaxActiveBlocksPerMultiprocessor(&per_cu, (const void*)fwd_kernel, NWAVES * 64, LDS_BYTES) != hipSuccess || per_cu < 1)
            fprintf(stderr, "kernel_launch: note: the occupancy query reports %d workgroups per CU\n", per_cu);
        (void)hipGetLastError();
        grid = cus;
    }
    if (grid < 0) return;
    if (hipMemsetAsync((char*)d_ws + WS_CTL, 0, CTL_ZERO_BYTES, stream) != hipSuccess) { fprintf(stderr, "kernel_launch: hipMemsetAsync of the control words failed; nothing launched\n"); return; }
    Args a{};
    for (int i = 0; i < 22; ++i) a.in[i] = (const float*)d_in[i];
    a.out = (float*)d_out; a.ws = (unsigned char*)d_ws;
    const int nl = MK_PER_PHASE ? N_PHASES : 1;
    for (int li = 0; li < nl; ++li) {
        a.ph_lo = MK_PER_PHASE ? li : 0; a.ph_hi = MK_PER_PHASE ? li + 1 : N_PHASES; a.li = li;
        hipLaunchKernelGGL(fwd_kernel, dim3(grid), dim3(NWAVES * 64), LDS_BYTES, stream, a);
        const hipError_t le = hipPeekAtLastError();
        if (le != hipSuccess) { fprintf(stderr, "kernel_launch: launch %d failed: %s (grid %d x %d threads, %d B LDS)\n", li, hipGetErrorName(le), grid, NWAVES * 64, LDS_BYTES); break; }
    }
}
#endif
```

```cpp
#ifndef EMU
#include <hip/hip_runtime.h>
#include <cstdio>
#include <cstdint>
#define HD __host__ __device__ __forceinline__
#else
#include <cstdio>
#include <cstdint>
#include <cmath>
#include <cstring>
#define HD inline
#endif

#ifndef SEQ_LEN
#define SEQ_LEN 8192
#endif
constexpr int BATCH = 2, SEQ = SEQ_LEN, D = 1024, M = BATCH * SEQ;
constexpr int DC = 512, DSC = 512, NIN = 4608, DFF = 2816, NUP = 2 * DFF, PLE = 256, CKA = 31, NLAYER = 2;
constexpr float EPS = 1e-6f;
constexpr int NQ_UP = (M + 61) / 62;
constexpr int NT_UP = (NQ_UP + 3) / 4;

typedef unsigned short bf16_t;
typedef short bf16x8 __attribute__((ext_vector_type(8)));
typedef float f32x4 __attribute__((ext_vector_type(4)));
typedef float f32x2 __attribute__((ext_vector_type(2)));
typedef unsigned u32x4 __attribute__((ext_vector_type(4)));
typedef unsigned u32x2 __attribute__((ext_vector_type(2)));

HD float bits2f(unsigned u) { return __builtin_bit_cast(float, u); }
HD unsigned f2bits(float f) { return __builtin_bit_cast(unsigned, f); }
HD unsigned f2bf(float f) { unsigned u = f2bits(f); return (u + 0x7fffu + ((u >> 16) & 1u)) >> 16; }
HD unsigned pk2(float lo, float hi) {
#if defined(__HIP_DEVICE_COMPILE__)
    unsigned r; asm volatile("v_cvt_pk_bf16_f32 %0, %1, %2" : "=v"(r) : "v"(lo), "v"(hi)); return r;
#else
    return f2bf(lo) | (f2bf(hi) << 16);
#endif
}
HD float bf_lo(unsigned w) { return bits2f(w << 16); }
HD float bf_hi(unsigned w) { return bits2f(w & 0xffff0000u); }
HD float fexp2(float x) {
#if defined(__HIP_DEVICE_COMPILE__)
    return __builtin_amdgcn_exp2f(x);
#else
    return exp2f(x);
#endif
}
HD float frcp(float x) {
#if defined(__HIP_DEVICE_COMPILE__)
    return __builtin_amdgcn_rcpf(x);
#else
    return 1.0f / x;
#endif
}
HD float frsq(float x) {
#if defined(__HIP_DEVICE_COMPILE__)
    return __builtin_amdgcn_rsqf(x);
#else
    return 1.0f / sqrtf(x);
#endif
}
HD float sigm(float x) { return frcp(1.0f + fexp2(-1.44269504089f * x)); }
HD float gelu_tanh(float x) { const float y = x * (1.5957691216f + 0.0713548163f * x * x); return x * sigm(y); }
HD f32x4 sigm4(f32x4 v) { return (f32x4){sigm(v[0]), sigm(v[1]), sigm(v[2]), sigm(v[3])}; }
HD u32x4 pk8(f32x4 a, f32x4 b) { u32x4 w; w.x = pk2(a[0], a[1]); w.y = pk2(a[2], a[3]); w.z = pk2(b[0], b[1]); w.w = pk2(b[2], b[3]); return w; }
HD u32x2 pk4(f32x4 a) { u32x2 w; w.x = pk2(a[0], a[1]); w.y = pk2(a[2], a[3]); return w; }
HD f32x4 unpk_lo(u32x4 w) { return (f32x4){bf_lo(w.x), bf_hi(w.x), bf_lo(w.y), bf_hi(w.y)}; }
HD f32x4 unpk_hi(u32x4 w) { return (f32x4){bf_lo(w.z), bf_hi(w.z), bf_lo(w.w), bf_hi(w.w)}; }
HD f32x4 unpk4(u32x2 w) { return (f32x4){bf_lo(w.x), bf_hi(w.x), bf_lo(w.y), bf_hi(w.y)}; }
#if defined(__HIP_DEVICE_COMPILE__)
#define CFENCE() asm volatile("" ::: "memory")
#define LAUNDER(x) asm volatile("" : "+v"(x))
#else
#define CFENCE() do {} while (0)
#define LAUNDER(x) do {} while (0)
#endif
HD float hsum4(f32x4 a) { return (a[0] + a[1]) + (a[2] + a[3]); }

HD float row_rs(const float* SS, int g) {
    const f32x4* p = (const f32x4*)(SS + (size_t)g * 16);
    const f32x4 a = p[0], b = p[1], c = p[2], d = p[3];
    const float s = (hsum4(a) + hsum4(b)) + (hsum4(c) + hsum4(d));
    return frsq(s * (1.0f / (float)D) + EPS);
}

HD int win_dst(int s) {
    if (s < 512) return 256 * (s >> 7) + (s & 127);
    if (s < 1024) { const int c = s - 512; return 256 * (c >> 7) + 128 + (c & 127); }
    if (s < 1536) return 2048 + (s - 1024);
    if (s < 2048) { const int c = s - 1536; return 256 * (4 + (c >> 7)) + (c & 127); }
    if (s < 2560) { const int c = s - 2048; return 256 * (4 + (c >> 7)) + 128 + (c & 127); }
    if (s < 3584) { const int c = s - 2560; return 256 * (10 + (c >> 7)) + (c & 127); }
    { const int c = s - 3584; return 256 * (10 + (c >> 7)) + 128 + (c & 127); }
}
HD int wup_dst(int s) { if (s < DFF) return 256 * (s >> 7) + (s & 127); const int c = s - DFF; return 256 * (c >> 7) + 128 + (c & 127); }

constexpr int BM = 256, BK = 64, HALF = 128, HTB = HALF * BK * 2  , STAGE_BYTES = 8 * HTB, NXCD = 8, WGM = 8;
struct Unit { int pm, pn; };
struct Gemm { const bf16_t* A; const bf16_t* Bt; int K; };
struct StaticOrder {
    int nM, nN, nwg, G, c;
    HD void init(int nM_, int nN_, int G_, int c_) { nM = nM_; nN = nN_; nwg = nM * nN; G = G_; c = c_; }
    HD bool next(int i, Unit& u) const {
        const long L = (long)i * G + c; if (L >= nwg) return false;
        int wgid = (int)L; { const int q = nwg / NXCD, r = nwg % NXCD, xcd = wgid % NXCD, off = wgid / NXCD; wgid = (xcd < r ? xcd * (q + 1) : r * (q + 1) + (xcd - r) * q) + off; }
        const int nig = WGM * nN, gid = wgid / nig, fm = gid * WGM, gsz = (nM - fm) < WGM ? (nM - fm) : WGM;
        u.pm = fm + ((wgid % nig) % gsz); u.pn = (wgid % nig) / gsz; return true;
    }
    HD void a_ready(const Unit&) const {}
    HD void done(const Unit&) const {}
};

typedef f32x4 Acc[2][2][4][2];

struct EpiE {
    static constexpr bool PERM = true, AFTER_DRAIN = false, HAS_MID = false; static constexpr int MID_T = -1;
    bf16_t* E;
    template <class Sh> HD void operator()(const Acc& acc, const Unit& u, int wr, int wc, int fr, int fq, const Sh&) const {
        const int cb = u.pn * 256 + wc * 32 + 8 * fq;
#pragma unroll
        for (int ai = 0; ai < 2; ++ai)
#pragma unroll
            for (int m = 0; m < 4; ++m) { const int g = u.pm * 256 + ai * 128 + wr * 64 + m * 16 + fr; bf16_t* rowp = E + (size_t)g * D + cb;
#pragma unroll
                for (int bj = 0; bj < 2; ++bj) *(u32x4*)(rowp + bj * 128) = pk8(acc[ai][bj][m][0], acc[ai][bj][m][1]); }
    }
    template <class Sh> HD void mid(Acc&, const Unit&, int, int, int, int, const Sh&) const {}
};

struct EpiIn {
    static constexpr bool PERM = true, AFTER_DRAIN = false, HAS_MID = false; static constexpr int MID_T = -1;
    const float* SS; const float* bgate; bf16_t *AGLU, *CV, *BS, *GR, *GB;
    template <class Sh> HD void operator()(const Acc& acc, const Unit& u, int wr, int wc, int fr, int fq, const Sh&) const {
        const int cb = wc * 32 + 8 * fq;
        const int pn = u.pn, grow = u.pm * 256 + wr * 64 + fr;
        if (pn < 4) {
#pragma unroll
            for (int ai = 0; ai < 2; ++ai)
#pragma unroll
                for (int m = 0; m < 4; ++m) { const int g = grow + ai * 128 + m * 16; const float rs = row_rs(SS, g);
                    *(u32x4*)(AGLU + (size_t)g * DC + pn * 128 + cb) = pk8((acc[ai][0][m][0] * rs) * sigm4(acc[ai][1][m][0] * rs), (acc[ai][0][m][1] * rs) * sigm4(acc[ai][1][m][1] * rs)); CFENCE(); }
        } else if (pn < 8) {
#pragma unroll
            for (int ai = 0; ai < 2; ++ai)
#pragma unroll
                for (int m = 0; m < 4; ++m) { const int g = grow + ai * 128 + m * 16; const float rs = row_rs(SS, g), r2 = rs * rs;
                    *(u32x4*)(CV + (size_t)g * DSC + (pn - 4) * 128 + cb) = pk8(acc[ai][0][m][0] * acc[ai][1][m][0] * r2, acc[ai][0][m][1] * acc[ai][1][m][1] * r2); CFENCE(); }
        } else if (pn < 10) {
#pragma unroll
            for (int ai = 0; ai < 2; ++ai)
#pragma unroll
                for (int m = 0; m < 4; ++m) { const int g = grow + ai * 128 + m * 16; const float rs = row_rs(SS, g);
                    bf16_t* rowp = BS + (size_t)g * DSC + (pn - 8) * 256 + cb;
                    *(u32x4*)rowp = pk8(acc[ai][0][m][0] * rs, acc[ai][0][m][1] * rs); *(u32x4*)(rowp + 128) = pk8(acc[ai][1][m][0] * rs, acc[ai][1][m][1] * rs); CFENCE(); }
        } else {
            const int t = pn - 10; const float* pa = bgate + t * 128 + cb; const float* pb = bgate + D + t * 128 + cb;
            const f32x4 ba0 = *(const f32x4*)pa, ba1 = *(const f32x4*)(pa + 4), bb0 = *(const f32x4*)pb, bb1 = *(const f32x4*)(pb + 4);
#pragma unroll
            for (int ai = 0; ai < 2; ++ai)
#pragma unroll
                for (int m = 0; m < 4; ++m) { const int g = grow + ai * 128 + m * 16; const float rs = row_rs(SS, g);
                    const size_t o = (size_t)g * D + t * 128 + cb;
                    const f32x4 la0 = acc[ai][0][m][0] * rs + ba0, la1 = acc[ai][0][m][1] * rs + ba1, lb0 = acc[ai][1][m][0] * rs + bb0, lb1 = acc[ai][1][m][1] * rs + bb1;
                    f32x4 r0, r1, g0, g1;
#pragma unroll
                    for (int j = 0; j < 4; ++j) {
                        const float ea0 = fexp2(-1.44269504089f * la0[j]), eb0 = fexp2(-1.44269504089f * lb0[j]), ea1 = fexp2(-1.44269504089f * la1[j]), eb1 = fexp2(-1.44269504089f * lb1[j]);
                        g0[j] = frcp(1.0f + eb0); r0[j] = (1.0f + eb0) * frcp(1.0f + ea0); g1[j] = frcp(1.0f + eb1); r1[j] = (1.0f + eb1) * frcp(1.0f + ea1); }
                    *(u32x4*)(GR + o) = pk8(r0, r1); *(u32x4*)(GB + o) = pk8(g0, g1); CFENCE(); }
        }
    }
    template <class Sh> HD void mid(Acc&, const Unit&, int, int, int, int, const Sh&) const {}
};

struct EpiMerge {
    static constexpr bool PERM = true, AFTER_DRAIN = false, HAS_MID = true; static constexpr int MID_T = 8;
    const bf16_t *GR, *GB; bf16_t* MG;
    template <class Sh> HD void mid(Acc& acc, const Unit& u, int wr, int wc, int fr, int fq, const Sh&) const {
        LAUNDER(fr); LAUNDER(fq);
        const int cb = u.pn * 256 + wc * 32 + 8 * fq;
#pragma unroll
        for (int ai = 0; ai < 2; ++ai)
#pragma unroll
            for (int m = 0; m < 4; ++m) { const int g = u.pm * 256 + ai * 128 + wr * 64 + m * 16 + fr; const bf16_t* rowp = GR + (size_t)g * D + cb;
#pragma unroll
                for (int bj = 0; bj < 2; ++bj) { const u32x4 w = *(const u32x4*)(rowp + bj * 128); acc[ai][bj][m][0] *= unpk_lo(w); acc[ai][bj][m][1] *= unpk_hi(w); CFENCE(); } }
    }
    template <class Sh> HD void operator()(const Acc& acc, const Unit& u, int wr, int wc, int fr, int fq, const Sh&) const {
        const int cb = u.pn * 256 + wc * 32 + 8 * fq;
#pragma unroll
        for (int ai = 0; ai < 2; ++ai)
#pragma unroll
            for (int m = 0; m < 4; ++m) { const int g = u.pm * 256 + ai * 128 + wr * 64 + m * 16 + fr; const size_t o = (size_t)g * D + cb;
#pragma unroll
                for (int bj = 0; bj < 2; ++bj) { const u32x4 w = *(const u32x4*)(GB + o + bj * 128);
                    *(u32x4*)(MG + o + bj * 128) = pk8(acc[ai][bj][m][0] * unpk_lo(w), acc[ai][bj][m][1] * unpk_hi(w)); } CFENCE(); }
    }
};

template <int MODE> struct EpiRes {
    static constexpr bool PERM = false, AFTER_DRAIN = false, HAS_MID = false; static constexpr int MID_T = -1;
    const float* xin; float* xout; bf16_t* xb; float* ssout; const float* ssin; const bf16_t* E;
    template <class Sh> HD void operator()(const Acc& acc, const Unit& u, int wr, int wc, int fr, int fq, const Sh& sh) const {
        const int c4 = u.pn * 256 + wc * 32 + 4 * fq; const int lane = fq * 16 + fr;
#pragma unroll
        for (int ai = 0; ai < 2; ++ai)
#pragma unroll
            for (int m = 0; m < 4; ++m) {
                const int g = u.pm * 256 + ai * 128 + wr * 64 + m * 16 + fr; const size_t o = (size_t)g * D + c4;
                float rs = 1.0f; if (MODE == 1) rs = row_rs(ssin, g);
                float sq = 0.f;
#pragma unroll
                for (int bj = 0; bj < 2; ++bj)
#pragma unroll
                    for (int n = 0; n < 2; ++n) { const size_t oo = o + bj * 128 + n * 16;
                        f32x4 v = acc[ai][bj][m][n];
                        if (MODE == 1) { const f32x4 e = unpk4(*(const u32x2*)(E + oo)); v = sigm4(v * rs) * e; }
                        const f32x4 xn = *(const f32x4*)(xin + oo) + v;
                        *(f32x4*)(xout + oo) = xn; *(u32x2*)(xb + oo) = pk4(xn);
                        sq += (xn[0] * xn[0] + xn[1] * xn[1]) + (xn[2] * xn[2] + xn[3] * xn[3]); }
                sq += sh(sq, lane ^ 16); sq += sh(sq, lane ^ 32);
                if (fq == 0) ssout[(size_t)g * 16 + u.pn * 4 + wc] = sq;
            }
    }
    template <class Sh> HD void mid(Acc&, const Unit&, int, int, int, int, const Sh&) const {}
};

struct EpiUp {
    static constexpr bool PERM = true, AFTER_DRAIN = false, HAS_MID = false; static constexpr int MID_T = -1;
    const float* SS; const float* cw; const float* cb_; bf16_t* F;
    template <class Sh> HD void operator()(const Acc& acc, const Unit& u, int wr, int wc, int fr, int fq, const Sh& sh) const {
        const int ch = u.pn * 128 + wc * 32 + 8 * fq;
        const int lane = fq * 16 + fr;
        const f32x4 w0a = *(const f32x4*)(cw + ch), w0b = *(const f32x4*)(cw + ch + 4), w1a = *(const f32x4*)(cw + DFF + ch), w1b = *(const f32x4*)(cw + DFF + ch + 4);
        const f32x4 w2a = *(const f32x4*)(cw + 2 * DFF + ch), w2b = *(const f32x4*)(cw + 2 * DFF + ch + 4), bia = *(const f32x4*)(cb_ + ch), bib = *(const f32x4*)(cb_ + ch + 4);
        const int s1 = (lane & 48) | ((fr + 15) & 15), s2 = (lane & 48) | ((fr + 14) & 15);
#pragma unroll
        for (int ai = 0; ai < 2; ++ai) {
            const int q = 4 * u.pm + 2 * ai + wr;
            f32x4 pa = {0.f, 0.f, 0.f, 0.f}, pb = pa;
#pragma unroll
            for (int m = 0; m < 4; ++m) {
                const int rho = m * 16 + fr, g = 62 * q - 2 + rho; const int gc = g < 0 ? 0 : (g > M - 1 ? M - 1 : g);
                const float rs = row_rs(SS, gc);
                const f32x4 ga = acc[ai][0][m][0] * rs, gb = acc[ai][0][m][1] * rs, va = acc[ai][1][m][0] * rs, vb = acc[ai][1][m][1] * rs;
                f32x4 t1a, t1b, t2a, t2b;
#pragma unroll
                for (int j = 0; j < 4; ++j) {
                    const float c1a = sh(ga[j], s1), c1b = sh(gb[j], s1), c2a = sh(ga[j], s2), c2b = sh(gb[j], s2);
                    const float p1a = sh(pa[j], s1), p1b = sh(pb[j], s1), p2a = sh(pa[j], s2), p2b = sh(pb[j], s2);
                    t1a[j] = fr >= 1 ? c1a : p1a; t1b[j] = fr >= 1 ? c1b : p1b; t2a[j] = fr >= 2 ? c2a : p2a; t2b[j] = fr >= 2 ? c2b : p2b;
                }
                pa = ga; pb = gb;
                const int t = gc % SEQ;
                if (t < 1) { t1a = (f32x4){0.f, 0.f, 0.f, 0.f}; t1b = t1a; }
                if (t < 2) { t2a = (f32x4){0.f, 0.f, 0.f, 0.f}; t2b = t2a; }
                const f32x4 fa = w2a * ga + w1a * t1a + w0a * t2a + bia, fb = w2b * gb + w1b * t1b + w0b * t2b + bib;
                f32x4 oa, ob;
#pragma unroll
                for (int j = 0; j < 4; ++j) { oa[j] = gelu_tanh(fa[j]) * va[j]; ob[j] = gelu_tanh(fb[j]) * vb[j]; }
                if (rho >= 2 && g < M) *(u32x4*)(F + (size_t)g * DFF + ch) = pk8(oa, ob);
            }
        }
    }
    template <class Sh> HD void mid(Acc&, const Unit&, int, int, int, int, const Sh&) const {}
};

#ifndef EMU
#define PG8_LAS __attribute__((address_space(3)))
#define GAS __attribute__((address_space(1)))
#define LAS __attribute__((address_space(3)))
typedef GAS unsigned gu32;
#define RLX_AGENT __ATOMIC_RELAXED, __HIP_MEMORY_SCOPE_AGENT
#define LDS_WAIT() asm volatile("s_waitcnt lgkmcnt(0)" ::: "memory")
#define VM_WAIT() asm volatile("s_waitcnt vmcnt(0)" ::: "memory")
struct ShflDev { __device__ __forceinline__ float operator()(float v, int src) const { return __shfl(v, src, 64); } };

__host__ __device__ __forceinline__ int lds_byte(int r, int c) { const int st = (r >> 4) * 2 + (c >> 5), rr = r & 15, cc = c & 31, ob = rr * 64 + cc * 2; return st * 1024 + (ob ^ (((ob >> 9) & 1) << 5)); }
__host__ __device__ __forceinline__ void stage_rc(int b, int& R, int& C) { const int st = b / 1024, sb = b % 1024, swz = sb ^ (((sb >> 9) & 1) << 5); R = (st >> 1) * 16 + swz / 64; C = (st & 1) * 32 + (swz % 64) / 2; }
__host__ __device__ __forceinline__ int perm32(int rho) { const int n = rho >> 4, i = rho & 15; return 8 * (i >> 2) + 4 * n + (i & 3); }

template <class Epi, class Sched, bool ALIGN_EPI = false, bool SP2 = false, bool ACHUNK = false>
__device__ __forceinline__ void gemm_phase(PG8_LAS unsigned char* lds, const Gemm g, const Sched& S, const Epi& E) {
    int tid_ = threadIdx.x; asm volatile("" : "+v"(tid_));
    const int tid = tid_, wid = __builtin_amdgcn_readfirstlane(tid >> 6), lane = tid & 63, wr = wid >> 2, wc = wid & 3, fr = lane & 15, fq = lane >> 4;
    int K_ = g.K; asm volatile("" : "+s"(K_));
    const int K = K_, nt = K / BK;
    unsigned voffA[2], voffB[2];
#pragma unroll
    for (int i = 0; i < 2; ++i) { int R, C; stage_rc(tid * 16 + i * 8192, R, C); const int Rb = Epi::PERM ? ((R & ~31) + perm32(R & 31)) : R;
        const int Ra = ACHUNK ? ((R >> 6) * 62 + (R & 63)) : R; voffA[i] = (unsigned)(Ra * K + C) * 2u; voffB[i] = (unsigned)(Rb * K + C) * 2u; }
    const size_t kstep = (size_t)(BK * 2);
    const size_t hstepB = (size_t)HALF * K * 2, hstepA = ACHUNK ? (size_t)124 * K * 2 : hstepB;
    const size_t tstepA = 2 * hstepA, tstepB = 2 * hstepB;
    const unsigned ldsw = (unsigned)wid * 1024u;
    const int aoff = lds_byte(wr * 64 + fr, fq * 8), boff = lds_byte(wc * 32 + fr, fq * 8);
#define PG8_SA(b, h) (((b) * 2 + (h)) * HTB)
#define PG8_SB(b, h) ((4 + (b) * 2 + (h)) * HTB)
#define PG8_STAGE(bufoff, gbase, voff) do { _Pragma("unroll") for (int _i = 0; _i < 2; ++_i) \
        __builtin_amdgcn_global_load_lds((const unsigned*)((const char*)(gbase) + (voff)[_i]), (PG8_LAS unsigned*)(lds + (bufoff) + ldsw + _i * 8192), 16, 0, 0); } while (0)
#define PG8_LDA(dst, b, h) do { _Pragma("unroll") for (int m = 0; m < 4; ++m) _Pragma("unroll") for (int k = 0; k < 2; ++k) dst[m][k] = *(const PG8_LAS bf16x8*)(lds + PG8_SA(b, h) + aoff + m * 2048 + k * 1024); } while (0)
#define PG8_LDB(dst, b, h) do { _Pragma("unroll") for (int n = 0; n < 2; ++n) _Pragma("unroll") for (int k = 0; k < 2; ++k) dst[n][k] = *(const PG8_LAS bf16x8*)(lds + PG8_SB(b, h) + boff + n * 2048 + k * 1024); } while (0)
#define PG8_MMA(ai, bj, At, Bt) do { __builtin_amdgcn_s_setprio(1); _Pragma("unroll") for (int m = 0; m < 4; ++m) _Pragma("unroll") for (int n = 0; n < 2; ++n) _Pragma("unroll") for (int k = 0; k < 2; ++k) \
        acc[ai][bj][m][n] = __builtin_amdgcn_mfma_f32_16x16x32_bf16(Bt[n][k], At[m][k], acc[ai][bj][m][n], 0, 0, 0); __builtin_amdgcn_s_setprio(0); } while (0)
#define PG8_WAIT_V(n) asm volatile("s_waitcnt vmcnt(" #n ")" ::: "memory")
#define PG8_WAIT_L(n) asm volatile("s_waitcnt lgkmcnt(" #n ")" ::: "memory")
#define PG8_BAR __builtin_amdgcn_s_barrier()
#define PG8_SCHED __builtin_amdgcn_sched_barrier(0)
    Unit cur, nxt; int ui = 0;
    if (!S.next(0, cur)) return;
    f32x4 acc[2][2][4][2];
#pragma unroll
    for (int a = 0; a < 2; ++a)
#pragma unroll
        for (int b = 0; b < 2; ++b)
#pragma unroll
            for (int m = 0; m < 4; ++m)
#pragma unroll
                for (int n = 0; n < 2; ++n) acc[a][b][m][n] = (f32x4){0.f, 0.f, 0.f, 0.f};
    bf16x8 At[4][2], B0[2][2], B1[2][2];
    const char* cA = (const char*)g.A + (size_t)cur.pm * tstepA; const char* cB = (const char*)g.Bt + (size_t)cur.pn * tstepB;
    S.a_ready(cur);
    if constexpr (SP2) {
        PG8_STAGE(PG8_SB(0, 0), cB, voffB); PG8_STAGE(PG8_SB(0, 1), cB + hstepB, voffB); PG8_STAGE(PG8_SA(0, 0), cA, voffA); PG8_STAGE(PG8_SA(0, 1), cA + hstepA, voffA);
        if (wr == 1) PG8_BAR;
        PG8_WAIT_V(2); PG8_BAR;
        PG8_STAGE(PG8_SB(1, 0), cB + kstep, voffB); PG8_STAGE(PG8_SA(1, 0), cA + kstep, voffA); PG8_STAGE(PG8_SB(1, 1), cB + hstepB + kstep, voffB);
        PG8_WAIT_V(6); PG8_BAR;
    } else {
        PG8_STAGE(PG8_SB(0, 0), cB, voffB); PG8_STAGE(PG8_SA(0, 0), cA, voffA); PG8_STAGE(PG8_SB(0, 1), cB + hstepB, voffB); PG8_STAGE(PG8_SA(0, 1), cA + hstepA, voffA);
        if (wr == 1) PG8_BAR;
        PG8_WAIT_V(4); PG8_BAR;
        PG8_STAGE(PG8_SB(1, 0), cB + kstep, voffB); PG8_STAGE(PG8_SA(1, 0), cA + kstep, voffA); PG8_STAGE(PG8_SB(1, 1), cB + hstepB + kstep, voffB);
        PG8_WAIT_V(6); PG8_BAR;
    }
    for (;;) {
        const bool has_next = S.next(ui + 1, nxt);
        const char* nA = has_next ? (const char*)g.A + (size_t)nxt.pm * tstepA : cA; const char* nB = has_next ? (const char*)g.Bt + (size_t)nxt.pn * tstepB : cB;
        for (int t = 0; t < nt; t += 2) {
            const bool last = (t == nt - 2);
            if constexpr (Epi::HAS_MID) { if (t == Epi::MID_T) E.mid(acc, cur, wr, wc, fr, fq, ShflDev{}); }
            const char* a1 = cA + (size_t)(t + 1) * kstep;
            const char* a2 = last ? nA : cA + (size_t)(t + 2) * kstep; const char* b2 = last ? nB : cB + (size_t)(t + 2) * kstep;
            const char* a3 = a2 + kstep; const char* b3 = b2 + kstep;
            if (last && has_next) S.a_ready(nxt);
            if constexpr (SP2) {
            PG8_LDB(B0, 0, 0); PG8_LDB(B1, 0, 1); PG8_SCHED; PG8_LDA(At, 0, 0); PG8_STAGE(PG8_SA(1, 1), a1 + hstepA, voffA);
            PG8_WAIT_V(8); PG8_WAIT_L(0); PG8_BAR; PG8_MMA(0, 0, At, B0); PG8_MMA(0, 1, At, B1); PG8_BAR; PG8_SCHED;
            PG8_LDA(At, 0, 1); PG8_STAGE(PG8_SB(0, 0), b2, voffB); PG8_STAGE(PG8_SB(0, 1), b2 + hstepB, voffB); PG8_STAGE(PG8_SA(0, 0), a2, voffA);
            PG8_WAIT_V(8); PG8_WAIT_L(0); PG8_BAR; PG8_MMA(1, 0, At, B0); PG8_MMA(1, 1, At, B1); PG8_BAR; PG8_SCHED;
            PG8_LDB(B0, 1, 0); PG8_LDB(B1, 1, 1); PG8_SCHED; PG8_LDA(At, 1, 0); PG8_STAGE(PG8_SA(0, 1), a2 + hstepA, voffA);
            PG8_WAIT_V(8); PG8_WAIT_L(0); PG8_BAR; PG8_MMA(0, 0, At, B0); PG8_MMA(0, 1, At, B1); PG8_BAR; PG8_SCHED;
            PG8_LDA(At, 1, 1); PG8_STAGE(PG8_SB(1, 0), b3, voffB); PG8_STAGE(PG8_SB(1, 1), b3 + hstepB, voffB); PG8_STAGE(PG8_SA(1, 0), a3, voffA);
            PG8_WAIT_V(8); PG8_WAIT_L(0); PG8_BAR; PG8_MMA(1, 0, At, B0); PG8_MMA(1, 1, At, B1); PG8_BAR; PG8_SCHED;
            } else {
            PG8_LDB(B0, 0, 0); PG8_SCHED; PG8_LDA(At, 0, 0); PG8_STAGE(PG8_SA(1, 1), a1 + hstepA, voffA);
            PG8_WAIT_L(8); PG8_BAR; PG8_WAIT_L(0); PG8_MMA(0, 0, At, B0); PG8_BAR; PG8_SCHED;
            PG8_LDB(B1, 0, 1); PG8_STAGE(PG8_SB(0, 0), b2, voffB);
            PG8_BAR; PG8_WAIT_L(0); PG8_MMA(0, 1, At, B1); PG8_BAR;
            PG8_LDA(At, 0, 1); PG8_STAGE(PG8_SA(0, 0), a2, voffA);
            PG8_BAR; PG8_WAIT_L(0); PG8_MMA(1, 0, At, B0); PG8_BAR; PG8_SCHED;
            PG8_STAGE(PG8_SB(0, 1), b2 + hstepB, voffB);
            PG8_WAIT_V(6); PG8_BAR; PG8_MMA(1, 1, At, B1); PG8_BAR;
            PG8_LDB(B0, 1, 0); PG8_SCHED; PG8_LDA(At, 1, 0); PG8_STAGE(PG8_SA(0, 1), a2 + hstepA, voffA);
            PG8_WAIT_L(8); PG8_BAR; PG8_WAIT_L(0); PG8_MMA(0, 0, At, B0); PG8_BAR; PG8_SCHED;
            PG8_LDB(B1, 1, 1); PG8_STAGE(PG8_SB(1, 0), b3, voffB);
            PG8_BAR; PG8_WAIT_L(0); PG8_MMA(0, 1, At, B1); PG8_BAR;
            PG8_LDA(At, 1, 1); PG8_STAGE(PG8_SA(1, 0), a3, voffA);
            PG8_BAR; PG8_WAIT_L(0); PG8_MMA(1, 0, At, B0); PG8_BAR; PG8_SCHED;
            PG8_STAGE(PG8_SB(1, 1), b3 + hstepB, voffB);
            PG8_WAIT_V(6); PG8_BAR; PG8_MMA(1, 1, At, B1); PG8_BAR;
            }
        }
        if constexpr (ALIGN_EPI) { if (wr == 0) PG8_BAR; }
        if constexpr (!Epi::AFTER_DRAIN) { E(acc, cur, wr, wc, fr, fq, ShflDev{}); S.done(cur); }
        if (!has_next) break;
#pragma unroll
        for (int a = 0; a < 2; ++a)
#pragma unroll
            for (int b = 0; b < 2; ++b)
#pragma unroll
                for (int m = 0; m < 4; ++m)
#pragma unroll
                    for (int n = 0; n < 2; ++n) acc[a][b][m][n] = (f32x4){0.f, 0.f, 0.f, 0.f};
        cur = nxt; cA = nA; cB = nB; ++ui;
        if constexpr (ALIGN_EPI) { if (wr == 1) PG8_BAR; }
    }
    PG8_WAIT_V(0);
    if constexpr (!ALIGN_EPI) { if (wr == 0) PG8_BAR; }
    PG8_BAR;
#undef PG8_SA
#undef PG8_SB
#undef PG8_STAGE
#undef PG8_LDA
#undef PG8_LDB
#undef PG8_MMA
#undef PG8_WAIT_V
#undef PG8_WAIT_L
#undef PG8_BAR
#undef PG8_SCHED
}

constexpr int NWAVES = 8;
#ifndef MK_PER_PHASE
#define MK_PER_PHASE 0
#endif
constexpr int N_PHASES = 8 * NLAYER + 1;

constexpr size_t MiB = 1u << 20;
constexpr size_t WS_CTL = 0, CTL_ZERO_BYTES = 64 * 1024;
constexpr size_t WS_SS0 = 1 * MiB, WS_SS1 = 2 * MiB;
constexpr size_t WS_WB = 3 * MiB;
constexpr size_t WB_WIN = 0, WB_WAB = WB_WIN + (size_t)NIN * D, WB_WO = WB_WAB + (size_t)D * D, WB_WUP = WB_WO + (size_t)D * D, WB_WDN = WB_WUP + (size_t)NUP * D,
                 WB_WPG = WB_WDN + (size_t)D * DFF, WB_WPL = WB_WPG + (size_t)D * D, WB_END = WB_WPL + (size_t)D * PLE;
static_assert(WB_END * 2 == 32 * MiB, "weight copies fill 32 MiB");
constexpr size_t WS_PB = 35 * MiB;
constexpr size_t WS_XB = 44 * MiB;
constexpr size_t WS_ACT = 77 * MiB;
constexpr size_t WS_AGLU = WS_ACT, WS_CV = WS_ACT + 16 * MiB, WS_BS = WS_ACT + 32 * MiB, WS_GR = WS_ACT + 48 * MiB, WS_GB = WS_ACT + 80 * MiB,
                 WS_A2S = WS_ACT + 112 * MiB, WS_E = WS_ACT + 144 * MiB, WS_END = WS_ACT + 176 * MiB;
constexpr size_t WS_MG = WS_AGLU;
constexpr size_t WS_F = WS_ACT;
constexpr size_t WS_XB2 = WS_A2S;
static_assert(WS_END <= 256 * MiB && WS_F + (size_t)M * DFF * 2 <= WS_A2S && WS_XB + (size_t)(M + 256) * D * 2 <= WS_ACT, "d_ws map");
constexpr int CW_BAR = 4096;

constexpr int RING_OFF = 0, RING_BYTES = 131072;
constexpr int LDSCTL_OFF = RING_BYTES, MISC_OFF = LDSCTL_OFF + 320;
constexpr int LDS_BYTES = 147456;
static_assert(MISC_OFF + 128 <= LDS_BYTES, "LDS map");

#define XB_TMO      128
#define XB_XCNT(j)  (256  + 64 * (j))
#define XB_XSUB(j)  (1280 + 64 * (j))
#define XB_XGEN(j)  (2304 + 64 * (j))
#define XB_TOP      3328
#define XB_TOPGEN   3392
#define XCD_BAR_WORDS 3456
#define XB_SPIN_CAP (1u << 18)

__device__ __forceinline__ unsigned xb_ld(unsigned* p)              { return __hip_atomic_load(p, __ATOMIC_RELAXED, __HIP_MEMORY_SCOPE_AGENT); }
__device__ __forceinline__ unsigned xb_add(unsigned* p, unsigned v) { return __hip_atomic_fetch_add(p, v, __ATOMIC_RELAXED, __HIP_MEMORY_SCOPE_AGENT); }
__device__ __forceinline__ unsigned xb_xcc_id() { return (unsigned)__builtin_amdgcn_s_getreg((3 << 11) | 20) & 0xFu; }
#define XB_SPIN(cond, bar) do { unsigned _sp = 0; while (cond) { __builtin_amdgcn_s_sleep(1); \
    if ((++_sp & 255u) == 0u) { if (xb_ld(&(bar)[XB_TMO])) break; if (_sp > XB_SPIN_CAP) { atomicAdd(&(bar)[XB_TMO], 1u); break; } } } } while (0)

struct XcdBarrier {
    unsigned* bar; unsigned x;
    volatile LAS unsigned* st;
};

__device__ __forceinline__ XcdBarrier xcd_barrier_post(unsigned* bar, volatile LAS unsigned* st) {
    XcdBarrier b; b.bar = bar; b.x = xb_xcc_id(); b.st = st;
    if (threadIdx.x == 0) (void)xb_add(&bar[XB_XCNT(b.x)], 1u);
    return b;
}
__device__ __forceinline__ void xcd_barrier_complete(unsigned* bar, unsigned x, unsigned& nloc, unsigned& nx) {
    const unsigned G = gridDim.x * gridDim.y * gridDim.z;
    unsigned sum, cnt, mine, sp = 0u;
    for (;;) {
        sum = 0u; cnt = 0u; mine = 0u;
#pragma unroll
        for (unsigned j = 0; j < 16; ++j) { const unsigned c = xb_ld(&bar[XB_XCNT(j)]); sum += c; cnt += (c > 0u) ? 1u : 0u; mine = (j == x) ? c : mine; }
        if (sum == G) break;
        __builtin_amdgcn_s_sleep(1);
        if ((++sp & 255u) == 0u) { if (xb_ld(&bar[XB_TMO])) break; if (sp > XB_SPIN_CAP) { atomicAdd(&bar[XB_TMO], 1u); break; } }
    }
    nloc = mine > 0u ? mine : 1u; nx = cnt > 0u ? cnt : 1u;
}

__device__ __forceinline__ void xcd_barrier(const XcdBarrier& b) {
    asm volatile("s_waitcnt vmcnt(0)" ::: "memory");
    __syncthreads();
    if (threadIdx.x == 0) {
        unsigned* bar = b.bar;
        __builtin_amdgcn_s_waitcnt(0);
        unsigned nloc = b.st[0], nx = b.st[1];
        if (nloc == 0u) { xcd_barrier_complete(bar, b.x, nloc, nx); b.st[0] = nloc; b.st[1] = nx; }
        const unsigned old = xb_add(&bar[XB_XSUB(b.x)], 1u);
        const unsigned gen = old / nloc;
        if (old + 1u == (gen + 1u) * nloc) {
            __builtin_amdgcn_fence(__ATOMIC_RELEASE, "agent");
            asm volatile("s_waitcnt vmcnt(0)" ::: "memory");
            const unsigned og = xb_add(&bar[XB_TOP], 1u);
            const unsigned tg = og / nx;
            if (og + 1u == (tg + 1u) * nx) xb_add(&bar[XB_TOPGEN], 1u);
            else XB_SPIN(xb_ld(&bar[XB_TOPGEN]) == tg, bar);
            __builtin_amdgcn_fence(__ATOMIC_ACQUIRE, "agent");
            xb_add(&bar[XB_XGEN(b.x)], 1u);
            asm volatile("s_waitcnt vmcnt(0)" ::: "memory");
        } else {
            XB_SPIN(xb_ld(&bar[XB_XGEN(b.x)]) == gen, bar);
            __builtin_amdgcn_fence(__ATOMIC_ACQUIRE, "agent");
            asm volatile("s_waitcnt vmcnt(0)" ::: "memory");
        }
    }
    __syncthreads();
}

struct Frame {
    LAS unsigned char* lds;
    volatile LAS unsigned* MISC;
    gu32* ctl;
    int tid, lane, wave;
    int vcu, G;
    float* out; unsigned char* ws;
};
__device__ __forceinline__ float wave_sum(float v) {
#pragma unroll
    for (int o = 1; o < 64; o <<= 1) v += __shfl_xor(v, o, 64);
    return v;
}

__device__ __forceinline__ void cv_item(const float* W, int N, const float* gk, bf16_t* WT, int ldt, int kofs, int drow, int kb, int nb, LAS float* scr, int lane) {
    const int k0 = 64 * kb, n0 = 32 * nb;
#pragma unroll 8
    for (int i = 0; i < 32; ++i) { const int kk = 2 * i + (lane >> 5); float v = W[(size_t)(k0 + kk) * N + n0 + (lane & 31)]; if (gk) v *= gk[k0 + kk]; scr[kk * 33 + (lane & 31)] = v; }
    LDS_WAIT(); asm volatile("" ::: "memory");
    const int c = lane & 7;
#pragma unroll
    for (int j = 0; j < 4; ++j) { const int n = (lane >> 3) + 8 * j; const LAS float* s = scr + (8 * c) * 33 + n;
        u32x4 o; o.x = pk2(s[0 * 33], s[1 * 33]); o.y = pk2(s[2 * 33], s[3 * 33]); o.z = pk2(s[4 * 33], s[5 * 33]); o.w = pk2(s[6 * 33], s[7 * 33]);
        *(GAS u32x4*)(WT + (size_t)(drow + n) * ldt + kofs + k0 + 8 * c) = o; }
    LDS_WAIT(); asm volatile("" ::: "memory");
}
struct CvPtrs { const float *x, *p, *g_mix, *w_in, *w_a, *w_b, *w_o, *g_ffn, *w_up, *w_dn, *g_ple, *w_pl, *w_pg; };
__device__ __forceinline__ void cv_phase(Frame& F, int layer, const CvPtrs& P) {
    LAS float* scr = (LAS float*)(F.lds + RING_OFF + F.wave * 16384);
    const int gw = F.vcu * NWAVES + F.wave, NGW = F.G * NWAVES;
    bf16_t* WB = (bf16_t*)(F.ws + WS_WB);
    const float* w_in = P.w_in + (size_t)layer * D * NIN;      const float* g_mix = P.g_mix + layer * D;
    const float* w_a = P.w_a + (size_t)layer * DC * D;          const float* w_b = P.w_b + (size_t)layer * DSC * D;
    const float* w_o = P.w_o + (size_t)layer * D * D;           const float* g_ffn = P.g_ffn + layer * D;
    const float* w_up = P.w_up + (size_t)layer * D * NUP;       const float* w_dn = P.w_dn + (size_t)layer * DFF * D;
    const float* g_ple = P.g_ple + layer * D;                   const float* w_pl = P.w_pl + (size_t)layer * PLE * D;
    const float* w_pg = P.w_pg + (size_t)layer * D * D;
    constexpr int I_IN = (D / 64) * (NIN / 32), I_A = (DC / 64) * (D / 32), I_O = (D / 64) * (D / 32), I_UP = (D / 64) * (NUP / 32), I_DN = (DFF / 64) * (D / 32), I_PL = (PLE / 64) * (D / 32);
    constexpr int NITEMS = I_IN + 2 * I_A + I_O + I_UP + I_DN + I_O + I_PL;
    for (int it = gw; it < NITEMS; it += NGW) {
        int r = it;
        if (r < I_IN) { const int nblk = NIN / 32, kb = r / nblk, nb = r % nblk; cv_item(w_in, NIN, g_mix, WB + WB_WIN, D, 0, win_dst(32 * nb), kb, nb, scr, F.lane); continue; } r -= I_IN;
        if (r < I_A)  { const int nblk = D / 32, kb = r / nblk, nb = r % nblk; cv_item(w_a, D, nullptr, WB + WB_WAB, D, 0, 32 * nb, kb, nb, scr, F.lane); continue; } r -= I_A;
        if (r < I_A)  { const int nblk = D / 32, kb = r / nblk, nb = r % nblk; cv_item(w_b, D, nullptr, WB + WB_WAB, D, DC, 32 * nb, kb, nb, scr, F.lane); continue; } r -= I_A;
        if (r < I_O)  { const int nblk = D / 32, kb = r / nblk, nb = r % nblk; cv_item(w_o, D, nullptr, WB + WB_WO, D, 0, 32 * nb, kb, nb, scr, F.lane); continue; } r -= I_O;
        if (r < I_UP) { const int nblk = NUP / 32, kb = r / nblk, nb = r % nblk; cv_item(w_up, NUP, g_ffn, WB + WB_WUP, D, 0, wup_dst(32 * nb), kb, nb, scr, F.lane); continue; } r -= I_UP;
        if (r < I_DN) { const int nblk = D / 32, kb = r / nblk, nb = r % nblk; cv_item(w_dn, D, nullptr, WB + WB_WDN, DFF, 0, 32 * nb, kb, nb, scr, F.lane); continue; } r -= I_DN;
        if (r < I_O)  { const int nblk = D / 32, kb = r / nblk, nb = r % nblk; cv_item(w_pg, D, g_ple, WB + WB_WPG, D, 0, 32 * nb, kb, nb, scr, F.lane); continue; } r -= I_O;
        { const int nblk = D / 32, kb = r / nblk, nb = r % nblk; cv_item(w_pl, D, nullptr, WB + WB_WPL, PLE, 0, 32 * nb, kb, nb, scr, F.lane); }
    }
    { const GAS f32x4* src = (const GAS f32x4*)(P.p + (size_t)layer * M * PLE); GAS u32x2* dst = (GAS u32x2*)(F.ws + WS_PB);
      const int gt = F.vcu * (NWAVES * 64) + F.tid, NT = F.G * NWAVES * 64;
      for (int i = gt; i < M * PLE / 4; i += NT) dst[i] = pk4(src[i]); }
    if (layer == 0) {
        for (int m = gw; m < M; m += NGW) {
            const GAS f32x4* xr = (const GAS f32x4*)(P.x + (size_t)m * D) + F.lane; GAS u32x2* o8 = (GAS u32x2*)(F.ws + WS_XB + (size_t)m * D * 2) + F.lane;
            float s = 0.f;
#pragma unroll
            for (int j = 0; j < 4; ++j) { const f32x4 v = xr[64 * j]; s += (v[0] * v[0] + v[1] * v[1]) + (v[2] * v[2] + v[3] * v[3]); o8[64 * j] = pk4(v); }
            s = wave_sum(s);
            if (F.lane < 16) ((GAS float*)(F.ws + WS_SS0))[(size_t)m * 16 + F.lane] = F.lane == 0 ? s : 0.f;
        }
    }
}

constexpr int CO_R = 16;
template <int S> struct CoStep {
    static __device__ __forceinline__ void run(f32x2 (&acc)[CO_R], const f32x2 (&w)[CKA], const GAS unsigned* src, int g0, int t0, int cw) {
        const int ts = t0 - (CKA - 1) + S; const bool ok = ts >= 0;
        const unsigned wd = src[(size_t)(ok ? g0 - (CKA - 1) + S : g0) * (DC / 2) + cw];
        f32x2 a; a.x = ok ? bf_lo(wd) : 0.f; a.y = ok ? bf_hi(wd) : 0.f;
#pragma unroll
        for (int r = 0; r < CO_R; ++r) { constexpr int dummy = 0; (void)dummy; const int k = S - r; if (k >= 0 && k < CKA) acc[r] += w[k] * a; }
        CoStep<S + 1>::run(acc, w, src, g0, t0, cw);
    }
};
template <> struct CoStep<CO_R + CKA - 1> { static __device__ __forceinline__ void run(f32x2 (&)[CO_R], const f32x2 (&)[CKA], const GAS unsigned*, int, int, int) {} };
__device__ __forceinline__ void co_phase(Frame& F, int layer, const float* cwa_, const float* cba_, const float* lng_, const float* lnb_, const float* cwb_) {
    const int grp = F.tid >> 8, wv = (F.tid >> 6) & 3, c0 = wv * 128 + F.lane * 2;
    const float* cwa = cwa_ + (size_t)layer * CKA * DC; const float* cba = cba_ + layer * DC; const float* lng = lng_ + layer * DC; const float* lnb = lnb_ + layer * DC;
    const float* cwb = cwb_ + (size_t)layer * 3 * DSC;
    const GAS unsigned* AGLU = (const GAS unsigned*)(F.ws + WS_AGLU); const GAS unsigned* CVp = (const GAS unsigned*)(F.ws + WS_CV); const GAS unsigned* BSp = (const GAS unsigned*)(F.ws + WS_BS);
    GAS unsigned* A2S = (GAS unsigned*)(F.ws + WS_A2S);
    LAS f32x2* part = (LAS f32x2*)(F.lds + RING_OFF) + grp * (CO_R * 4);
    f32x2 w[CKA];
#pragma unroll
    for (int k = 0; k < CKA; ++k) w[k] = *(const f32x2*)(cwa + k * DC + c0);
    const f32x2 bias = *(const f32x2*)(cba + c0), lg = *(const f32x2*)(lng + c0), lb = *(const f32x2*)(lnb + c0);
    const f32x2 wb0 = *(const f32x2*)(cwb + c0), wb1 = *(const f32x2*)(cwb + DSC + c0), wb2 = *(const f32x2*)(cwb + 2 * DSC + c0);
    constexpr int NITEM = M / CO_R;
    const int ngrp = 2 * F.G;
    for (int it0 = 0; it0 < NITEM; it0 += ngrp) {
        const int it = it0 + F.vcu * 2 + grp; const bool live = it < NITEM;
        const int g0 = (live ? it : 0) * CO_R, t0 = g0 % SEQ;
        f32x2 acc[CO_R];
#pragma unroll
        for (int r = 0; r < CO_R; ++r) acc[r] = bias;
        CoStep<0>::run(acc, w, AGLU, g0, t0, c0 >> 1);
#pragma unroll
        for (int r = 0; r < CO_R; ++r) {
            float s1 = acc[r].x + acc[r].y, s2 = acc[r].x * acc[r].x + acc[r].y * acc[r].y;
            s1 = wave_sum(s1); s2 = wave_sum(s2);
            if (F.lane == 0) part[r * 4 + wv] = (f32x2){s1, s2};
        }
        __syncthreads();
#pragma unroll
        for (int r = 0; r < CO_R; ++r) {
            const f32x2 p0 = part[r * 4 + 0], p1 = part[r * 4 + 1], p2 = part[r * 4 + 2], p3 = part[r * 4 + 3];
            const float mean = ((p0.x + p1.x) + (p2.x + p3.x)) * (1.0f / DC), ex2 = ((p0.y + p1.y) + (p2.y + p3.y)) * (1.0f / DC);
            const float var = fmaxf(ex2 - mean * mean, 0.f), rstd = frsq(var + EPS);
            float y0 = (acc[r].x - mean) * rstd * lg.x + lb.x, y1 = (acc[r].y - mean) * rstd * lg.y + lb.y;
            y0 = y0 * sigm(y0); y1 = y1 * sigm(y1);
            if (live) A2S[(size_t)(g0 + r) * (D / 2) + (c0 >> 1)] = pk2(y0, y1);
        }
        {
            f32x2 c2 = {0.f, 0.f}, c1 = {0.f, 0.f};
            if (t0 >= 2) { const unsigned wd = CVp[(size_t)(g0 - 2) * (DSC / 2) + (c0 >> 1)]; c2 = (f32x2){bf_lo(wd), bf_hi(wd)}; }
            if (t0 >= 1) { const unsigned wd = CVp[(size_t)(g0 - 1) * (DSC / 2) + (c0 >> 1)]; c1 = (f32x2){bf_lo(wd), bf_hi(wd)}; }
#pragma unroll 8
            for (int r = 0; r < CO_R; ++r) {
                const unsigned wc_ = CVp[(size_t)(g0 + r) * (DSC / 2) + (c0 >> 1)], wb_ = BSp[(size_t)(g0 + r) * (DSC / 2) + (c0 >> 1)];
                const f32x2 c = {bf_lo(wc_), bf_hi(wc_)}, b = {bf_lo(wb_), bf_hi(wb_)};
                const f32x2 o = b * (wb0 * c2 + wb1 * c1 + wb2 * c);
                if (live) A2S[(size_t)(g0 + r) * (D / 2) + (DC >> 1) + (c0 >> 1)] = pk2(o.x, o.y);
                c2 = c1; c1 = c;
            }
        }
        __syncthreads();
    }
}

__device__ __forceinline__ void final_phase(Frame& F, const float* g_final) {
    const int gw = F.vcu * NWAVES + F.wave, NGW = F.G * NWAVES;
    const float* SS = (const float*)(F.ws + ((NLAYER & 1) ? WS_SS1 : WS_SS0));
    const f32x4* gf = (const f32x4*)g_final + F.lane;
    f32x4 gv[4];
#pragma unroll
    for (int j = 0; j < 4; ++j) gv[j] = gf[64 * j];
    for (int m = gw; m < M; m += NGW) {
        const float rs = row_rs(SS, m);
        GAS f32x4* xr = (GAS f32x4*)(F.out + (size_t)m * D) + F.lane;
#pragma unroll
        for (int j = 0; j < 4; ++j) xr[64 * j] = xr[64 * j] * rs * gv[j];
    }
}

struct Args { const float* in[22]; float* out; unsigned char* ws; int ph_lo, ph_hi, li, pad; };
__global__ void __launch_bounds__(NWAVES * 64, 2) fwd_kernel(Args args) {
    extern __shared__ __attribute__((aligned(16))) unsigned char lds[];
    Frame F;
    F.lds = (LAS unsigned char*)lds;
    F.MISC = (volatile LAS unsigned*)(F.lds + MISC_OFF);
    F.tid = threadIdx.x; F.lane = F.tid & 63; F.wave = __builtin_amdgcn_readfirstlane(F.tid >> 6);
    F.G = gridDim.x; { const int bx = blockIdx.x; F.vcu = (F.G % 8 == 0) ? (bx % 8) * (F.G / 8) + bx / 8 : bx; }
    unsigned char* ws = args.ws; F.ws = ws; F.out = args.out;
    F.ctl = (gu32*)(ws + WS_CTL);
    for (int u = F.tid; u < (LDS_BYTES - LDSCTL_OFF) / 4; u += NWAVES * 64) ((LAS unsigned*)(F.lds + LDSCTL_OFF))[u] = 0u;
    __syncthreads();
    XcdBarrier bar; bar.bar = (unsigned*)(F.ctl + CW_BAR); bar.x = 0; bar.st = nullptr;
    if (!MK_PER_PHASE) bar = xcd_barrier_post((unsigned*)(F.ctl + CW_BAR), F.MISC + 8);

    bf16_t* WB = (bf16_t*)(ws + WS_WB);
    const int lo = args.ph_lo, hi = args.ph_hi;
    for (int p = lo; p < hi; ++p) {
        const int layer = p >> 3, k = p & 7;
        { int tv = threadIdx.x; asm volatile("" : "+v"(tv)); F.tid = tv; F.lane = tv & 63; F.wave = __builtin_amdgcn_readfirstlane(tv >> 6); }
        float* SSa = (float*)(ws + ((layer & 1) ? WS_SS1 : WS_SS0));
        float* SSb = (float*)(ws + ((layer & 1) ? WS_SS0 : WS_SS1));
#ifndef PHMASK
#define PHMASK 0x1ff
#endif
        if (p == N_PHASES - 1) { if (PHMASK & 0x100) final_phase(F, args.in[21]); }
        else if (k == 0) { if (PHMASK & 1) { const CvPtrs P{args.in[0], args.in[1], args.in[2], args.in[3], args.in[9], args.in[11], args.in[12], args.in[13], args.in[14], args.in[17], args.in[18], args.in[19], args.in[20]}; cv_phase(F, layer, P); } }
        else if (k == 1) { if (PHMASK & 2) {
#ifndef NO_EG
            {
                Gemm g{(const bf16_t*)(ws + WS_PB), WB + WB_WPL, PLE}; StaticOrder S; S.init(M / BM, D / BM, F.G, (int)blockIdx.x);
                EpiE E{(bf16_t*)(ws + WS_E)};
                gemm_phase<EpiE, StaticOrder, false, true, false>(F.lds + RING_OFF, g, S, E);
            }
#endif
#ifndef NO_IN
            {
                Gemm g{(const bf16_t*)(ws + (layer == 0 ? WS_XB : WS_XB2)), WB + WB_WIN, D}; StaticOrder S; S.init(M / BM, NIN / BM, F.G, (int)blockIdx.x);
                EpiIn E{SSa, args.in[4] + (size_t)layer * 2 * D, (bf16_t*)(ws + WS_AGLU), (bf16_t*)(ws + WS_CV), (bf16_t*)(ws + WS_BS), (bf16_t*)(ws + WS_GR), (bf16_t*)(ws + WS_GB)};
                gemm_phase<EpiIn, StaticOrder, true, true, false>(F.lds + RING_OFF, g, S, E);
            }
#endif
        } }
        else if (k == 2) { if (PHMASK & 4) co_phase(F, layer, args.in[5], args.in[6], args.in[7], args.in[8], args.in[10]); }
        else if (k == 3) { if (PHMASK & 8) {
            Gemm g{(const bf16_t*)(ws + WS_A2S), WB + WB_WAB, D}; StaticOrder S; S.init(M / BM, D / BM, F.G, (int)blockIdx.x);
            EpiMerge E{(const bf16_t*)(ws + WS_GR), (const bf16_t*)(ws + WS_GB), (bf16_t*)(ws + WS_MG)};
            gemm_phase<EpiMerge, StaticOrder, false, true, false>(F.lds + RING_OFF, g, S, E);
        } }
        else if (k == 4) { if (PHMASK & 16) {
            Gemm g{(const bf16_t*)(ws + WS_MG), WB + WB_WO, D}; StaticOrder S; S.init(M / BM, D / BM, F.G, (int)blockIdx.x);
            EpiRes<0> E{layer == 0 ? args.in[0] : (const float*)F.out, F.out, (bf16_t*)(ws + WS_XB), SSb, nullptr, nullptr};
            gemm_phase<EpiRes<0>, StaticOrder, false, true, false>(F.lds + RING_OFF, g, S, E);
        } }
        else if (k == 5) { if (PHMASK & 32) {
            Gemm g{(const bf16_t*)(ws + WS_XB) - 2 * D, WB + WB_WUP, D}; StaticOrder S; S.init(NT_UP, NUP / BM, F.G, (int)blockIdx.x);
            EpiUp E{SSb, args.in[15] + (size_t)layer * 3 * DFF, args.in[16] + (size_t)layer * DFF, (bf16_t*)(ws + WS_F)};
            gemm_phase<EpiUp, StaticOrder, true, true, true>(F.lds + RING_OFF, g, S, E);
        } }
        else if (k == 6) { if (PHMASK & 64) {
            Gemm g{(const bf16_t*)(ws + WS_F), WB + WB_WDN, DFF}; StaticOrder S; S.init(M / BM, D / BM, F.G, (int)blockIdx.x);
            EpiRes<0> E{(const float*)F.out, F.out, (bf16_t*)(ws + WS_XB), SSa, nullptr, nullptr};
            gemm_phase<EpiRes<0>, StaticOrder, false, true, false>(F.lds + RING_OFF, g, S, E);
        } }
        else { if (PHMASK & 128) {
            Gemm g{(const bf16_t*)(ws + WS_XB), WB + WB_WPG, D}; StaticOrder S; S.init(M / BM, D / BM, F.G, (int)blockIdx.x);
            EpiRes<1> E{(const float*)F.out, F.out, (bf16_t*)(ws + WS_XB2), SSb, SSa, (const bf16_t*)(ws + WS_E)};
            gemm_phase<EpiRes<1>, StaticOrder, false, true, false>(F.lds + RING_OFF, g, S, E);
        } }
        if (p + 1 < hi) xcd_barrier(bar);
    }
}

extern "C" void kernel_launch(void* const* d_in, const int* in_sizes, int n_in, void* d_out, int out_size, void* d_ws, size_t ws_size, hipStream_t stream) {
    static int grid = 0;
    if (grid == 0) {
        if (n_in != 22 || in_sizes[0] != M * D || out_size != M * D || ws_size < WS_END) { fprintf(stderr, "kernel_launch: built for 22 inputs, x and out of %d floats, >= %zu bytes of workspace; got n_in %d, in0 %d, out %d, ws %zu; nothing launched\n", M * D, (size_t)WS_END, n_in, n_in > 0 ? in_sizes[0] : -1, out_size, ws_size); grid = -1; return; }
        int dev = 0, cus = 0, per_cu = 0;
        if (hipGetDevice(&dev) != hipSuccess || hipDeviceGetAttribute(&cus, hipDeviceAttributeMultiprocessorCount, dev) != hipSuccess) { fprintf(stderr, "kernel_launch: hipGetDevice / hipDeviceGetAttribute failed; nothing launched\n"); grid = -1; return; }
        if (hipFuncSetAttribute((const void*)fwd_kernel, hipFuncAttributeMaxDynamicSharedMemorySize, LDS_BYTES) != hipSuccess) { fprintf(stderr, "kernel_launch: hipFuncSetAttribute failed\n"); grid = -1; return; }
        if (hipOccupancyMaxActiveBlocksPerMultiprocessor(&per_cu, (const void*)fwd_kernel, NWAVES * 64, LDS_BYTES) != hipSuccess || per_cu < 1)
            fprintf(stderr, "kernel_launch: note: the occupancy query reports %d workgroups per CU\n", per_cu);
        (void)hipGetLastError();
        grid = cus;
    }
    if (grid < 0) return;
    if (hipMemsetAsync((char*)d_ws + WS_CTL, 0, CTL_ZERO_BYTES, stream) != hipSuccess) { fprintf(stderr, "kernel_launch: hipMemsetAsync of the control words failed; nothing launched\n"); return; }
    Args a{};
    for (int i = 0; i < 22; ++i) a.in[i] = (const float*)d_in[i];
    a.out = (float*)d_out; a.ws = (unsigned char*)d_ws;
    const int nl = MK_PER_PHASE ? N_PHASES : 1;
    for (int li = 0; li < nl; ++li) {
        a.ph_lo = MK_PER_PHASE ? li : 0; a.ph_hi = MK_PER_PHASE ? li + 1 : N_PHASES; a.li = li;
        hipLaunchKernelGGL(fwd_kernel, dim3(grid), dim3(NWAVES * 64), LDS_BYTES, stream, a);
        const hipError_t le = hipPeekAtLastError();
        if (le != hipSuccess) { fprintf(stderr, "kernel_launch: launch %d failed: %s (grid %d x %d threads, %d B LDS)\n", li, hipGetErrorName(le), grid, NWAVES * 64, LDS_BYTES); break; }
    }
}
#endif
```

```cpp
#ifndef EMU
#include <hip/hip_runtime.h>
#include <cstdio>
#include <cstdint>
#define HD __host__ __device__ __forceinline__
#else
#include <cstdio>
#include <cstdint>
#include <cmath>
#include <cstring>
#define HD inline
#endif

#ifndef SEQ_LEN
#define SEQ_LEN 8192
#endif
constexpr int BATCH = 2, SEQ = SEQ_LEN, D = 1024, M = BATCH * SEQ;
constexpr int DC = 512, DSC = 512, NIN = 4608, DFF = 2816, NUP = 2 * DFF, PLE = 256, CKA = 31, NLAYER = 2;
constexpr float EPS = 1e-6f;
constexpr int NQ_UP = (M + 61) / 62;
constexpr int NT_UP = (NQ_UP + 3) / 4;

typedef unsigned short bf16_t;
typedef short bf16x8 __attribute__((ext_vector_type(8)));
typedef float f32x4 __attribute__((ext_vector_type(4)));
typedef float f32x2 __attribute__((ext_vector_type(2)));
typedef unsigned u32x4 __attribute__((ext_vector_type(4)));
typedef unsigned u32x2 __attribute__((ext_vector_type(2)));

HD float bits2f(unsigned u) { return __builtin_bit_cast(float, u); }
HD unsigned f2bits(float f) { return __builtin_bit_cast(unsigned, f); }
HD unsigned f2bf(float f) { unsigned u = f2bits(f); return (u + 0x7fffu + ((u >> 16) & 1u)) >> 16; }
HD unsigned pk2(float lo, float hi) {
#if defined(__HIP_DEVICE_COMPILE__)
    unsigned r; asm volatile("v_cvt_pk_bf16_f32 %0, %1, %2" : "=v"(r) : "v"(lo), "v"(hi)); return r;
#else
    return f2bf(lo) | (f2bf(hi) << 16);
#endif
}
HD float bf_lo(unsigned w) { return bits2f(w << 16); }
HD float bf_hi(unsigned w) { return bits2f(w & 0xffff0000u); }
HD float fexp2(float x) {
#if defined(__HIP_DEVICE_COMPILE__)
    return __builtin_amdgcn_exp2f(x);
#else
    return exp2f(x);
#endif
}
HD float frcp(float x) {
#if defined(__HIP_DEVICE_COMPILE__)
    return __builtin_amdgcn_rcpf(x);
#else
    return 1.0f / x;
#endif
}
HD float frsq(float x) {
#if defined(__HIP_DEVICE_COMPILE__)
    return __builtin_amdgcn_rsqf(x);
#else
    return 1.0f / sqrtf(x);
#endif
}
HD float sigm(float x) { return frcp(1.0f + fexp2(-1.44269504089f * x)); }
HD float gelu_tanh(float x) { const float y = x * (1.5957691216f + 0.0713548163f * x * x); return x * sigm(y); }
HD f32x4 sigm4(f32x4 v) { return (f32x4){sigm(v[0]), sigm(v[1]), sigm(v[2]), sigm(v[3])}; }
HD u32x4 pk8(f32x4 a, f32x4 b) { u32x4 w; w.x = pk2(a[0], a[1]); w.y = pk2(a[2], a[3]); w.z = pk2(b[0], b[1]); w.w = pk2(b[2], b[3]); return w; }
HD u32x2 pk4(f32x4 a) { u32x2 w; w.x = pk2(a[0], a[1]); w.y = pk2(a[2], a[3]); return w; }
HD f32x4 unpk_lo(u32x4 w) { return (f32x4){bf_lo(w.x), bf_hi(w.x), bf_lo(w.y), bf_hi(w.y)}; }
HD f32x4 unpk_hi(u32x4 w) { return (f32x4){bf_lo(w.z), bf_hi(w.z), bf_lo(w.w), bf_hi(w.w)}; }
HD f32x4 unpk4(u32x2 w) { return (f32x4){bf_lo(w.x), bf_hi(w.x), bf_lo(w.y), bf_hi(w.y)}; }
#if defined(__HIP_DEVICE_COMPILE__)
#define CFENCE() asm volatile("" ::: "memory")
#define LAUNDER(x) asm volatile("" : "+v"(x))
#else
#define CFENCE() do {} while (0)
#define LAUNDER(x) do {} while (0)
#endif
HD float hsum4(f32x4 a) { return (a[0] + a[1]) + (a[2] + a[3]); }

HD float row_rs(const float* SS, int g) {
    const f32x4* p = (const f32x4*)(SS + (size_t)g * 16);
    const f32x4 a = p[0], b = p[1], c = p[2], d = p[3];
    const float s = (hsum4(a) + hsum4(b)) + (hsum4(c) + hsum4(d));
    return frsq(s * (1.0f / (float)D) + EPS);
}

template <class Sh> HD float row_rs_q(const float* SS, int g, int fq, int lane, const Sh& sh) {
    float s = hsum4(*(const f32x4*)(SS + (size_t)g * 16 + fq * 4));
    s += sh(s, lane ^ 16); s += sh(s, lane ^ 32);
    return frsq(s * (1.0f / (float)D) + EPS);
}

HD int win_dst(int s) {
    if (s < 512) return 256 * (s >> 7) + (s & 127);
    if (s < 1024) { const int c = s - 512; return 256 * (c >> 7) + 128 + (c & 127); }
    if (s < 1536) return 2048 + (s - 1024);
    if (s < 2048) { const int c = s - 1536; return 256 * (4 + (c >> 7)) + (c & 127); }
    if (s < 2560) { const int c = s - 2048; return 256 * (4 + (c >> 7)) + 128 + (c & 127); }
    if (s < 3584) { const int c = s - 2560; return 256 * (10 + (c >> 7)) + (c & 127); }
    { const int c = s - 3584; return 256 * (10 + (c >> 7)) + 128 + (c & 127); }
}
HD int wup_dst(int s) { if (s < DFF) return 256 * (s >> 7) + (s & 127); const int c = s - DFF; return 256 * (c >> 7) + 128 + (c & 127); }

constexpr int BM = 256, BK = 64, HALF = 128, HTB = HALF * BK * 2  , STAGE_BYTES = 8 * HTB, NXCD = 8, WGM = 8;
struct Unit { int pm, pn; };
struct Gemm { const bf16_t* A; const bf16_t* Bt; int K; };
struct StaticOrder {
    int nM, nN, nwg, G, c;
    HD void init(int nM_, int nN_, int G_, int c_) { nM = nM_; nN = nN_; nwg = nM * nN; G = G_; c = c_; }
    HD bool next(int i, Unit& u) const {
        const long L = (long)i * G + c; if (L >= nwg) return false;
        int wgid = (int)L; { const int q = nwg / NXCD, r = nwg % NXCD, xcd = wgid % NXCD, off = wgid / NXCD; wgid = (xcd < r ? xcd * (q + 1) : r * (q + 1) + (xcd - r) * q) + off; }
        const int nig = WGM * nN, gid = wgid / nig, fm = gid * WGM, gsz = (nM - fm) < WGM ? (nM - fm) : WGM;
        u.pm = fm + ((wgid % nig) % gsz); u.pn = (wgid % nig) / gsz; return true;
    }
    HD void a_ready(const Unit&) const {}
    HD void done(const Unit&) const {}
};

typedef f32x4 Acc[2][2][4][2];

struct EpiE {
    static constexpr bool PERM = true, AFTER_DRAIN = false, HAS_MID = false; static constexpr int MID_T = -1;
    bf16_t* E;
    template <class Sh> HD void operator()(const Acc& acc, const Unit& u, int wr, int wc, int fr, int fq, const Sh&) const {
        const int cb = u.pn * 256 + wc * 32 + 8 * fq;
#pragma unroll
        for (int ai = 0; ai < 2; ++ai)
#pragma unroll
            for (int m = 0; m < 4; ++m) { const int g = u.pm * 256 + ai * 128 + wr * 64 + m * 16 + fr; bf16_t* rowp = E + (size_t)g * D + cb;
#pragma unroll
                for (int bj = 0; bj < 2; ++bj) *(u32x4*)(rowp + bj * 128) = pk8(acc[ai][bj][m][0], acc[ai][bj][m][1]); }
    }
    template <class Sh> HD void mid(Acc&, const Unit&, int, int, int, int, const Sh&) const {}
};

struct EpiIn {
    static constexpr bool PERM = true, AFTER_DRAIN = false, HAS_MID = false; static constexpr int MID_T = -1;
    const float* SS; const float* bgate; bf16_t *AGLU, *CV, *BS, *GR, *GB;
    template <class Sh> HD void operator()(const Acc& acc, const Unit& u, int wr, int wc, int fr, int fq, const Sh& sh) const {
        const int cb = wc * 32 + 8 * fq;
        const int pn = u.pn, grow = u.pm * 256 + wr * 64 + fr, lane = fq * 16 + fr;
        float rsv[2][4];
#pragma unroll
        for (int ai = 0; ai < 2; ++ai)
#pragma unroll
            for (int m = 0; m < 4; ++m) rsv[ai][m] = row_rs_q(SS, grow + ai * 128 + m * 16, fq, lane, sh);
        if (pn < 4) {
#pragma unroll
            for (int ai = 0; ai < 2; ++ai)
#pragma unroll
                for (int m = 0; m < 4; ++m) { const int g = grow + ai * 128 + m * 16; const float rs = rsv[ai][m];
                    *(u32x4*)(AGLU + (size_t)g * DC + pn * 128 + cb) = pk8((acc[ai][0][m][0] * rs) * sigm4(acc[ai][1][m][0] * rs), (acc[ai][0][m][1] * rs) * sigm4(acc[ai][1][m][1] * rs)); }
        } else if (pn < 8) {
#pragma unroll
            for (int ai = 0; ai < 2; ++ai)
#pragma unroll
                for (int m = 0; m < 4; ++m) { const int g = grow + ai * 128 + m * 16; const float r2 = rsv[ai][m] * rsv[ai][m];
                    *(u32x4*)(CV + (size_t)g * DSC + (pn - 4) * 128 + cb) = pk8(acc[ai][0][m][0] * acc[ai][1][m][0] * r2, acc[ai][0][m][1] * acc[ai][1][m][1] * r2); }
        } else if (pn < 10) {
#pragma unroll
            for (int ai = 0; ai < 2; ++ai)
#pragma unroll
                for (int m = 0; m < 4; ++m) { const int g = grow + ai * 128 + m * 16; const float rs = rsv[ai][m];
                    bf16_t* rowp = BS + (size_t)g * DSC + (pn - 8) * 256 + cb;
                    *(u32x4*)rowp = pk8(acc[ai][0][m][0] * rs, acc[ai][0][m][1] * rs); *(u32x4*)(rowp + 128) = pk8(acc[ai][1][m][0] * rs, acc[ai][1][m][1] * rs); }
        } else {
            const int t = pn - 10; const float* pa = bgate + t * 128 + cb; const float* pb = bgate + D + t * 128 + cb;
            const f32x4 ba0 = *(const f32x4*)pa, ba1 = *(const f32x4*)(pa + 4), bb0 = *(const f32x4*)pb, bb1 = *(const f32x4*)(pb + 4);
#pragma unroll
            for (int ai = 0; ai < 2; ++ai)
#pragma unroll
                for (int m = 0; m < 4; ++m) { const int g = grow + ai * 128 + m * 16; const float rs = rsv[ai][m];
                    const size_t o = (size_t)g * D + t * 128 + cb;
                    const f32x4 la0 = acc[ai][0][m][0] * rs + ba0, la1 = acc[ai][0][m][1] * rs + ba1, lb0 = acc[ai][1][m][0] * rs + bb0, lb1 = acc[ai][1][m][1] * rs + bb1;
                    f32x4 r0, r1, g0, g1;
#pragma unroll
                    for (int j = 0; j < 4; ++j) {
                        const float ea0 = fexp2(-1.44269504089f * la0[j]), eb0 = fexp2(-1.44269504089f * lb0[j]), ea1 = fexp2(-1.44269504089f * la1[j]), eb1 = fexp2(-1.44269504089f * lb1[j]);
                        g0[j] = frcp(1.0f + eb0); r0[j] = (1.0f + eb0) * frcp(1.0f + ea0); g1[j] = frcp(1.0f + eb1); r1[j] = (1.0f + eb1) * frcp(1.0f + ea1); }
                    *(u32x4*)(GR + o) = pk8(r0, r1); *(u32x4*)(GB + o) = pk8(g0, g1); }
        }
    }
    template <class Sh> HD void mid(Acc&, const Unit&, int, int, int, int, const Sh&) const {}
};

struct EpiMerge {
    static constexpr bool PERM = true, AFTER_DRAIN = false, HAS_MID = true; static constexpr int MID_T = 8;
    const bf16_t *GR, *GB; bf16_t* MG;
    template <class Sh> HD void mid(Acc& acc, const Unit& u, int wr, int wc, int fr, int fq, const Sh&) const {
        LAUNDER(fr); LAUNDER(fq);
        const int cb = u.pn * 256 + wc * 32 + 8 * fq;
#pragma unroll
        for (int ai = 0; ai < 2; ++ai)
#pragma unroll
            for (int m = 0; m < 4; ++m) { const int g = u.pm * 256 + ai * 128 + wr * 64 + m * 16 + fr; const bf16_t* rowp = GR + (size_t)g * D + cb;
#pragma unroll
                for (int bj = 0; bj < 2; ++bj) { const u32x4 w = *(const u32x4*)(rowp + bj * 128); acc[ai][bj][m][0] *= unpk_lo(w); acc[ai][bj][m][1] *= unpk_hi(w); CFENCE(); } }
    }
    template <class Sh> HD void operator()(const Acc& acc, const Unit& u, int wr, int wc, int fr, int fq, const Sh&) const {
        const int cb = u.pn * 256 + wc * 32 + 8 * fq;
#pragma unroll
        for (int ai = 0; ai < 2; ++ai)
#pragma unroll
            for (int m = 0; m < 4; ++m) { const int g = u.pm * 256 + ai * 128 + wr * 64 + m * 16 + fr; const size_t o = (size_t)g * D + cb;
#pragma unroll
                for (int bj = 0; bj < 2; ++bj) { const u32x4 w = *(const u32x4*)(GB + o + bj * 128);
                    *(u32x4*)(MG + o + bj * 128) = pk8(acc[ai][bj][m][0] * unpk_lo(w), acc[ai][bj][m][1] * unpk_hi(w)); } CFENCE(); }
    }
};

template <int MODE> struct EpiRes {
    static constexpr bool PERM = true, AFTER_DRAIN = false, HAS_MID = false; static constexpr int MID_T = -1;
    const bf16_t* xin; bf16_t* xout; float* ssout; const float* ssin; const bf16_t* E;
    template <class Sh> HD void operator()(const Acc& acc, const Unit& u, int wr, int wc, int fr, int fq, const Sh& sh) const {
        const int cb = u.pn * 256 + wc * 32 + 8 * fq; const int lane = fq * 16 + fr, grow = u.pm * 256 + wr * 64 + fr;
        float rsv[2][4];
        if (MODE == 1) {
#pragma unroll
            for (int ai = 0; ai < 2; ++ai)
#pragma unroll
                for (int m = 0; m < 4; ++m) rsv[ai][m] = row_rs_q(ssin, grow + ai * 128 + m * 16, fq, lane, sh);
        }
        constexpr int MB = MODE == 1 ? 2 : 4;
#pragma unroll
        for (int ai = 0; ai < 2; ++ai)
#pragma unroll
        for (int mh = 0; mh < 4; mh += MB) {
            u32x4 xi[MB][2], ev[MB][2];
#pragma unroll
            for (int mm = 0; mm < MB; ++mm)
#pragma unroll
                for (int bj = 0; bj < 2; ++bj) { const size_t o = (size_t)(grow + ai * 128 + (mh + mm) * 16) * D + cb + bj * 128; xi[mm][bj] = *(const u32x4*)(xin + o); if (MODE == 1) ev[mm][bj] = *(const u32x4*)(E + o); }
#pragma unroll
            for (int mm = 0; mm < MB; ++mm) {
                const int m = mh + mm, g = grow + ai * 128 + m * 16; float sq = 0.f;
#pragma unroll
                for (int bj = 0; bj < 2; ++bj) { const size_t o = (size_t)g * D + cb + bj * 128;
                    f32x4 v0 = acc[ai][bj][m][0], v1 = acc[ai][bj][m][1];
                    if (MODE == 1) { const float rs = rsv[ai][m]; v0 = sigm4(v0 * rs) * unpk_lo(ev[mm][bj]); v1 = sigm4(v1 * rs) * unpk_hi(ev[mm][bj]); }
                    const f32x4 x0 = unpk_lo(xi[mm][bj]) + v0, x1 = unpk_hi(xi[mm][bj]) + v1;
                    *(u32x4*)(xout + o) = pk8(x0, x1);
                    sq += ((x0[0] * x0[0] + x0[1] * x0[1]) + (x0[2] * x0[2] + x0[3] * x0[3])) + ((x1[0] * x1[0] + x1[1] * x1[1]) + (x1[2] * x1[2] + x1[3] * x1[3])); }
                sq += sh(sq, lane ^ 16); sq += sh(sq, lane ^ 32);
                if (fq == 0) ssout[(size_t)g * 16 + u.pn * 4 + wc] = sq;
            }
            CFENCE();
        }
    }
    template <class Sh> HD void mid(Acc&, const Unit&, int, int, int, int, const Sh&) const {}
};

struct EpiUp {
    static constexpr bool PERM = true, AFTER_DRAIN = false, HAS_MID = false; static constexpr int MID_T = -1;
    const float* SS; const float* cw; const float* cb_; bf16_t* F;
    template <class Sh> HD void operator()(const Acc& acc, const Unit& u, int wr, int wc, int fr, int fq, const Sh& sh) const {
        const int ch = u.pn * 128 + wc * 32 + 8 * fq;
        const int lane = fq * 16 + fr;
        float rsv[2][4];
#pragma unroll
        for (int ai = 0; ai < 2; ++ai)
#pragma unroll
            for (int m = 0; m < 4; ++m) { const int g = 62 * (4 * u.pm + 2 * ai + wr) - 2 + m * 16 + fr; rsv[ai][m] = row_rs_q(SS, g < 0 ? 0 : (g > M - 1 ? M - 1 : g), fq, lane, sh); }
        const f32x4 w0a = *(const f32x4*)(cw + ch), w0b = *(const f32x4*)(cw + ch + 4), w1a = *(const f32x4*)(cw + DFF + ch), w1b = *(const f32x4*)(cw + DFF + ch + 4);
        const f32x4 w2a = *(const f32x4*)(cw + 2 * DFF + ch), w2b = *(const f32x4*)(cw + 2 * DFF + ch + 4), bia = *(const f32x4*)(cb_ + ch), bib = *(const f32x4*)(cb_ + ch + 4);
#pragma unroll
        for (int ai = 0; ai < 2; ++ai) {
            const int q = 4 * u.pm + 2 * ai + wr;
            f32x4 pa = {0.f, 0.f, 0.f, 0.f}, pb = pa;
#pragma unroll
            for (int m = 0; m < 4; ++m) {
                const int rho = m * 16 + fr, g = 62 * q - 2 + rho; const int gc = g < 0 ? 0 : (g > M - 1 ? M - 1 : g);
                const float rs = rsv[ai][m];
                const f32x4 ga = acc[ai][0][m][0] * rs, gb = acc[ai][0][m][1] * rs, va = acc[ai][1][m][0] * rs, vb = acc[ai][1][m][1] * rs;
                f32x4 t1a, t1b, t2a, t2b;
#pragma unroll
                for (int j = 0; j < 4; ++j) {
                    t1a[j] = sh.ror1(fr == 15 ? pa[j] : ga[j]); t1b[j] = sh.ror1(fr == 15 ? pb[j] : gb[j]);
                    t2a[j] = sh.ror2(fr >= 14 ? pa[j] : ga[j]); t2b[j] = sh.ror2(fr >= 14 ? pb[j] : gb[j]);
                }
                pa = ga; pb = gb;
                const int t = gc % SEQ;
                if (t < 1) { t1a = (f32x4){0.f, 0.f, 0.f, 0.f}; t1b = t1a; }
                if (t < 2) { t2a = (f32x4){0.f, 0.f, 0.f, 0.f}; t2b = t2a; }
                const f32x4 fa = w2a * ga + w1a * t1a + w0a * t2a + bia, fb = w2b * gb + w1b * t1b + w0b * t2b + bib;
                f32x4 oa, ob;
#pragma unroll
                for (int j = 0; j < 4; ++j) { oa[j] = gelu_tanh(fa[j]) * va[j]; ob[j] = gelu_tanh(fb[j]) * vb[j]; }
                if (rho >= 2 && g < M) *(u32x4*)(F + (size_t)g * DFF + ch) = pk8(oa, ob);
            }
        }
    }
    template <class Sh> HD void mid(Acc&, const Unit&, int, int, int, int, const Sh&) const {}
};

#ifndef EMU
#define PG8_LAS __attribute__((address_space(3)))
#define GAS __attribute__((address_space(1)))
#define LAS __attribute__((address_space(3)))
typedef GAS unsigned gu32;
#define RLX_AGENT __ATOMIC_RELAXED, __HIP_MEMORY_SCOPE_AGENT
#define LDS_WAIT() asm volatile("s_waitcnt lgkmcnt(0)" ::: "memory")
#define VM_WAIT() asm volatile("s_waitcnt vmcnt(0)" ::: "memory")
#ifndef ROR_DPP
#define ROR_DPP 1
#endif
struct ShflDev {
    __device__ __forceinline__ float operator()(float v, int src) const { return __shfl(v, src, 64); }
#if ROR_DPP
    __device__ __forceinline__ float ror1(float v) const { return __builtin_bit_cast(float, __builtin_amdgcn_update_dpp(0, __builtin_bit_cast(int, v), 0x121, 0xf, 0xf, false)); }
    __device__ __forceinline__ float ror2(float v) const { return __builtin_bit_cast(float, __builtin_amdgcn_update_dpp(0, __builtin_bit_cast(int, v), 0x122, 0xf, 0xf, false)); }
#else
    __device__ __forceinline__ float ror1(float v) const { const int l = threadIdx.x & 63; return __shfl(v, (l & 48) | ((l + 15) & 15), 64); }
    __device__ __forceinline__ float ror2(float v) const { const int l = threadIdx.x & 63; return __shfl(v, (l & 48) | ((l + 14) & 15), 64); }
#endif
};

__host__ __device__ __forceinline__ int lds_byte(int r, int c) { const int st = (r >> 4) * 2 + (c >> 5), rr = r & 15, cc = c & 31, ob = rr * 64 + cc * 2; return st * 1024 + (ob ^ (((ob >> 9) & 1) << 5)); }
__host__ __device__ __forceinline__ void stage_rc(int b, int& R, int& C) { const int st = b / 1024, sb = b % 1024, swz = sb ^ (((sb >> 9) & 1) << 5); R = (st >> 1) * 16 + swz / 64; C = (st & 1) * 32 + (swz % 64) / 2; }
__host__ __device__ __forceinline__ int perm32(int rho) { const int n = rho >> 4, i = rho & 15; return 8 * (i >> 2) + 4 * n + (i & 3); }

template <class Epi, class Sched, bool ALIGN_EPI = false, bool SP2 = false, bool ACHUNK = false>
__device__ __forceinline__ void gemm_phase(PG8_LAS unsigned char* lds, const Gemm g, const Sched& S, const Epi& E) {
    int tid_ = threadIdx.x; asm volatile("" : "+v"(tid_));
    const int tid = tid_, wid = __builtin_amdgcn_readfirstlane(tid >> 6), lane = tid & 63, wr = wid >> 2, wc = wid & 3, fr = lane & 15, fq = lane >> 4;
    int K_ = g.K; asm volatile("" : "+s"(K_));
    const int K = K_, nt = K / BK;
    unsigned voffA[2], voffB[2];
#pragma unroll
    for (int i = 0; i < 2; ++i) { int R, C; stage_rc(tid * 16 + i * 8192, R, C); const int Rb = Epi::PERM ? ((R & ~31) + perm32(R & 31)) : R;
        const int Ra = ACHUNK ? ((R >> 6) * 62 + (R & 63)) : R; voffA[i] = (unsigned)(Ra * K + C) * 2u; voffB[i] = (unsigned)(Rb * K + C) * 2u; }
    const size_t kstep = (size_t)(BK * 2);
    const size_t hstepB = (size_t)HALF * K * 2, hstepA = ACHUNK ? (size_t)124 * K * 2 : hstepB;
    const size_t tstepA = 2 * hstepA, tstepB = 2 * hstepB;
    const unsigned ldsw = (unsigned)wid * 1024u;
    const int aoff = lds_byte(wr * 64 + fr, fq * 8), boff = lds_byte(wc * 32 + fr, fq * 8);
#define PG8_SA(b, h) (((b) * 2 + (h)) * HTB)
#define PG8_SB(b, h) ((4 + (b) * 2 + (h)) * HTB)
#define PG8_STAGE(bufoff, gbase, voff) do { _Pragma("unroll") for (int _i = 0; _i < 2; ++_i) \
        __builtin_amdgcn_global_load_lds((const unsigned*)((const char*)(gbase) + (voff)[_i]), (PG8_LAS unsigned*)(lds + (bufoff) + ldsw + _i * 8192), 16, 0, 0); } while (0)
#define PG8_LDA(dst, b, h) do { _Pragma("unroll") for (int m = 0; m < 4; ++m) _Pragma("unroll") for (int k = 0; k < 2; ++k) dst[m][k] = *(const PG8_LAS bf16x8*)(lds + PG8_SA(b, h) + aoff + m * 2048 + k * 1024); } while (0)
#define PG8_LDB(dst, b, h) do { _Pragma("unroll") for (int n = 0; n < 2; ++n) _Pragma("unroll") for (int k = 0; k < 2; ++k) dst[n][k] = *(const PG8_LAS bf16x8*)(lds + PG8_SB(b, h) + boff + n * 2048 + k * 1024); } while (0)
#define PG8_MMA(ai, bj, At, Bt) do { __builtin_amdgcn_s_setprio(1); _Pragma("unroll") for (int m = 0; m < 4; ++m) _Pragma("unroll") for (int n = 0; n < 2; ++n) _Pragma("unroll") for (int k = 0; k < 2; ++k) \
        acc[ai][bj][m][n] = __builtin_amdgcn_mfma_f32_16x16x32_bf16(Bt[n][k], At[m][k], acc[ai][bj][m][n], 0, 0, 0); __builtin_amdgcn_s_setprio(0); } while (0)
#define PG8_WAIT_V(n) asm volatile("s_waitcnt vmcnt(" #n ")" ::: "memory")
#define PG8_WAIT_L(n) asm volatile("s_waitcnt lgkmcnt(" #n ")" ::: "memory")
#define PG8_BAR __builtin_amdgcn_s_barrier()
#define PG8_SCHED __builtin_amdgcn_sched_barrier(0)
    Unit cur, nxt; int ui = 0;
    if (!S.next(0, cur)) return;
    f32x4 acc[2][2][4][2];
#pragma unroll
    for (int a = 0; a < 2; ++a)
#pragma unroll
        for (int b = 0; b < 2; ++b)
#pragma unroll
            for (int m = 0; m < 4; ++m)
#pragma unroll
                for (int n = 0; n < 2; ++n) acc[a][b][m][n] = (f32x4){0.f, 0.f, 0.f, 0.f};
    bf16x8 At[4][2], B0[2][2], B1[2][2];
    const char* cA = (const char*)g.A + (size_t)cur.pm * tstepA; const char* cB = (const char*)g.Bt + (size_t)cur.pn * tstepB;
    S.a_ready(cur);
    if constexpr (SP2) {
        PG8_STAGE(PG8_SB(0, 0), cB, voffB); PG8_STAGE(PG8_SB(0, 1), cB + hstepB, voffB); PG8_STAGE(PG8_SA(0, 0), cA, voffA); PG8_STAGE(PG8_SA(0, 1), cA + hstepA, voffA);
        if (wr == 1) PG8_BAR;
        PG8_WAIT_V(2); PG8_BAR;
        PG8_STAGE(PG8_SB(1, 0), cB + kstep, voffB); PG8_STAGE(PG8_SA(1, 0), cA + kstep, voffA); PG8_STAGE(PG8_SB(1, 1), cB + hstepB + kstep, voffB);
        PG8_WAIT_V(6); PG8_BAR;
    } else {
        PG8_STAGE(PG8_SB(0, 0), cB, voffB); PG8_STAGE(PG8_SA(0, 0), cA, voffA); PG8_STAGE(PG8_SB(0, 1), cB + hstepB, voffB); PG8_STAGE(PG8_SA(0, 1), cA + hstepA, voffA);
        if (wr == 1) PG8_BAR;
        PG8_WAIT_V(4); PG8_BAR;
        PG8_STAGE(PG8_SB(1, 0), cB + kstep, voffB); PG8_STAGE(PG8_SA(1, 0), cA + kstep, voffA); PG8_STAGE(PG8_SB(1, 1), cB + hstepB + kstep, voffB);
        PG8_WAIT_V(6); PG8_BAR;
    }
    for (;;) {
        const bool has_next = S.next(ui + 1, nxt);
        const char* nA = has_next ? (const char*)g.A + (size_t)nxt.pm * tstepA : cA; const char* nB = has_next ? (const char*)g.Bt + (size_t)nxt.pn * tstepB : cB;
        for (int t = 0; t < nt; t += 2) {
            const bool last = (t == nt - 2);
            if constexpr (Epi::HAS_MID) { if (t == Epi::MID_T) E.mid(acc, cur, wr, wc, fr, fq, ShflDev{}); }
            const char* a1 = cA + (size_t)(t + 1) * kstep;
            const char* a2 = last ? nA : cA + (size_t)(t + 2) * kstep; const char* b2 = last ? nB : cB + (size_t)(t + 2) * kstep;
            const char* a3 = a2 + kstep; const char* b3 = b2 + kstep;
            if (last && has_next) S.a_ready(nxt);
            if constexpr (SP2) {
            PG8_LDB(B0, 0, 0); PG8_LDB(B1, 0, 1); PG8_SCHED; PG8_LDA(At, 0, 0); PG8_STAGE(PG8_SA(1, 1), a1 + hstepA, voffA);
            PG8_WAIT_V(8); PG8_WAIT_L(0); PG8_BAR; PG8_MMA(0, 0, At, B0); PG8_MMA(0, 1, At, B1); PG8_BAR; PG8_SCHED;
            PG8_LDA(At, 0, 1); PG8_STAGE(PG8_SB(0, 0), b2, voffB); PG8_STAGE(PG8_SB(0, 1), b2 + hstepB, voffB); PG8_STAGE(PG8_SA(0, 0), a2, voffA);
            PG8_WAIT_V(8); PG8_WAIT_L(0); PG8_BAR; PG8_MMA(1, 0, At, B0); PG8_MMA(1, 1, At, B1); PG8_BAR; PG8_SCHED;
            PG8_LDB(B0, 1, 0); PG8_LDB(B1, 1, 1); PG8_SCHED; PG8_LDA(At, 1, 0); PG8_STAGE(PG8_SA(0, 1), a2 + hstepA, voffA);
            PG8_WAIT_V(8); PG8_WAIT_L(0); PG8_BAR; PG8_MMA(0, 0, At, B0); PG8_MMA(0, 1, At, B1); PG8_BAR; PG8_SCHED;
            PG8_LDA(At, 1, 1); PG8_STAGE(PG8_SB(1, 0), b3, voffB); PG8_STAGE(PG8_SB(1, 1), b3 + hstepB, voffB); PG8_STAGE(PG8_SA(1, 0), a3, voffA);
            PG8_WAIT_V(8); PG8_WAIT_L(0); PG8_BAR; PG8_MMA(1, 0, At, B0); PG8_MMA(1, 1, At, B1); PG8_BAR; PG8_SCHED;
            } else {
            PG8_LDB(B0, 0, 0); PG8_SCHED; PG8_LDA(At, 0, 0); PG8_STAGE(PG8_SA(1, 1), a1 + hstepA, voffA);
            PG8_WAIT_L(8); PG8_BAR; PG8_WAIT_L(0); PG8_MMA(0, 0, At, B0); PG8_BAR; PG8_SCHED;
            PG8_LDB(B1, 0, 1); PG8_STAGE(PG8_SB(0, 0), b2, voffB);
            PG8_BAR; PG8_WAIT_L(0); PG8_MMA(0, 1, At, B1); PG8_BAR;
            PG8_LDA(At, 0, 1); PG8_STAGE(PG8_SA(0, 0), a2, voffA);
            PG8_BAR; PG8_WAIT_L(0); PG8_MMA(1, 0, At, B0); PG8_BAR; PG8_SCHED;
            PG8_STAGE(PG8_SB(0, 1), b2 + hstepB, voffB);
            PG8_WAIT_V(6); PG8_BAR; PG8_MMA(1, 1, At, B1); PG8_BAR;
            PG8_LDB(B0, 1, 0); PG8_SCHED; PG8_LDA(At, 1, 0); PG8_STAGE(PG8_SA(0, 1), a2 + hstepA, voffA);
            PG8_WAIT_L(8); PG8_BAR; PG8_WAIT_L(0); PG8_MMA(0, 0, At, B0); PG8_BAR; PG8_SCHED;
            PG8_LDB(B1, 1, 1); PG8_STAGE(PG8_SB(1, 0), b3, voffB);
            PG8_BAR; PG8_WAIT_L(0); PG8_MMA(0, 1, At, B1); PG8_BAR;
            PG8_LDA(At, 1, 1); PG8_STAGE(PG8_SA(1, 0), a3, voffA);
            PG8_BAR; PG8_WAIT_L(0); PG8_MMA(1, 0, At, B0); PG8_BAR; PG8_SCHED;
            PG8_STAGE(PG8_SB(1, 1), b3 + hstepB, voffB);
            PG8_WAIT_V(6); PG8_BAR; PG8_MMA(1, 1, At, B1); PG8_BAR;
            }
        }
        if constexpr (ALIGN_EPI) { if (wr == 0) PG8_BAR; }
        if constexpr (!Epi::AFTER_DRAIN) { E(acc, cur, wr, wc, fr, fq, ShflDev{}); S.done(cur); }
        if (!has_next) break;
#pragma unroll
        for (int a = 0; a < 2; ++a)
#pragma unroll
            for (int b = 0; b < 2; ++b)
#pragma unroll
                for (int m = 0; m < 4; ++m)
#pragma unroll
                    for (int n = 0; n < 2; ++n) acc[a][b][m][n] = (f32x4){0.f, 0.f, 0.f, 0.f};
        cur = nxt; cA = nA; cB = nB; ++ui;
        if constexpr (ALIGN_EPI) { if (wr == 1) PG8_BAR; }
    }
    PG8_WAIT_V(0);
    if constexpr (!ALIGN_EPI) { if (wr == 0) PG8_BAR; }
    PG8_BAR;
#undef PG8_SA
#undef PG8_SB
#undef PG8_STAGE
#undef PG8_LDA
#undef PG8_LDB
#undef PG8_MMA
#undef PG8_WAIT_V
#undef PG8_WAIT_L
#undef PG8_BAR
#undef PG8_SCHED
}

constexpr int NWAVES = 8;
#ifndef MK_PER_PHASE
#define MK_PER_PHASE 0
#endif
constexpr int N_PHASES = 8 * NLAYER + 1;

constexpr size_t MiB = 1u << 20;
constexpr size_t WS_CTL = 0, CTL_ZERO_BYTES = 64 * 1024;
constexpr size_t WS_SS0 = 1 * MiB, WS_SS1 = 2 * MiB;
constexpr size_t WS_WB = 3 * MiB;
constexpr size_t WB_WIN = 0, WB_WAB = WB_WIN + (size_t)NIN * D, WB_WO = WB_WAB + (size_t)D * D, WB_WUP = WB_WO + (size_t)D * D, WB_WDN = WB_WUP + (size_t)NUP * D,
                 WB_WPG = WB_WDN + (size_t)D * DFF, WB_WPL = WB_WPG + (size_t)D * D, WB_END = WB_WPL + (size_t)D * PLE;
static_assert(WB_END * 2 == 32 * MiB, "weight copies fill 32 MiB");
constexpr size_t WS_PB = 35 * MiB;
constexpr size_t WS_XB = 44 * MiB;
constexpr size_t WS_ACT = 77 * MiB;
constexpr size_t WS_AGLU = WS_ACT, WS_CV = WS_ACT + 16 * MiB, WS_BS = WS_ACT + 32 * MiB, WS_GR = WS_ACT + 48 * MiB, WS_GB = WS_ACT + 80 * MiB,
                 WS_A2S = WS_ACT + 112 * MiB, WS_E = WS_ACT + 144 * MiB, WS_END = WS_ACT + 176 * MiB;
constexpr size_t WS_MG = WS_AGLU;
constexpr size_t WS_F = WS_ACT;
constexpr size_t WS_XB2 = WS_A2S;
static_assert(WS_END <= 256 * MiB && WS_F + (size_t)M * DFF * 2 <= WS_A2S && WS_XB + (size_t)(M + 256) * D * 2 <= WS_ACT, "d_ws map");
constexpr int CW_BAR = 4096;

constexpr int RING_OFF = 0, RING_BYTES = 131072;
constexpr int LDSCTL_OFF = RING_BYTES, MISC_OFF = LDSCTL_OFF + 320;
constexpr int LDS_BYTES = 147456;
static_assert(MISC_OFF + 128 <= LDS_BYTES, "LDS map");

#define XB_TMO      128
#define XB_XCNT(j)  (256  + 64 * (j))
#define XB_XSUB(j)  (1280 + 64 * (j))
#define XB_XGEN(j)  (2304 + 64 * (j))
#define XB_TOP      3328
#define XB_TOPGEN   3392
#define XCD_BAR_WORDS 3456
#define XB_SPIN_CAP (1u << 18)

__device__ __forceinline__ unsigned xb_ld(unsigned* p)              { return __hip_atomic_load(p, __ATOMIC_RELAXED, __HIP_MEMORY_SCOPE_AGENT); }
__device__ __forceinline__ unsigned xb_add(unsigned* p, unsigned v) { return __hip_atomic_fetch_add(p, v, __ATOMIC_RELAXED, __HIP_MEMORY_SCOPE_AGENT); }
__device__ __forceinline__ unsigned xb_xcc_id() { return (unsigned)__builtin_amdgcn_s_getreg((3 << 11) | 20) & 0xFu; }
#define XB_SPIN(cond, bar) do { unsigned _sp = 0; while (cond) { __builtin_amdgcn_s_sleep(1); \
    if ((++_sp & 255u) == 0u) { if (xb_ld(&(bar)[XB_TMO])) break; if (_sp > XB_SPIN_CAP) { atomicAdd(&(bar)[XB_TMO], 1u); break; } } } } while (0)

struct XcdBarrier {
    unsigned* bar; unsigned x;
    volatile LAS unsigned* st;
};

__device__ __forceinline__ XcdBarrier xcd_barrier_post(unsigned* bar, volatile LAS unsigned* st) {
    XcdBarrier b; b.bar = bar; b.x = xb_xcc_id(); b.st = st;
    if (threadIdx.x == 0) (void)xb_add(&bar[XB_XCNT(b.x)], 1u);
    return b;
}
__device__ __forceinline__ void xcd_barrier_complete(unsigned* bar, unsigned x, unsigned& nloc, unsigned& nx) {
    const unsigned G = gridDim.x * gridDim.y * gridDim.z;
    unsigned sum, cnt, mine, sp = 0u;
    for (;;) {
        sum = 0u; cnt = 0u; mine = 0u;
#pragma unroll
        for (unsigned j = 0; j < 16; ++j) { const unsigned c = xb_ld(&bar[XB_XCNT(j)]); sum += c; cnt += (c > 0u) ? 1u : 0u; mine = (j == x) ? c : mine; }
        if (sum == G) break;
        __builtin_amdgcn_s_sleep(1);
        if ((++sp & 255u) == 0u) { if (xb_ld(&bar[XB_TMO])) break; if (sp > XB_SPIN_CAP) { atomicAdd(&bar[XB_TMO], 1u); break; } }
    }
    nloc = mine > 0u ? mine : 1u; nx = cnt > 0u ? cnt : 1u;
}

__device__ __forceinline__ void xcd_barrier(const XcdBarrier& b) {
    asm volatile("s_waitcnt vmcnt(0)" ::: "memory");
    __syncthreads();
    if (threadIdx.x == 0) {
        unsigned* bar = b.bar;
        __builtin_amdgcn_s_waitcnt(0);
        unsigned nloc = b.st[0], nx = b.st[1];
        if (nloc == 0u) { xcd_barrier_complete(bar, b.x, nloc, nx); b.st[0] = nloc; b.st[1] = nx; }
        const unsigned old = xb_add(&bar[XB_XSUB(b.x)], 1u);
        const unsigned gen = old / nloc;
        if (old + 1u == (gen + 1u) * nloc) {
            __builtin_amdgcn_fence(__ATOMIC_RELEASE, "agent");
            asm volatile("s_waitcnt vmcnt(0)" ::: "memory");
            const unsigned og = xb_add(&bar[XB_TOP], 1u);
            const unsigned tg = og / nx;
            if (og + 1u == (tg + 1u) * nx) xb_add(&bar[XB_TOPGEN], 1u);
            else XB_SPIN(xb_ld(&bar[XB_TOPGEN]) == tg, bar);
            __builtin_amdgcn_fence(__ATOMIC_ACQUIRE, "agent");
            xb_add(&bar[XB_XGEN(b.x)], 1u);
            asm volatile("s_waitcnt vmcnt(0)" ::: "memory");
        } else {
            XB_SPIN(xb_ld(&bar[XB_XGEN(b.x)]) == gen, bar);
            __builtin_amdgcn_fence(__ATOMIC_ACQUIRE, "agent");
            asm volatile("s_waitcnt vmcnt(0)" ::: "memory");
        }
    }
    __syncthreads();
}

struct Frame {
    LAS unsigned char* lds;
    volatile LAS unsigned* MISC;
    gu32* ctl;
    int tid, lane, wave;
    int vcu, G;
    float* out; unsigned char* ws;
};
__device__ __forceinline__ float wave_sum(float v) {
#pragma unroll
    for (int o = 1; o < 64; o <<= 1) v += __shfl_xor(v, o, 64);
    return v;
}

__device__ __forceinline__ void cv_item(const float* W, int N, const float* gk, bf16_t* WT, int ldt, int kofs, int drow, int kb, int nb, LAS float* scr, int lane) {
    const int k0 = 64 * kb, n0 = 32 * nb;
#pragma unroll 8
    for (int i = 0; i < 32; ++i) { const int kk = 2 * i + (lane >> 5); float v = W[(size_t)(k0 + kk) * N + n0 + (lane & 31)]; if (gk) v *= gk[k0 + kk]; scr[kk * 33 + (lane & 31)] = v; }
    LDS_WAIT(); asm volatile("" ::: "memory");
    const int c = lane & 7;
#pragma unroll
    for (int j = 0; j < 4; ++j) { const int n = (lane >> 3) + 8 * j; const LAS float* s = scr + (8 * c) * 33 + n;
        u32x4 o; o.x = pk2(s[0 * 33], s[1 * 33]); o.y = pk2(s[2 * 33], s[3 * 33]); o.z = pk2(s[4 * 33], s[5 * 33]); o.w = pk2(s[6 * 33], s[7 * 33]);
        *(GAS u32x4*)(WT + (size_t)(drow + n) * ldt + kofs + k0 + 8 * c) = o; }
    LDS_WAIT(); asm volatile("" ::: "memory");
}
struct CvPtrs { const float *x, *p, *g_mix, *w_in, *w_a, *w_b, *w_o, *g_ffn, *w_up, *w_dn, *g_ple, *w_pl, *w_pg; };
__device__ __forceinline__ void cv_phase(Frame& F, int layer, const CvPtrs& P) {
    LAS float* scr = (LAS float*)(F.lds + RING_OFF + F.wave * 16384);
    const int gw = F.vcu * NWAVES + F.wave, NGW = F.G * NWAVES;
    bf16_t* WB = (bf16_t*)(F.ws + WS_WB);
    const float* w_in = P.w_in + (size_t)layer * D * NIN;      const float* g_mix = P.g_mix + layer * D;
    const float* w_a = P.w_a + (size_t)layer * DC * D;          const float* w_b = P.w_b + (size_t)layer * DSC * D;
    const float* w_o = P.w_o + (size_t)layer * D * D;           const float* g_ffn = P.g_ffn + layer * D;
    const float* w_up = P.w_up + (size_t)layer * D * NUP;       const float* w_dn = P.w_dn + (size_t)layer * DFF * D;
    const float* g_ple = P.g_ple + layer * D;                   const float* w_pl = P.w_pl + (size_t)layer * PLE * D;
    const float* w_pg = P.w_pg + (size_t)layer * D * D;
    constexpr int I_IN = (D / 64) * (NIN / 32), I_A = (DC / 64) * (D / 32), I_O = (D / 64) * (D / 32), I_UP = (D / 64) * (NUP / 32), I_DN = (DFF / 64) * (D / 32), I_PL = (PLE / 64) * (D / 32);
    constexpr int NITEMS = I_IN + 2 * I_A + I_O + I_UP + I_DN + I_O + I_PL;
    for (int it = gw; it < NITEMS; it += NGW) {
        int r = it;
        if (r < I_IN) { const int nblk = NIN / 32, kb = r / nblk, nb = r % nblk; cv_item(w_in, NIN, g_mix, WB + WB_WIN, D, 0, win_dst(32 * nb), kb, nb, scr, F.lane); continue; } r -= I_IN;
        if (r < I_A)  { const int nblk = D / 32, kb = r / nblk, nb = r % nblk; cv_item(w_a, D, nullptr, WB + WB_WAB, D, 0, 32 * nb, kb, nb, scr, F.lane); continue; } r -= I_A;
        if (r < I_A)  { const int nblk = D / 32, kb = r / nblk, nb = r % nblk; cv_item(w_b, D, nullptr, WB + WB_WAB, D, DC, 32 * nb, kb, nb, scr, F.lane); continue; } r -= I_A;
        if (r < I_O)  { const int nblk = D / 32, kb = r / nblk, nb = r % nblk; cv_item(w_o, D, nullptr, WB + WB_WO, D, 0, 32 * nb, kb, nb, scr, F.lane); continue; } r -= I_O;
        if (r < I_UP) { const int nblk = NUP / 32, kb = r / nblk, nb = r % nblk; cv_item(w_up, NUP, g_ffn, WB + WB_WUP, D, 0, wup_dst(32 * nb), kb, nb, scr, F.lane); continue; } r -= I_UP;
        if (r < I_DN) { const int nblk = D / 32, kb = r / nblk, nb = r % nblk; cv_item(w_dn, D, nullptr, WB + WB_WDN, DFF, 0, 32 * nb, kb, nb, scr, F.lane); continue; } r -= I_DN;
        if (r < I_O)  { const int nblk = D / 32, kb = r / nblk, nb = r % nblk; cv_item(w_pg, D, g_ple, WB + WB_WPG, D, 0, 32 * nb, kb, nb, scr, F.lane); continue; } r -= I_O;
        { const int nblk = D / 32, kb = r / nblk, nb = r % nblk; cv_item(w_pl, D, nullptr, WB + WB_WPL, PLE, 0, 32 * nb, kb, nb, scr, F.lane); }
    }
    { const GAS f32x4* src = (const GAS f32x4*)(P.p + (size_t)layer * M * PLE); GAS u32x2* dst = (GAS u32x2*)(F.ws + WS_PB);
      const int gt = F.vcu * (NWAVES * 64) + F.tid, NT = F.G * NWAVES * 64;
      for (int i = gt; i < M * PLE / 4; i += NT) dst[i] = pk4(src[i]); }
    if (layer == 0) {
        for (int m = gw; m < M; m += NGW) {
            const GAS f32x4* xr = (const GAS f32x4*)(P.x + (size_t)m * D) + F.lane; GAS u32x2* o8 = (GAS u32x2*)(F.ws + WS_XB + (size_t)m * D * 2) + F.lane;
            float s = 0.f;
#pragma unroll
            for (int j = 0; j < 4; ++j) { const f32x4 v = xr[64 * j]; s += (v[0] * v[0] + v[1] * v[1]) + (v[2] * v[2] + v[3] * v[3]); o8[64 * j] = pk4(v); }
            s = wave_sum(s);
            if (F.lane < 16) ((GAS float*)(F.ws + WS_SS0))[(size_t)m * 16 + F.lane] = F.lane == 0 ? s : 0.f;
        }
    }
}

constexpr int CO_R = 16;
template <int S> struct CoStep {
    static __device__ __forceinline__ void run(f32x2 (&acc)[CO_R], const f32x2 (&w)[CKA], const GAS unsigned* src, int g0, int t0, int cw) {
        const int ts = t0 - (CKA - 1) + S; const bool ok = ts >= 0;
        const unsigned wd = src[(size_t)(ok ? g0 - (CKA - 1) + S : g0) * (DC / 2) + cw];
        f32x2 a; a.x = ok ? bf_lo(wd) : 0.f; a.y = ok ? bf_hi(wd) : 0.f;
#pragma unroll
        for (int r = 0; r < CO_R; ++r) { constexpr int dummy = 0; (void)dummy; const int k = S - r; if (k >= 0 && k < CKA) acc[r] += w[k] * a; }
        CoStep<S + 1>::run(acc, w, src, g0, t0, cw);
    }
};
template <> struct CoStep<CO_R + CKA - 1> { static __device__ __forceinline__ void run(f32x2 (&)[CO_R], const f32x2 (&)[CKA], const GAS unsigned*, int, int, int) {} };
__device__ __forceinline__ void co_phase(Frame& F, int layer, const float* cwa_, const float* cba_, const float* lng_, const float* lnb_, const float* cwb_) {
    const int grp = F.tid >> 8, wv = (F.tid >> 6) & 3, c0 = wv * 128 + F.lane * 2;
    const float* cwa = cwa_ + (size_t)layer * CKA * DC; const float* cba = cba_ + layer * DC; const float* lng = lng_ + layer * DC; const float* lnb = lnb_ + layer * DC;
    const float* cwb = cwb_ + (size_t)layer * 3 * DSC;
    const GAS unsigned* AGLU = (const GAS unsigned*)(F.ws + WS_AGLU); const GAS unsigned* CVp = (const GAS unsigned*)(F.ws + WS_CV); const GAS unsigned* BSp = (const GAS unsigned*)(F.ws + WS_BS);
    GAS unsigned* A2S = (GAS unsigned*)(F.ws + WS_A2S);
    LAS f32x2* part = (LAS f32x2*)(F.lds + RING_OFF) + grp * (CO_R * 4);
    f32x2 w[CKA];
#pragma unroll
    for (int k = 0; k < CKA; ++k) w[k] = *(const f32x2*)(cwa + k * DC + c0);
    const f32x2 bias = *(const f32x2*)(cba + c0), lg = *(const f32x2*)(lng + c0), lb = *(const f32x2*)(lnb + c0);
    const f32x2 wb0 = *(const f32x2*)(cwb + c0), wb1 = *(const f32x2*)(cwb + DSC + c0), wb2 = *(const f32x2*)(cwb + 2 * DSC + c0);
    constexpr int NITEM = M / CO_R;
    const int ngrp = 2 * F.G;
    for (int it0 = 0; it0 < NITEM; it0 += ngrp) {
        const int it = it0 + F.vcu * 2 + grp; const bool live = it < NITEM;
        const int g0 = (live ? it : 0) * CO_R, t0 = g0 % SEQ;
        f32x2 acc[CO_R];
#pragma unroll
        for (int r = 0; r < CO_R; ++r) acc[r] = bias;
        CoStep<0>::run(acc, w, AGLU, g0, t0, c0 >> 1);
#pragma unroll
        for (int r = 0; r < CO_R; ++r) {
            float s1 = acc[r].x + acc[r].y, s2 = acc[r].x * acc[r].x + acc[r].y * acc[r].y;
            s1 = wave_sum(s1); s2 = wave_sum(s2);
            if (F.lane == 0) part[r * 4 + wv] = (f32x2){s1, s2};
        }
        __syncthreads();
#pragma unroll
        for (int r = 0; r < CO_R; ++r) {
            const f32x2 p0 = part[r * 4 + 0], p1 = part[r * 4 + 1], p2 = part[r * 4 + 2], p3 = part[r * 4 + 3];
            const float mean = ((p0.x + p1.x) + (p2.x + p3.x)) * (1.0f / DC), ex2 = ((p0.y + p1.y) + (p2.y + p3.y)) * (1.0f / DC);
            const float var = fmaxf(ex2 - mean * mean, 0.f), rstd = frsq(var + EPS);
            float y0 = (acc[r].x - mean) * rstd * lg.x + lb.x, y1 = (acc[r].y - mean) * rstd * lg.y + lb.y;
            y0 = y0 * sigm(y0); y1 = y1 * sigm(y1);
            if (live) A2S[(size_t)(g0 + r) * (D / 2) + (c0 >> 1)] = pk2(y0, y1);
        }
        {
            f32x2 c2 = {0.f, 0.f}, c1 = {0.f, 0.f};
            if (t0 >= 2) { const unsigned wd = CVp[(size_t)(g0 - 2) * (DSC / 2) + (c0 >> 1)]; c2 = (f32x2){bf_lo(wd), bf_hi(wd)}; }
            if (t0 >= 1) { const unsigned wd = CVp[(size_t)(g0 - 1) * (DSC / 2) + (c0 >> 1)]; c1 = (f32x2){bf_lo(wd), bf_hi(wd)}; }
#pragma unroll 8
            for (int r = 0; r < CO_R; ++r) {
                const unsigned wc_ = CVp[(size_t)(g0 + r) * (DSC / 2) + (c0 >> 1)], wb_ = BSp[(size_t)(g0 + r) * (DSC / 2) + (c0 >> 1)];
                const f32x2 c = {bf_lo(wc_), bf_hi(wc_)}, b = {bf_lo(wb_), bf_hi(wb_)};
                const f32x2 o = b * (wb0 * c2 + wb1 * c1 + wb2 * c);
                if (live) A2S[(size_t)(g0 + r) * (D / 2) + (DC >> 1) + (c0 >> 1)] = pk2(o.x, o.y);
                c2 = c1; c1 = c;
            }
        }
        __syncthreads();
    }
}

__device__ __forceinline__ void final_phase(Frame& F, const float* g_final) {
    const int gw = F.vcu * NWAVES + F.wave, NGW = F.G * NWAVES;
    const float* SS = (const float*)(F.ws + ((NLAYER & 1) ? WS_SS1 : WS_SS0));
    const f32x4* gf = (const f32x4*)g_final + F.lane;
    f32x4 gv[4];
#pragma unroll
    for (int j = 0; j < 4; ++j) gv[j] = gf[64 * j];
    for (int m = gw; m < M; m += NGW) {
        const float rs = row_rs(SS, m);
        const GAS u32x2* xr = (const GAS u32x2*)(F.ws + WS_XB2 + (size_t)m * D * 2) + F.lane; GAS f32x4* orow = (GAS f32x4*)(F.out + (size_t)m * D) + F.lane;
#pragma unroll
        for (int j = 0; j < 4; ++j) orow[64 * j] = unpk4(xr[64 * j]) * rs * gv[j];
    }
}

struct Args { const float* in[22]; float* out; unsigned char* ws; int ph_lo, ph_hi, li, pad; };
__global__ void __launch_bounds__(NWAVES * 64, 2) fwd_kernel(Args args) {
    extern __shared__ __attribute__((aligned(16))) unsigned char lds[];
    Frame F;
    F.lds = (LAS unsigned char*)lds;
    F.MISC = (volatile LAS unsigned*)(F.lds + MISC_OFF);
    F.tid = threadIdx.x; F.lane = F.tid & 63; F.wave = __builtin_amdgcn_readfirstlane(F.tid >> 6);
    F.G = gridDim.x; { const int bx = blockIdx.x; F.vcu = (F.G % 8 == 0) ? (bx % 8) * (F.G / 8) + bx / 8 : bx; }
    unsigned char* ws = args.ws; F.ws = ws; F.out = args.out;
    F.ctl = (gu32*)(ws + WS_CTL);
    for (int u = F.tid; u < (LDS_BYTES - LDSCTL_OFF) / 4; u += NWAVES * 64) ((LAS unsigned*)(F.lds + LDSCTL_OFF))[u] = 0u;
    __syncthreads();
    XcdBarrier bar; bar.bar = (unsigned*)(F.ctl + CW_BAR); bar.x = 0; bar.st = nullptr;
    if (!MK_PER_PHASE) bar = xcd_barrier_post((unsigned*)(F.ctl + CW_BAR), F.MISC + 8);

    bf16_t* WB = (bf16_t*)(ws + WS_WB);
    const int lo = args.ph_lo, hi = args.ph_hi;
#ifndef DUP_MASK
#define DUP_MASK 0u
#endif
    const int qlo = lo + __builtin_popcount((unsigned)DUP_MASK & ((1u << lo) - 1u)), qhi = hi + __builtin_popcount((unsigned)DUP_MASK & ((1u << hi) - 1u));
    for (int q = qlo; q < qhi; ++q) {
        int p = 0; while (p + 1 + __builtin_popcount((unsigned)DUP_MASK & ((1u << (p + 1)) - 1u)) <= q) ++p;
        const int layer = p >> 3, k = p & 7;
        { int tv = threadIdx.x; asm volatile("" : "+v"(tv)); F.tid = tv; F.lane = tv & 63; F.wave = __builtin_amdgcn_readfirstlane(tv >> 6); }
        float* SSa = (float*)(ws + ((layer & 1) ? WS_SS1 : WS_SS0));
        float* SSb = (float*)(ws + ((layer & 1) ? WS_SS0 : WS_SS1));
#ifndef PHMASK
#define PHMASK 0x1ff
#endif
        if (p == N_PHASES - 1) { if (PHMASK & 0x100) final_phase(F, args.in[21]); }
        else if (k == 0) { if (PHMASK & 1) { const CvPtrs P{args.in[0], args.in[1], args.in[2], args.in[3], args.in[9], args.in[11], args.in[12], args.in[13], args.in[14], args.in[17], args.in[18], args.in[19], args.in[20]}; cv_phase(F, layer, P); } }
        else if (k == 1) { if (PHMASK & 2) {
#ifndef NO_EG
            {
                Gemm g{(const bf16_t*)(ws + WS_PB), WB + WB_WPL, PLE}; StaticOrder S; S.init(M / BM, D / BM, F.G, (int)blockIdx.x);
                EpiE E{(bf16_t*)(ws + WS_E)};
                gemm_phase<EpiE, StaticOrder, false, true, false>(F.lds + RING_OFF, g, S, E);
            }
#endif
#ifndef NO_IN
            {
                Gemm g{layer == 0 ? (const bf16_t*)(ws + WS_XB) : (const bf16_t*)F.out, WB + WB_WIN, D};   StaticOrder S; S.init(M / BM, NIN / BM, F.G, (int)blockIdx.x);
                EpiIn E{SSa, args.in[4] + (size_t)layer * 2 * D, (bf16_t*)(ws + WS_AGLU), (bf16_t*)(ws + WS_CV), (bf16_t*)(ws + WS_BS), (bf16_t*)(ws + WS_GR), (bf16_t*)(ws + WS_GB)};
                gemm_phase<EpiIn, StaticOrder, true, true, false>(F.lds + RING_OFF, g, S, E);
            }
#endif
        } }
        else if (k == 2) { if (PHMASK & 4) co_phase(F, layer, args.in[5], args.in[6], args.in[7], args.in[8], args.in[10]); }
        else if (k == 3) { if (PHMASK & 8) {
            Gemm g{(const bf16_t*)(ws + WS_A2S), WB + WB_WAB, D}; StaticOrder S; S.init(M / BM, D / BM, F.G, (int)blockIdx.x);
            EpiMerge E{(const bf16_t*)(ws + WS_GR), (const bf16_t*)(ws + WS_GB), (bf16_t*)(ws + WS_MG)};
            gemm_phase<EpiMerge, StaticOrder, false, true, false>(F.lds + RING_OFF, g, S, E);
        } }
        else if (k == 4) { if (PHMASK & 16) {
            Gemm g{(const bf16_t*)(ws + WS_MG), WB + WB_WO, D}; StaticOrder S; S.init(M / BM, D / BM, F.G, (int)blockIdx.x);
            EpiRes<0> E{layer == 0 ? (const bf16_t*)(ws + WS_XB) : (const bf16_t*)F.out, (bf16_t*)(ws + WS_XB), SSb, nullptr, nullptr};
            gemm_phase<EpiRes<0>, StaticOrder, false, true, false>(F.lds + RING_OFF, g, S, E);
        } }
        else if (k == 5) { if (PHMASK & 32) {
            Gemm g{(const bf16_t*)(ws + WS_XB) - 2 * D, WB + WB_WUP, D}; StaticOrder S; S.init(NT_UP, NUP / BM, F.G, (int)blockIdx.x);
            EpiUp E{SSb, args.in[15] + (size_t)layer * 3 * DFF, args.in[16] + (size_t)layer * DFF, (bf16_t*)(ws + WS_F)};
            gemm_phase<EpiUp, StaticOrder, true, true, true>(F.lds + RING_OFF, g, S, E);
        } }
        else if (k == 6) { if (PHMASK & 64) {
            Gemm g{(const bf16_t*)(ws + WS_F), WB + WB_WDN, DFF}; StaticOrder S; S.init(M / BM, D / BM, F.G, (int)blockIdx.x);
            EpiRes<0> E{(const bf16_t*)(ws + WS_XB), (bf16_t*)(ws + WS_XB), SSa, nullptr, nullptr};
            gemm_phase<EpiRes<0>, StaticOrder, false, true, false>(F.lds + RING_OFF, g, S, E);
        } }
        else { if (PHMASK & 128) {
            Gemm g{(const bf16_t*)(ws + WS_XB), WB + WB_WPG, D}; StaticOrder S; S.init(M / BM, D / BM, F.G, (int)blockIdx.x);
            EpiRes<1> E{(const bf16_t*)(ws + WS_XB), layer == NLAYER - 1 ? (bf16_t*)(ws + WS_XB2) : (bf16_t*)F.out, SSb, SSa, (const bf16_t*)(ws + WS_E)};
            gemm_phase<EpiRes<1>, StaticOrder, false, true, false>(F.lds + RING_OFF, g, S, E);
        } }
        if (q + 1 < qhi) xcd_barrier(bar);
    }
}

extern "C" void kernel_launch(void* const* d_in, const int* in_sizes, int n_in, void* d_out, int out_size, void* d_ws, size_t ws_size, hipStream_t stream) {
    static int grid = 0;
    if (grid == 0) {
        if (n_in != 22 || in_sizes[0] != M * D || out_size != M * D || ws_size < WS_END) { fprintf(stderr, "kernel_launch: built for 22 inputs, x and out of %d floats, >= %zu bytes of workspace; got n_in %d, in0 %d, out %d, ws %zu; nothing launched\n", M * D, (size_t)WS_END, n_in, n_in > 0 ? in_sizes[0] : -1, out_size, ws_size); grid = -1; return; }
        int dev = 0, cus = 0, per_cu = 0;
        if (hipGetDevice(&dev) != hipSuccess || hipDeviceGetAttribute(&cus, hipDeviceAttributeMultiprocessorCount, dev) != hipSuccess) { fprintf(stderr, "kernel_launch: hipGetDevice / hipDeviceGetAttribute failed; nothing launched\n"); grid = -1; return; }
        if (hipFuncSetAttribute((const void*)fwd_kernel, hipFuncAttributeMaxDynamicSharedMemorySize, LDS_BYTES) != hipSuccess) { fprintf(stderr, "kernel_launch: hipFuncSetAttribute failed\n"); grid = -1; return; }
        if (hipOccupancyMaxActiveBlocksPerMultiprocessor(&per_cu, (const void*)fwd_kernel, NWAVES * 64, LDS_BYTES) != hipSuccess || per_cu < 1)
            fprintf(stderr, "kernel_launch: note: the occupancy query reports %d workgroups per CU\n", per_cu);
        (void)hipGetLastError();
        grid = cus;
    }
    if (grid < 0) return;
    if (hipMemsetAsync((char*)d_ws + WS_CTL, 0, CTL_ZERO_BYTES, stream) != hipSuccess) { fprintf(stderr, "kernel_launch: hipMemsetAsync of the control words failed; nothing launched\n"); return; }
    Args a{};
    for (int i = 0; i < 22; ++i) a.in[i] = (const float*)d_in[i];
    a.out = (float*)d_out; a.ws = (unsigned char*)d_ws;
    const int nl = MK_PER_PHASE ? N_PHASES : 1;
    for (int li = 0; li < nl; ++li) {
        a.ph_lo = MK_PER_PHASE ? li : 0; a.ph_hi = MK_PER_PHASE ? li + 1 : N_PHASES; a.li = li;
        hipLaunchKernelGGL(fwd_kernel, dim3(grid), dim3(NWAVES * 64), LDS_BYTES, stream, a);
        const hipError_t le = hipPeekAtLastError();
        if (le != hipSuccess) { fprintf(stderr, "kernel_launch: launch %d failed: %s (grid %d x %d threads, %d B LDS)\n", li, hipGetErrorName(le), grid, NWAVES * 64, LDS_BYTES); break; }
    }
}
#endif
```

```cpp
#ifndef EMU
#include <hip/hip_runtime.h>
#include <cstdio>
#include <cstdint>
#define HD __host__ __device__ __forceinline__
#else
#include <cstdio>
#include <cstdint>
#include <cmath>
#include <cstring>
#define HD inline
#endif

#ifndef SEQ_LEN
#define SEQ_LEN 8192
#endif
constexpr int BATCH = 2, SEQ = SEQ_LEN, D = 1024, M = BATCH * SEQ;
constexpr int DC = 512, DSC = 512, NIN = 4608, DFF = 2816, NUP = 2 * DFF, PLE = 256, CKA = 31, NLAYER = 2;
constexpr float EPS = 1e-6f;
constexpr int NQ_UP = (M + 61) / 62;
constexpr int NT_UP = (NQ_UP + 3) / 4;

typedef unsigned short bf16_t;
typedef short bf16x8 __attribute__((ext_vector_type(8)));
typedef float f32x4 __attribute__((ext_vector_type(4)));
typedef float f32x2 __attribute__((ext_vector_type(2)));
typedef unsigned u32x4 __attribute__((ext_vector_type(4)));
typedef unsigned u32x2 __attribute__((ext_vector_type(2)));

HD float bits2f(unsigned u) { return __builtin_bit_cast(float, u); }
HD unsigned f2bits(float f) { return __builtin_bit_cast(unsigned, f); }
HD unsigned f2bf(float f) { unsigned u = f2bits(f); return (u + 0x7fffu + ((u >> 16) & 1u)) >> 16; }
HD unsigned pk2(float lo, float hi) {
#if defined(__HIP_DEVICE_COMPILE__)
    unsigned r; asm volatile("v_cvt_pk_bf16_f32 %0, %1, %2" : "=v"(r) : "v"(lo), "v"(hi)); return r;
#else
    return f2bf(lo) | (f2bf(hi) << 16);
#endif
}
HD float bf_lo(unsigned w) { return bits2f(w << 16); }
HD float bf_hi(unsigned w) { return bits2f(w & 0xffff0000u); }
HD float fexp2(float x) {
#if defined(__HIP_DEVICE_COMPILE__)
    return __builtin_amdgcn_exp2f(x);
#else
    return exp2f(x);
#endif
}
HD float frcp(float x) {
#if defined(__HIP_DEVICE_COMPILE__)
    return __builtin_amdgcn_rcpf(x);
#else
    return 1.0f / x;
#endif
}
HD float frsq(float x) {
#if defined(__HIP_DEVICE_COMPILE__)
    return __builtin_amdgcn_rsqf(x);
#else
    return 1.0f / sqrtf(x);
#endif
}
HD float sigm(float x) { return frcp(1.0f + fexp2(-1.44269504089f * x)); }
HD float gelu_tanh(float x) { const float y = x * (1.5957691216f + 0.0713548163f * x * x); return x * sigm(y); }
HD f32x4 sigm4(f32x4 v) { return (f32x4){sigm(v[0]), sigm(v[1]), sigm(v[2]), sigm(v[3])}; }
HD u32x4 pk8(f32x4 a, f32x4 b) { u32x4 w; w.x = pk2(a[0], a[1]); w.y = pk2(a[2], a[3]); w.z = pk2(b[0], b[1]); w.w = pk2(b[2], b[3]); return w; }
HD u32x2 pk4(f32x4 a) { u32x2 w; w.x = pk2(a[0], a[1]); w.y = pk2(a[2], a[3]); return w; }
HD f32x4 unpk_lo(u32x4 w) { return (f32x4){bf_lo(w.x), bf_hi(w.x), bf_lo(w.y), bf_hi(w.y)}; }
HD f32x4 unpk_hi(u32x4 w) { return (f32x4){bf_lo(w.z), bf_hi(w.z), bf_lo(w.w), bf_hi(w.w)}; }
HD f32x4 unpk4(u32x2 w) { return (f32x4){bf_lo(w.x), bf_hi(w.x), bf_lo(w.y), bf_hi(w.y)}; }
#if defined(__HIP_DEVICE_COMPILE__)
#define CFENCE() asm volatile("" ::: "memory")
#define LAUNDER(x) asm volatile("" : "+v"(x))
#else
#define CFENCE() do {} while (0)
#define LAUNDER(x) do {} while (0)
#endif
HD float hsum4(f32x4 a) { return (a[0] + a[1]) + (a[2] + a[3]); }

HD float row_rs(const float* SS, int g) {
    const f32x4* p = (const f32x4*)(SS + (size_t)g * 16);
    const f32x4 a = p[0], b = p[1], c = p[2], d = p[3];
    const float s = (hsum4(a) + hsum4(b)) + (hsum4(c) + hsum4(d));
    return frsq(s * (1.0f / (float)D) + EPS);
}

template <class Sh> HD float row_rs_q(const float* SS, int g, int fq, int lane, const Sh& sh) {
    float s = hsum4(*(const f32x4*)(SS + (size_t)g * 16 + fq * 4));
    s += sh(s, lane ^ 16); s += sh(s, lane ^ 32);
    return frsq(s * (1.0f / (float)D) + EPS);
}

HD int win_dst(int s) {
    if (s < 512) return 256 * (s >> 7) + (s & 127);
    if (s < 1024) { const int c = s - 512; return 256 * (c >> 7) + 128 + (c & 127); }
    if (s < 1536) return 2048 + (s - 1024);
    if (s < 2048) { const int c = s - 1536; return 256 * (4 + (c >> 7)) + (c & 127); }
    if (s < 2560) { const int c = s - 2048; return 256 * (4 + (c >> 7)) + 128 + (c & 127); }
    if (s < 3584) { const int c = s - 2560; return 256 * (10 + (c >> 7)) + (c & 127); }
    { const int c = s - 3584; return 256 * (10 + (c >> 7)) + 128 + (c & 127); }
}
HD int wup_dst(int s) { if (s < DFF) return 256 * (s >> 7) + (s & 127); const int c = s - DFF; return 256 * (c >> 7) + 128 + (c & 127); }

constexpr int BM = 256, BK = 64, HALF = 128, HTB = HALF * BK * 2  , STAGE_BYTES = 8 * HTB, NXCD = 8, WGM = 8;
struct Unit { int pm, pn; };
struct Gemm { const bf16_t* A; const bf16_t* Bt; int K; };
struct StaticOrder {
    int nM, nN, nwg, G, c;
    HD void init(int nM_, int nN_, int G_, int c_) { nM = nM_; nN = nN_; nwg = nM * nN; G = G_; c = c_; }
    HD bool next(int i, Unit& u) const {
        const long L = (long)i * G + c; if (L >= nwg) return false;
        int wgid = (int)L; { const int q = nwg / NXCD, r = nwg % NXCD, xcd = wgid % NXCD, off = wgid / NXCD; wgid = (xcd < r ? xcd * (q + 1) : r * (q + 1) + (xcd - r) * q) + off; }
        const int nig = WGM * nN, gid = wgid / nig, fm = gid * WGM, gsz = (nM - fm) < WGM ? (nM - fm) : WGM;
        u.pm = fm + ((wgid % nig) % gsz); u.pn = (wgid % nig) / gsz; return true;
    }
    HD void a_ready(const Unit&) const {}
    HD void done(const Unit&) const {}
};

typedef f32x4 Acc[2][2][4][2];

struct EpiE {
    static constexpr bool PERM = true, AFTER_DRAIN = false, HAS_MID = false; static constexpr int MID_T = -1;
    bf16_t* E;
    template <class Sh> HD void operator()(const Acc& acc, const Unit& u, int wr, int wc, int fr, int fq, const Sh&) const {
        const int cb = u.pn * 256 + wc * 32 + 8 * fq;
#pragma unroll
        for (int ai = 0; ai < 2; ++ai)
#pragma unroll
            for (int m = 0; m < 4; ++m) { const int g = u.pm * 256 + ai * 128 + wr * 64 + m * 16 + fr; bf16_t* rowp = E + (size_t)g * D + cb;
#pragma unroll
                for (int bj = 0; bj < 2; ++bj) *(u32x4*)(rowp + bj * 128) = pk8(acc[ai][bj][m][0], acc[ai][bj][m][1]); }
    }
    template <class Sh> HD void mid(Acc&, const Unit&, int, int, int, int, const Sh&) const {}
};

struct EpiIn {
    static constexpr bool PERM = true, AFTER_DRAIN = false, HAS_MID = false; static constexpr int MID_T = -1;
    const float* SS; const float* bgate; bf16_t *AGLU, *CV, *BS, *GR, *GB;
    template <class Sh> HD void operator()(const Acc& acc, const Unit& u, int wr, int wc, int fr, int fq, const Sh& sh) const {
        const int cb = wc * 32 + 8 * fq;
        const int pn = u.pn, grow = u.pm * 256 + wr * 64 + fr, lane = fq * 16 + fr;
        float rsv[2][4];
#pragma unroll
        for (int ai = 0; ai < 2; ++ai)
#pragma unroll
            for (int m = 0; m < 4; ++m) rsv[ai][m] = row_rs_q(SS, grow + ai * 128 + m * 16, fq, lane, sh);
        if (pn < 4) {
#pragma unroll
            for (int ai = 0; ai < 2; ++ai)
#pragma unroll
                for (int m = 0; m < 4; ++m) { const int g = grow + ai * 128 + m * 16; const float rs = rsv[ai][m];
                    *(u32x4*)(AGLU + (size_t)g * DC + pn * 128 + cb) = pk8((acc[ai][0][m][0] * rs) * sigm4(acc[ai][1][m][0] * rs), (acc[ai][0][m][1] * rs) * sigm4(acc[ai][1][m][1] * rs)); }
        } else if (pn < 8) {
#pragma unroll
            for (int ai = 0; ai < 2; ++ai)
#pragma unroll
                for (int m = 0; m < 4; ++m) { const int g = grow + ai * 128 + m * 16; const float r2 = rsv[ai][m] * rsv[ai][m];
                    *(u32x4*)(CV + (size_t)g * DSC + (pn - 4) * 128 + cb) = pk8(acc[ai][0][m][0] * acc[ai][1][m][0] * r2, acc[ai][0][m][1] * acc[ai][1][m][1] * r2); }
        } else if (pn < 10) {
#pragma unroll
            for (int ai = 0; ai < 2; ++ai)
#pragma unroll
                for (int m = 0; m < 4; ++m) { const int g = grow + ai * 128 + m * 16; const float rs = rsv[ai][m];
                    bf16_t* rowp = BS + (size_t)g * DSC + (pn - 8) * 256 + cb;
                    *(u32x4*)rowp = pk8(acc[ai][0][m][0] * rs, acc[ai][0][m][1] * rs); *(u32x4*)(rowp + 128) = pk8(acc[ai][1][m][0] * rs, acc[ai][1][m][1] * rs); }
        } else {
            const int t = pn - 10; const float* pa = bgate + t * 128 + cb; const float* pb = bgate + D + t * 128 + cb;
            const f32x4 ba0 = *(const f32x4*)pa, ba1 = *(const f32x4*)(pa + 4), bb0 = *(const f32x4*)pb, bb1 = *(const f32x4*)(pb + 4);
#pragma unroll
            for (int ai = 0; ai < 2; ++ai)
#pragma unroll
                for (int m = 0; m < 4; ++m) { const int g = grow + ai * 128 + m * 16; const float rs = rsv[ai][m];
                    const size_t o = (size_t)g * D + t * 128 + cb;
                    const f32x4 la0 = acc[ai][0][m][0] * rs + ba0, la1 = acc[ai][0][m][1] * rs + ba1, lb0 = acc[ai][1][m][0] * rs + bb0, lb1 = acc[ai][1][m][1] * rs + bb1;
                    f32x4 r0, r1, g0, g1;
#pragma unroll
                    for (int j = 0; j < 4; ++j) {
                        const float ea0 = fexp2(-1.44269504089f * la0[j]), eb0 = fexp2(-1.44269504089f * lb0[j]), ea1 = fexp2(-1.44269504089f * la1[j]), eb1 = fexp2(-1.44269504089f * lb1[j]);
                        g0[j] = frcp(1.0f + eb0); r0[j] = (1.0f + eb0) * frcp(1.0f + ea0); g1[j] = frcp(1.0f + eb1); r1[j] = (1.0f + eb1) * frcp(1.0f + ea1); }
                    *(u32x4*)(GR + o) = pk8(r0, r1); *(u32x4*)(GB + o) = pk8(g0, g1); }
        }
    }
    template <class Sh> HD void mid(Acc&, const Unit&, int, int, int, int, const Sh&) const {}
};

struct EpiMerge {
    static constexpr bool PERM = true, AFTER_DRAIN = false, HAS_MID = true; static constexpr int MID_T = 8;
    const bf16_t *GR, *GB; bf16_t* MG;
    template <class Sh> HD void mid(Acc& acc, const Unit& u, int wr, int wc, int fr, int fq, const Sh&) const {
        LAUNDER(fr); LAUNDER(fq);
        const int cb = u.pn * 256 + wc * 32 + 8 * fq;
#pragma unroll
        for (int ai = 0; ai < 2; ++ai)
#pragma unroll
            for (int m = 0; m < 4; ++m) { const int g = u.pm * 256 + ai * 128 + wr * 64 + m * 16 + fr; const bf16_t* rowp = GR + (size_t)g * D + cb;
#pragma unroll
                for (int bj = 0; bj < 2; ++bj) { const u32x4 w = *(const u32x4*)(rowp + bj * 128); acc[ai][bj][m][0] *= unpk_lo(w); acc[ai][bj][m][1] *= unpk_hi(w); CFENCE(); } }
    }
    template <class Sh> HD void operator()(const Acc& acc, const Unit& u, int wr, int wc, int fr, int fq, const Sh&) const {
        const int cb = u.pn * 256 + wc * 32 + 8 * fq;
#pragma unroll
        for (int ai = 0; ai < 2; ++ai)
#pragma unroll
            for (int m = 0; m < 4; ++m) { const int g = u.pm * 256 + ai * 128 + wr * 64 + m * 16 + fr; const size_t o = (size_t)g * D + cb;
#pragma unroll
                for (int bj = 0; bj < 2; ++bj) { const u32x4 w = *(const u32x4*)(GB + o + bj * 128);
                    *(u32x4*)(MG + o + bj * 128) = pk8(acc[ai][bj][m][0] * unpk_lo(w), acc[ai][bj][m][1] * unpk_hi(w)); } CFENCE(); }
    }
};

template <int MODE> struct EpiRes {
    static constexpr bool PERM = true, AFTER_DRAIN = false, HAS_MID = false; static constexpr int MID_T = -1;
    const bf16_t* xin; bf16_t* xout; float* ssout; const float* ssin; const bf16_t* E;
    template <class Sh> HD void operator()(const Acc& acc, const Unit& u, int wr, int wc, int fr, int fq, const Sh& sh) const {
        const int cb = u.pn * 256 + wc * 32 + 8 * fq; const int lane = fq * 16 + fr, grow = u.pm * 256 + wr * 64 + fr;
        float rsv[2][4];
        if (MODE == 1) {
#pragma unroll
            for (int ai = 0; ai < 2; ++ai)
#pragma unroll
                for (int m = 0; m < 4; ++m) rsv[ai][m] = row_rs_q(ssin, grow + ai * 128 + m * 16, fq, lane, sh);
        }
        constexpr int MB = MODE == 1 ? 2 : 4;
#pragma unroll
        for (int ai = 0; ai < 2; ++ai)
#pragma unroll
        for (int mh = 0; mh < 4; mh += MB) {
            u32x4 xi[MB][2], ev[MB][2];
#pragma unroll
            for (int mm = 0; mm < MB; ++mm)
#pragma unroll
                for (int bj = 0; bj < 2; ++bj) { const size_t o = (size_t)(grow + ai * 128 + (mh + mm) * 16) * D + cb + bj * 128; xi[mm][bj] = *(const u32x4*)(xin + o); if (MODE == 1) ev[mm][bj] = *(const u32x4*)(E + o); }
#pragma unroll
            for (int mm = 0; mm < MB; ++mm) {
                const int m = mh + mm, g = grow + ai * 128 + m * 16; float sq = 0.f;
#pragma unroll
                for (int bj = 0; bj < 2; ++bj) { const size_t o = (size_t)g * D + cb + bj * 128;
                    f32x4 v0 = acc[ai][bj][m][0], v1 = acc[ai][bj][m][1];
                    if (MODE == 1) { const float rs = rsv[ai][m]; v0 = sigm4(v0 * rs) * unpk_lo(ev[mm][bj]); v1 = sigm4(v1 * rs) * unpk_hi(ev[mm][bj]); }
                    const f32x4 x0 = unpk_lo(xi[mm][bj]) + v0, x1 = unpk_hi(xi[mm][bj]) + v1;
                    *(u32x4*)(xout + o) = pk8(x0, x1);
                    sq += ((x0[0] * x0[0] + x0[1] * x0[1]) + (x0[2] * x0[2] + x0[3] * x0[3])) + ((x1[0] * x1[0] + x1[1] * x1[1]) + (x1[2] * x1[2] + x1[3] * x1[3])); }
                sq += sh(sq, lane ^ 16); sq += sh(sq, lane ^ 32);
                if (fq == 0) ssout[(size_t)g * 16 + u.pn * 4 + wc] = sq;
            }
            CFENCE();
        }
    }
    template <class Sh> HD void mid(Acc&, const Unit&, int, int, int, int, const Sh&) const {}
};

struct EpiUp {
    static constexpr bool PERM = true, AFTER_DRAIN = false, HAS_MID = false; static constexpr int MID_T = -1;
    const float* SS; const float* cw; const float* cb_; bf16_t* F;
    template <class Sh> HD void operator()(const Acc& acc, const Unit& u, int wr, int wc, int fr, int fq, const Sh& sh) const {
        const int ch = u.pn * 128 + wc * 32 + 8 * fq;
        const int lane = fq * 16 + fr;
        float rsv[2][4];
#pragma unroll
        for (int ai = 0; ai < 2; ++ai)
#pragma unroll
            for (int m = 0; m < 4; ++m) { const int g = 62 * (4 * u.pm + 2 * ai + wr) - 2 + m * 16 + fr; rsv[ai][m] = row_rs_q(SS, g < 0 ? 0 : (g > M - 1 ? M - 1 : g), fq, lane, sh); }
        const f32x4 w0a = *(const f32x4*)(cw + ch), w0b = *(const f32x4*)(cw + ch + 4), w1a = *(const f32x4*)(cw + DFF + ch), w1b = *(const f32x4*)(cw + DFF + ch + 4);
        const f32x4 w2a = *(const f32x4*)(cw + 2 * DFF + ch), w2b = *(const f32x4*)(cw + 2 * DFF + ch + 4), bia = *(const f32x4*)(cb_ + ch), bib = *(const f32x4*)(cb_ + ch + 4);
#pragma unroll
        for (int ai = 0; ai < 2; ++ai) {
            const int q = 4 * u.pm + 2 * ai + wr;
            f32x4 pa = {0.f, 0.f, 0.f, 0.f}, pb = pa;
#pragma unroll
            for (int m = 0; m < 4; ++m) {
                const int rho = m * 16 + fr, g = 62 * q - 2 + rho; const int gc = g < 0 ? 0 : (g > M - 1 ? M - 1 : g);
                const float rs = rsv[ai][m];
                const f32x4 ga = acc[ai][0][m][0] * rs, gb = acc[ai][0][m][1] * rs, va = acc[ai][1][m][0] * rs, vb = acc[ai][1][m][1] * rs;
                f32x4 t1a, t1b, t2a, t2b;
#pragma unroll
                for (int j = 0; j < 4; ++j) {
                    t1a[j] = sh.ror1(fr == 15 ? pa[j] : ga[j]); t1b[j] = sh.ror1(fr == 15 ? pb[j] : gb[j]);
                    t2a[j] = sh.ror2(fr >= 14 ? pa[j] : ga[j]); t2b[j] = sh.ror2(fr >= 14 ? pb[j] : gb[j]);
                }
                pa = ga; pb = gb;
                const int t = gc % SEQ;
                if (t < 1) { t1a = (f32x4){0.f, 0.f, 0.f, 0.f}; t1b = t1a; }
                if (t < 2) { t2a = (f32x4){0.f, 0.f, 0.f, 0.f}; t2b = t2a; }
                const f32x4 fa = w2a * ga + w1a * t1a + w0a * t2a + bia, fb = w2b * gb + w1b * t1b + w0b * t2b + bib;
                f32x4 oa, ob;
#pragma unroll
                for (int j = 0; j < 4; ++j) { oa[j] = gelu_tanh(fa[j]) * va[j]; ob[j] = gelu_tanh(fb[j]) * vb[j]; }
                if (rho >= 2 && g < M) *(u32x4*)(F + (size_t)g * DFF + ch) = pk8(oa, ob);
            }
        }
    }
    template <class Sh> HD void mid(Acc&, const Unit&, int, int, int, int, const Sh&) const {}
};

#ifndef EMU
#define PG8_LAS __attribute__((address_space(3)))
#define GAS __attribute__((address_space(1)))
#define LAS __attribute__((address_space(3)))
typedef GAS unsigned gu32;
#define RLX_AGENT __ATOMIC_RELAXED, __HIP_MEMORY_SCOPE_AGENT
#define LDS_WAIT() asm volatile("s_waitcnt lgkmcnt(0)" ::: "memory")
#define VM_WAIT() asm volatile("s_waitcnt vmcnt(0)" ::: "memory")
#ifndef ROR_DPP
#define ROR_DPP 1
#endif
struct ShflDev {
    __device__ __forceinline__ float operator()(float v, int src) const { return __shfl(v, src, 64); }
#if ROR_DPP
    __device__ __forceinline__ float ror1(float v) const { return __builtin_bit_cast(float, __builtin_amdgcn_update_dpp(0, __builtin_bit_cast(int, v), 0x121, 0xf, 0xf, false)); }
    __device__ __forceinline__ float ror2(float v) const { return __builtin_bit_cast(float, __builtin_amdgcn_update_dpp(0, __builtin_bit_cast(int, v), 0x122, 0xf, 0xf, false)); }
#else
    __device__ __forceinline__ float ror1(float v) const { const int l = threadIdx.x & 63; return __shfl(v, (l & 48) | ((l + 15) & 15), 64); }
    __device__ __forceinline__ float ror2(float v) const { const int l = threadIdx.x & 63; return __shfl(v, (l & 48) | ((l + 14) & 15), 64); }
#endif
};

__host__ __device__ __forceinline__ int lds_byte(int r, int c) { const int st = (r >> 4) * 2 + (c >> 5), rr = r & 15, cc = c & 31, ob = rr * 64 + cc * 2; return st * 1024 + (ob ^ (((ob >> 9) & 1) << 5)); }
__host__ __device__ __forceinline__ void stage_rc(int b, int& R, int& C) { const int st = b / 1024, sb = b % 1024, swz = sb ^ (((sb >> 9) & 1) << 5); R = (st >> 1) * 16 + swz / 64; C = (st & 1) * 32 + (swz % 64) / 2; }
__host__ __device__ __forceinline__ int perm32(int rho) { const int n = rho >> 4, i = rho & 15; return 8 * (i >> 2) + 4 * n + (i & 3); }

template <class Epi, class Sched, bool ALIGN_EPI = false, bool SP2 = false, bool ACHUNK = false>
__device__ __forceinline__ void gemm_phase(PG8_LAS unsigned char* lds, const Gemm g, const Sched& S, const Epi& E) {
    int tid_ = threadIdx.x; asm volatile("" : "+v"(tid_));
    const int tid = tid_, wid = __builtin_amdgcn_readfirstlane(tid >> 6), lane = tid & 63, wr = wid >> 2, wc = wid & 3, fr = lane & 15, fq = lane >> 4;
    int K_ = g.K; asm volatile("" : "+s"(K_));
    const int K = K_, nt = K / BK;
    unsigned voffA[2], voffB[2];
#pragma unroll
    for (int i = 0; i < 2; ++i) { int R, C; stage_rc(tid * 16 + i * 8192, R, C); const int Rb = Epi::PERM ? ((R & ~31) + perm32(R & 31)) : R;
        const int Ra = ACHUNK ? ((R >> 6) * 62 + (R & 63)) : R; voffA[i] = (unsigned)(Ra * K + C) * 2u; voffB[i] = (unsigned)(Rb * K + C) * 2u; }
    const size_t kstep = (size_t)(BK * 2);
    const size_t hstepB = (size_t)HALF * K * 2, hstepA = ACHUNK ? (size_t)124 * K * 2 : hstepB;
    const size_t tstepA = 2 * hstepA, tstepB = 2 * hstepB;
    const unsigned ldsw = (unsigned)wid * 1024u;
    const int aoff = lds_byte(wr * 64 + fr, fq * 8), boff = lds_byte(wc * 32 + fr, fq * 8);
#define PG8_SA(b, h) (((b) * 2 + (h)) * HTB)
#define PG8_SB(b, h) ((4 + (b) * 2 + (h)) * HTB)
#define PG8_STAGE(bufoff, gbase, voff) do { _Pragma("unroll") for (int _i = 0; _i < 2; ++_i) \
        __builtin_amdgcn_global_load_lds((const unsigned*)((const char*)(gbase) + (voff)[_i]), (PG8_LAS unsigned*)(lds + (bufoff) + ldsw + _i * 8192), 16, 0, 0); } while (0)
#define PG8_LDA(dst, b, h) do { _Pragma("unroll") for (int m = 0; m < 4; ++m) _Pragma("unroll") for (int k = 0; k < 2; ++k) dst[m][k] = *(const PG8_LAS bf16x8*)(lds + PG8_SA(b, h) + aoff + m * 2048 + k * 1024); } while (0)
#define PG8_LDB(dst, b, h) do { _Pragma("unroll") for (int n = 0; n < 2; ++n) _Pragma("unroll") for (int k = 0; k < 2; ++k) dst[n][k] = *(const PG8_LAS bf16x8*)(lds + PG8_SB(b, h) + boff + n * 2048 + k * 1024); } while (0)
#define PG8_MMA(ai, bj, At, Bt) do { __builtin_amdgcn_s_setprio(1); _Pragma("unroll") for (int m = 0; m < 4; ++m) _Pragma("unroll") for (int n = 0; n < 2; ++n) _Pragma("unroll") for (int k = 0; k < 2; ++k) \
        acc[ai][bj][m][n] = __builtin_amdgcn_mfma_f32_16x16x32_bf16(Bt[n][k], At[m][k], acc[ai][bj][m][n], 0, 0, 0); __builtin_amdgcn_s_setprio(0); } while (0)
#define PG8_WAIT_V(n) asm volatile("s_waitcnt vmcnt(" #n ")" ::: "memory")
#define PG8_WAIT_L(n) asm volatile("s_waitcnt lgkmcnt(" #n ")" ::: "memory")
#define PG8_BAR __builtin_amdgcn_s_barrier()
#define PG8_SCHED __builtin_amdgcn_sched_barrier(0)
    Unit cur, nxt; int ui = 0;
    if (!S.next(0, cur)) return;
    f32x4 acc[2][2][4][2];
#pragma unroll
    for (int a = 0; a < 2; ++a)
#pragma unroll
        for (int b = 0; b < 2; ++b)
#pragma unroll
            for (int m = 0; m < 4; ++m)
#pragma unroll
                for (int n = 0; n < 2; ++n) acc[a][b][m][n] = (f32x4){0.f, 0.f, 0.f, 0.f};
    bf16x8 At[4][2], B0[2][2], B1[2][2];
    const char* cA = (const char*)g.A + (size_t)cur.pm * tstepA; const char* cB = (const char*)g.Bt + (size_t)cur.pn * tstepB;
    S.a_ready(cur);
    if constexpr (SP2) {
        PG8_STAGE(PG8_SB(0, 0), cB, voffB); PG8_STAGE(PG8_SB(0, 1), cB + hstepB, voffB); PG8_STAGE(PG8_SA(0, 0), cA, voffA); PG8_STAGE(PG8_SA(0, 1), cA + hstepA, voffA);
        if (wr == 1) PG8_BAR;
        PG8_WAIT_V(2); PG8_BAR;
        PG8_STAGE(PG8_SB(1, 0), cB + kstep, voffB); PG8_STAGE(PG8_SA(1, 0), cA + kstep, voffA); PG8_STAGE(PG8_SB(1, 1), cB + hstepB + kstep, voffB);
        PG8_WAIT_V(6); PG8_BAR;
    } else {
        PG8_STAGE(PG8_SB(0, 0), cB, voffB); PG8_STAGE(PG8_SA(0, 0), cA, voffA); PG8_STAGE(PG8_SB(0, 1), cB + hstepB, voffB); PG8_STAGE(PG8_SA(0, 1), cA + hstepA, voffA);
        if (wr == 1) PG8_BAR;
        PG8_WAIT_V(4); PG8_BAR;
        PG8_STAGE(PG8_SB(1, 0), cB + kstep, voffB); PG8_STAGE(PG8_SA(1, 0), cA + kstep, voffA); PG8_STAGE(PG8_SB(1, 1), cB + hstepB + kstep, voffB);
        PG8_WAIT_V(6); PG8_BAR;
    }
    for (;;) {
        const bool has_next = S.next(ui + 1, nxt);
        const char* nA = has_next ? (const char*)g.A + (size_t)nxt.pm * tstepA : cA; const char* nB = has_next ? (const char*)g.Bt + (size_t)nxt.pn * tstepB : cB;
        for (int t = 0; t < nt; t += 2) {
            const bool last = (t == nt - 2);
            if constexpr (Epi::HAS_MID) { if (t == Epi::MID_T) E.mid(acc, cur, wr, wc, fr, fq, ShflDev{}); }
            const char* a1 = cA + (size_t)(t + 1) * kstep;
            const char* a2 = last ? nA : cA + (size_t)(t + 2) * kstep; const char* b2 = last ? nB : cB + (size_t)(t + 2) * kstep;
            const char* a3 = a2 + kstep; const char* b3 = b2 + kstep;
            if (last && has_next) S.a_ready(nxt);
            if constexpr (SP2) {
            PG8_LDB(B0, 0, 0); PG8_LDB(B1, 0, 1); PG8_SCHED; PG8_LDA(At, 0, 0); PG8_STAGE(PG8_SA(1, 1), a1 + hstepA, voffA);
            PG8_WAIT_V(8); PG8_WAIT_L(0); PG8_BAR; PG8_MMA(0, 0, At, B0); PG8_MMA(0, 1, At, B1); PG8_BAR; PG8_SCHED;
            PG8_LDA(At, 0, 1); PG8_STAGE(PG8_SB(0, 0), b2, voffB); PG8_STAGE(PG8_SB(0, 1), b2 + hstepB, voffB); PG8_STAGE(PG8_SA(0, 0), a2, voffA);
            PG8_WAIT_V(8); PG8_WAIT_L(0); PG8_BAR; PG8_MMA(1, 0, At, B0); PG8_MMA(1, 1, At, B1); PG8_BAR; PG8_SCHED;
            PG8_LDB(B0, 1, 0); PG8_LDB(B1, 1, 1); PG8_SCHED; PG8_LDA(At, 1, 0); PG8_STAGE(PG8_SA(0, 1), a2 + hstepA, voffA);
            PG8_WAIT_V(8); PG8_WAIT_L(0); PG8_BAR; PG8_MMA(0, 0, At, B0); PG8_MMA(0, 1, At, B1); PG8_BAR; PG8_SCHED;
            PG8_LDA(At, 1, 1); PG8_STAGE(PG8_SB(1, 0), b3, voffB); PG8_STAGE(PG8_SB(1, 1), b3 + hstepB, voffB); PG8_STAGE(PG8_SA(1, 0), a3, voffA);
            PG8_WAIT_V(8); PG8_WAIT_L(0); PG8_BAR; PG8_MMA(1, 0, At, B0); PG8_MMA(1, 1, At, B1); PG8_BAR; PG8_SCHED;
            } else {
            PG8_LDB(B0, 0, 0); PG8_SCHED; PG8_LDA(At, 0, 0); PG8_STAGE(PG8_SA(1, 1), a1 + hstepA, voffA);
            PG8_WAIT_L(8); PG8_BAR; PG8_WAIT_L(0); PG8_MMA(0, 0, At, B0); PG8_BAR; PG8_SCHED;
            PG8_LDB(B1, 0, 1); PG8_STAGE(PG8_SB(0, 0), b2, voffB);
            PG8_BAR; PG8_WAIT_L(0); PG8_MMA(0, 1, At, B1); PG8_BAR;
            PG8_LDA(At, 0, 1); PG8_STAGE(PG8_SA(0, 0), a2, voffA);
            PG8_BAR; PG8_WAIT_L(0); PG8_MMA(1, 0, At, B0); PG8_BAR; PG8_SCHED;
            PG8_STAGE(PG8_SB(0, 1), b2 + hstepB, voffB);
            PG8_WAIT_V(6); PG8_BAR; PG8_MMA(1, 1, At, B1); PG8_BAR;
            PG8_LDB(B0, 1, 0); PG8_SCHED; PG8_LDA(At, 1, 0); PG8_STAGE(PG8_SA(0, 1), a2 + hstepA, voffA);
            PG8_WAIT_L(8); PG8_BAR; PG8_WAIT_L(0); PG8_MMA(0, 0, At, B0); PG8_BAR; PG8_SCHED;
            PG8_LDB(B1, 1, 1); PG8_STAGE(PG8_SB(1, 0), b3, voffB);
            PG8_BAR; PG8_WAIT_L(0); PG8_MMA(0, 1, At, B1); PG8_BAR;
            PG8_LDA(At, 1, 1); PG8_STAGE(PG8_SA(1, 0), a3, voffA);
            PG8_BAR; PG8_WAIT_L(0); PG8_MMA(1, 0, At, B0); PG8_BAR; PG8_SCHED;
            PG8_STAGE(PG8_SB(1, 1), b3 + hstepB, voffB);
            PG8_WAIT_V(6); PG8_BAR; PG8_MMA(1, 1, At, B1); PG8_BAR;
            }
        }
        if constexpr (ALIGN_EPI) { if (wr == 0) PG8_BAR; }
        if constexpr (!Epi::AFTER_DRAIN) { E(acc, cur, wr, wc, fr, fq, ShflDev{}); S.done(cur); }
        if (!has_next) break;
#pragma unroll
        for (int a = 0; a < 2; ++a)
#pragma unroll
            for (int b = 0; b < 2; ++b)
#pragma unroll
                for (int m = 0; m < 4; ++m)
#pragma unroll
                    for (int n = 0; n < 2; ++n) acc[a][b][m][n] = (f32x4){0.f, 0.f, 0.f, 0.f};
        cur = nxt; cA = nA; cB = nB; ++ui;
        if constexpr (ALIGN_EPI) { if (wr == 1) PG8_BAR; }
    }
    PG8_WAIT_V(0);
    if constexpr (!ALIGN_EPI) { if (wr == 0) PG8_BAR; }
    PG8_BAR;
#undef PG8_SA
#undef PG8_SB
#undef PG8_STAGE
#undef PG8_LDA
#undef PG8_LDB
#undef PG8_MMA
#undef PG8_WAIT_V
#undef PG8_WAIT_L
#undef PG8_BAR
#undef PG8_SCHED
}

constexpr int NWAVES = 8;
#ifndef MK_PER_PHASE
#define MK_PER_PHASE 0
#endif
constexpr int N_PHASES = 7 * NLAYER + 2;

constexpr size_t MiB = 1u << 20;
constexpr size_t WS_CTL = 0, CTL_ZERO_BYTES = 64 * 1024;
constexpr size_t WS_SS0 = 1 * MiB, WS_SS1 = 2 * MiB;
constexpr size_t WS_WB = 3 * MiB;
constexpr size_t WB_WIN = 0, WB_WAB = WB_WIN + (size_t)NIN * D, WB_WO = WB_WAB + (size_t)D * D, WB_WUP = WB_WO + (size_t)D * D, WB_WDN = WB_WUP + (size_t)NUP * D,
                 WB_WPG = WB_WDN + (size_t)D * DFF, WB_WPL = WB_WPG + (size_t)D * D, WB_END = WB_WPL + (size_t)D * PLE;
static_assert(WB_END * 2 == 32 * MiB, "weight copies fill 32 MiB");
constexpr size_t WS_PB = 35 * MiB;
constexpr size_t WS_XB = 44 * MiB;
constexpr size_t WS_ACT = 77 * MiB;
constexpr size_t WS_AGLU = WS_ACT, WS_CV = WS_ACT + 16 * MiB, WS_BS = WS_ACT + 32 * MiB, WS_GR = WS_ACT + 48 * MiB, WS_GB = WS_ACT + 80 * MiB,
                 WS_A2S = WS_ACT + 112 * MiB, WS_E = WS_ACT + 144 * MiB, WS_END = WS_ACT + 176 * MiB;
constexpr size_t WS_MG = WS_AGLU;
constexpr size_t WS_F = WS_ACT;
constexpr size_t WS_XB2 = WS_A2S;
static_assert(WS_END <= 256 * MiB && WS_F + (size_t)M * DFF * 2 <= WS_A2S && WS_XB + (size_t)(M + 256) * D * 2 <= WS_ACT, "d_ws map");
constexpr size_t OUT_XB2 = 0, OUT_WB1 = 32 * MiB;
static_assert(NLAYER == 2, "one layer's weight copies live in d_ws, the other's in d_out");
constexpr int CW_BAR = 4096;

constexpr int RING_OFF = 0, RING_BYTES = 131072;
constexpr int LDSCTL_OFF = RING_BYTES, MISC_OFF = LDSCTL_OFF + 320;
constexpr int LDS_BYTES = 147456;
static_assert(MISC_OFF + 128 <= LDS_BYTES, "LDS map");

#define XB_TMO      128
#define XB_XCNT(j)  (256  + 64 * (j))
#define XB_XSUB(j)  (1280 + 64 * (j))
#define XB_XGEN(j)  (2304 + 64 * (j))
#define XB_TOP      3328
#define XB_TOPGEN   3392
#define XCD_BAR_WORDS 3456
#define XB_SPIN_CAP (1u << 18)

__device__ __forceinline__ unsigned xb_ld(unsigned* p)              { return __hip_atomic_load(p, __ATOMIC_RELAXED, __HIP_MEMORY_SCOPE_AGENT); }
__device__ __forceinline__ unsigned xb_add(unsigned* p, unsigned v) { return __hip_atomic_fetch_add(p, v, __ATOMIC_RELAXED, __HIP_MEMORY_SCOPE_AGENT); }
__device__ __forceinline__ unsigned xb_xcc_id() { return (unsigned)__builtin_amdgcn_s_getreg((3 << 11) | 20) & 0xFu; }
#define XB_SPIN(cond, bar) do { unsigned _sp = 0; while (cond) { __builtin_amdgcn_s_sleep(1); \
    if ((++_sp & 255u) == 0u) { if (xb_ld(&(bar)[XB_TMO])) break; if (_sp > XB_SPIN_CAP) { atomicAdd(&(bar)[XB_TMO], 1u); break; } } } } while (0)

struct XcdBarrier {
    unsigned* bar; unsigned x;
    volatile LAS unsigned* st;
};

__device__ __forceinline__ XcdBarrier xcd_barrier_post(unsigned* bar, volatile LAS unsigned* st) {
    XcdBarrier b; b.bar = bar; b.x = xb_xcc_id(); b.st = st;
    if (threadIdx.x == 0) (void)xb_add(&bar[XB_XCNT(b.x)], 1u);
    return b;
}
__device__ __forceinline__ void xcd_barrier_complete(unsigned* bar, unsigned x, unsigned& nloc, unsigned& nx) {
    const unsigned G = gridDim.x * gridDim.y * gridDim.z;
    unsigned sum, cnt, mine, sp = 0u;
    for (;;) {
        sum = 0u; cnt = 0u; mine = 0u;
#pragma unroll
        for (unsigned j = 0; j < 16; ++j) { const unsigned c = xb_ld(&bar[XB_XCNT(j)]); sum += c; cnt += (c > 0u) ? 1u : 0u; mine = (j == x) ? c : mine; }
        if (sum == G) break;
        __builtin_amdgcn_s_sleep(1);
        if ((++sp & 255u) == 0u) { if (xb_ld(&bar[XB_TMO])) break; if (sp > XB_SPIN_CAP) { atomicAdd(&bar[XB_TMO], 1u); break; } }
    }
    nloc = mine > 0u ? mine : 1u; nx = cnt > 0u ? cnt : 1u;
}

__device__ __forceinline__ void xcd_barrier(const XcdBarrier& b) {
    asm volatile("s_waitcnt vmcnt(0)" ::: "memory");
    __syncthreads();
    if (threadIdx.x == 0) {
        unsigned* bar = b.bar;
        __builtin_amdgcn_s_waitcnt(0);
        unsigned nloc = b.st[0], nx = b.st[1];
        if (nloc == 0u) { xcd_barrier_complete(bar, b.x, nloc, nx); b.st[0] = nloc; b.st[1] = nx; }
        const unsigned old = xb_add(&bar[XB_XSUB(b.x)], 1u);
        const unsigned gen = old / nloc;
        if (old + 1u == (gen + 1u) * nloc) {
            __builtin_amdgcn_fence(__ATOMIC_RELEASE, "agent");
            asm volatile("s_waitcnt vmcnt(0)" ::: "memory");
            const unsigned og = xb_add(&bar[XB_TOP], 1u);
            const unsigned tg = og / nx;
            if (og + 1u == (tg + 1u) * nx) xb_add(&bar[XB_TOPGEN], 1u);
            else XB_SPIN(xb_ld(&bar[XB_TOPGEN]) == tg, bar);
            __builtin_amdgcn_fence(__ATOMIC_ACQUIRE, "agent");
            xb_add(&bar[XB_XGEN(b.x)], 1u);
            asm volatile("s_waitcnt vmcnt(0)" ::: "memory");
        } else {
            XB_SPIN(xb_ld(&bar[XB_XGEN(b.x)]) == gen, bar);
            __builtin_amdgcn_fence(__ATOMIC_ACQUIRE, "agent");
            asm volatile("s_waitcnt vmcnt(0)" ::: "memory");
        }
    }
    __syncthreads();
}

struct Frame {
    LAS unsigned char* lds;
    volatile LAS unsigned* MISC;
    gu32* ctl;
    int tid, lane, wave;
    int vcu, G;
    float* out; unsigned char* ws;
};
__device__ __forceinline__ float wave_sum(float v) {
#pragma unroll
    for (int o = 1; o < 64; o <<= 1) v += __shfl_xor(v, o, 64);
    return v;
}

__device__ __forceinline__ void cv_item(const float* W, int N, const float* gk, bf16_t* WT, int ldt, int kofs, int drow, int kb, int nb, LAS float* scr, int lane) {
    const int k0 = 64 * kb, n0 = 32 * nb, kq = lane >> 3, n4 = (lane & 7) * 4;
    f32x4 v[8]; float sc[8];
#pragma unroll
    for (int i = 0; i < 8; ++i) { v[i] = *(const GAS f32x4*)(W + (size_t)(k0 + 8 * i + kq) * N + n0 + n4); sc[i] = gk ? gk[k0 + 8 * i + kq] : 1.0f; }
#pragma unroll
    for (int i = 0; i < 8; ++i) { LAS float* d = scr + (8 * i + kq) * 33 + n4; const f32x4 t = v[i] * sc[i]; d[0] = t[0]; d[1] = t[1]; d[2] = t[2]; d[3] = t[3]; }
    LDS_WAIT(); asm volatile("" ::: "memory");
    const int c = lane & 7;
#pragma unroll
    for (int j = 0; j < 4; ++j) { const int n = (lane >> 3) + 8 * j; const LAS float* s = scr + (8 * c) * 33 + n;
        u32x4 o; o.x = pk2(s[0 * 33], s[1 * 33]); o.y = pk2(s[2 * 33], s[3 * 33]); o.z = pk2(s[4 * 33], s[5 * 33]); o.w = pk2(s[6 * 33], s[7 * 33]);
        *(GAS u32x4*)(WT + (size_t)(drow + n) * ldt + kofs + k0 + 8 * c) = o; }
    LDS_WAIT(); asm volatile("" ::: "memory");
}
struct CvPtrs { const float *x, *p, *g_mix, *w_in, *w_a, *w_b, *w_o, *g_ffn, *w_up, *w_dn, *g_ple, *w_pl, *w_pg; };
__device__ __forceinline__ void cv_p(Frame& F, int layer, const float* p) {
    const GAS f32x4* src = (const GAS f32x4*)(p + (size_t)layer * M * PLE); GAS u32x2* dst = (GAS u32x2*)(F.ws + WS_PB);
    const int gt = F.vcu * (NWAVES * 64) + F.tid, NT = F.G * NWAVES * 64;
    for (int i = gt; i < M * PLE / 4; i += 4 * NT) {
        f32x4 v[4];
#pragma unroll
        for (int j = 0; j < 4; ++j) { const int ii = i + j * NT; v[j] = src[ii < M * PLE / 4 ? ii : i]; }
#pragma unroll
        for (int j = 0; j < 4; ++j) { const int ii = i + j * NT; if (ii < M * PLE / 4) dst[ii] = pk4(v[j]); }
    }
}
__device__ __forceinline__ void cv_phase(Frame& F, const CvPtrs& P) {
    LAS float* scr = (LAS float*)(F.lds + RING_OFF + F.wave * 16384);
    const int gw = F.vcu * NWAVES + F.wave, NGW = F.G * NWAVES;
    constexpr int I_IN = (D / 64) * (NIN / 32), I_A = (DC / 64) * (D / 32), I_O = (D / 64) * (D / 32), I_UP = (D / 64) * (NUP / 32), I_DN = (DFF / 64) * (D / 32), I_PL = (PLE / 64) * (D / 32);
    constexpr int NITEMS = I_IN + 2 * I_A + I_O + I_UP + I_DN + I_O + I_PL;
    for (int it = gw; it < NLAYER * NITEMS; it += NGW) {
        const int layer = it / NITEMS; int r = it % NITEMS;
        bf16_t* WB = layer == 0 ? (bf16_t*)(F.ws + WS_WB) : (bf16_t*)((unsigned char*)F.out + OUT_WB1);
        if (r < I_IN) { const int nblk = NIN / 32, kb = r / nblk, nb = r % nblk; cv_item(P.w_in + (size_t)layer * D * NIN, NIN, P.g_mix + layer * D, WB + WB_WIN, D, 0, win_dst(32 * nb), kb, nb, scr, F.lane); continue; } r -= I_IN;
        if (r < I_A)  { const int nblk = D / 32, kb = r / nblk, nb = r % nblk; cv_item(P.w_a + (size_t)layer * DC * D, D, nullptr, WB + WB_WAB, D, 0, 32 * nb, kb, nb, scr, F.lane); continue; } r -= I_A;
        if (r < I_A)  { const int nblk = D / 32, kb = r / nblk, nb = r % nblk; cv_item(P.w_b + (size_t)layer * DSC * D, D, nullptr, WB + WB_WAB, D, DC, 32 * nb, kb, nb, scr, F.lane); continue; } r -= I_A;
        if (r < I_O)  { const int nblk = D / 32, kb = r / nblk, nb = r % nblk; cv_item(P.w_o + (size_t)layer * D * D, D, nullptr, WB + WB_WO, D, 0, 32 * nb, kb, nb, scr, F.lane); continue; } r -= I_O;
        if (r < I_UP) { const int nblk = NUP / 32, kb = r / nblk, nb = r % nblk; cv_item(P.w_up + (size_t)layer * D * NUP, NUP, P.g_ffn + layer * D, WB + WB_WUP, D, 0, wup_dst(32 * nb), kb, nb, scr, F.lane); continue; } r -= I_UP;
        if (r < I_DN) { const int nblk = D / 32, kb = r / nblk, nb = r % nblk; cv_item(P.w_dn + (size_t)layer * DFF * D, D, nullptr, WB + WB_WDN, DFF, 0, 32 * nb, kb, nb, scr, F.lane); continue; } r -= I_DN;
        if (r < I_O)  { const int nblk = D / 32, kb = r / nblk, nb = r % nblk; cv_item(P.w_pg + (size_t)layer * D * D, D, P.g_ple + layer * D, WB + WB_WPG, D, 0, 32 * nb, kb, nb, scr, F.lane); continue; } r -= I_O;
        { const int nblk = D / 32, kb = r / nblk, nb = r % nblk; cv_item(P.w_pl + (size_t)layer * PLE * D, D, nullptr, WB + WB_WPL, PLE, 0, 32 * nb, kb, nb, scr, F.lane); }
    }
    cv_p(F, 0, P.p);
    for (int m0 = gw * 4; m0 < M; m0 += NGW * 4) {
        f32x4 v[4][4];
#pragma unroll
        for (int r = 0; r < 4; ++r)
#pragma unroll
            for (int j = 0; j < 4; ++j) v[r][j] = ((const GAS f32x4*)(P.x + (size_t)(m0 + r) * D) + F.lane)[64 * j];
#pragma unroll
        for (int r = 0; r < 4; ++r) {
            GAS u32x2* o8 = (GAS u32x2*)(F.ws + WS_XB + (size_t)(m0 + r) * D * 2) + F.lane; float s = 0.f;
#pragma unroll
            for (int j = 0; j < 4; ++j) { const f32x4 t = v[r][j]; s += (t[0] * t[0] + t[1] * t[1]) + (t[2] * t[2] + t[3] * t[3]); o8[64 * j] = pk4(t); }
            s = wave_sum(s);
            if (F.lane < 16) ((GAS float*)(F.ws + WS_SS0))[(size_t)(m0 + r) * 16 + F.lane] = F.lane == 0 ? s : 0.f;
        }
    }
}

constexpr int CO_R = 16;
template <int S> struct CoStep {
    static __device__ __forceinline__ void run(f32x2 (&acc)[CO_R], const f32x2 (&w)[CKA], const GAS unsigned* src, int g0, int t0, int cw) {
        const int ts = t0 - (CKA - 1) + S; const bool ok = ts >= 0;
        const unsigned wd = src[(size_t)(ok ? g0 - (CKA - 1) + S : g0) * (DC / 2) + cw];
        f32x2 a; a.x = ok ? bf_lo(wd) : 0.f; a.y = ok ? bf_hi(wd) : 0.f;
#pragma unroll
        for (int r = 0; r < CO_R; ++r) { constexpr int dummy = 0; (void)dummy; const int k = S - r; if (k >= 0 && k < CKA) acc[r] += w[k] * a; }
        CoStep<S + 1>::run(acc, w, src, g0, t0, cw);
    }
};
template <> struct CoStep<CO_R + CKA - 1> { static __device__ __forceinline__ void run(f32x2 (&)[CO_R], const f32x2 (&)[CKA], const GAS unsigned*, int, int, int) {} };
__device__ __forceinline__ void co_phase(Frame& F, int layer, const float* cwa_, const float* cba_, const float* lng_, const float* lnb_, const float* cwb_, const float* p_) {
    const int grp = F.tid >> 8, wv = (F.tid >> 6) & 3, c0 = wv * 128 + F.lane * 2;
    const float* cwa = cwa_ + (size_t)layer * CKA * DC; const float* cba = cba_ + layer * DC; const float* lng = lng_ + layer * DC; const float* lnb = lnb_ + layer * DC;
    const float* cwb = cwb_ + (size_t)layer * 3 * DSC;
    const GAS unsigned* AGLU = (const GAS unsigned*)(F.ws + WS_AGLU); const GAS unsigned* CVp = (const GAS unsigned*)(F.ws + WS_CV); const GAS unsigned* BSp = (const GAS unsigned*)(F.ws + WS_BS);
    GAS unsigned* A2S = (GAS unsigned*)(F.ws + WS_A2S);
    LAS f32x2* part = (LAS f32x2*)(F.lds + RING_OFF) + grp * (CO_R * 4);
    f32x2 w[CKA];
#pragma unroll
    for (int k = 0; k < CKA; ++k) w[k] = *(const f32x2*)(cwa + k * DC + c0);
    const f32x2 bias = *(const f32x2*)(cba + c0), lg = *(const f32x2*)(lng + c0), lb = *(const f32x2*)(lnb + c0);
    const f32x2 wb0 = *(const f32x2*)(cwb + c0), wb1 = *(const f32x2*)(cwb + DSC + c0), wb2 = *(const f32x2*)(cwb + 2 * DSC + c0);
    constexpr int NITEM = M / CO_R;
    const int ngrp = 2 * F.G;
    for (int it0 = 0; it0 < NITEM; it0 += ngrp) {
        const int it = it0 + F.vcu * 2 + grp; const bool live = it < NITEM;
        const int g0 = (live ? it : 0) * CO_R, t0 = g0 % SEQ;
        f32x2 acc[CO_R];
#pragma unroll
        for (int r = 0; r < CO_R; ++r) acc[r] = bias;
        CoStep<0>::run(acc, w, AGLU, g0, t0, c0 >> 1);
        {
            float vals[2 * CO_R];
#pragma unroll
            for (int r = 0; r < CO_R; ++r) { vals[r] = acc[r].x + acc[r].y; vals[CO_R + r] = acc[r].x * acc[r].x + acc[r].y * acc[r].y; }
#pragma unroll
            for (int half = CO_R, bit = 32; half >= 1; half >>= 1, bit >>= 1) {
                const bool up = (F.lane & bit) != 0;
#pragma unroll
                for (int i = 0; i < half; ++i) { const float send = up ? vals[i] : vals[i + half], keep = up ? vals[i + half] : vals[i]; vals[i] = keep + __shfl_xor(send, bit, 64); }
            }
            const float tot = vals[0] + __shfl_xor(vals[0], 1, 64);
            const int idx = (F.lane >> 1) & 31;
            if ((F.lane & 1) == 0) ((LAS float*)part)[((idx & (CO_R - 1)) * 4 + wv) * 2 + (idx >> 4)] = tot;
        }
        __syncthreads();
#pragma unroll
        for (int r = 0; r < CO_R; ++r) {
            const f32x2 p0 = part[r * 4 + 0], p1 = part[r * 4 + 1], p2 = part[r * 4 + 2], p3 = part[r * 4 + 3];
            const float mean = ((p0.x + p1.x) + (p2.x + p3.x)) * (1.0f / DC), ex2 = ((p0.y + p1.y) + (p2.y + p3.y)) * (1.0f / DC);
            const float var = fmaxf(ex2 - mean * mean, 0.f), rstd = frsq(var + EPS);
            float y0 = (acc[r].x - mean) * rstd * lg.x + lb.x, y1 = (acc[r].y - mean) * rstd * lg.y + lb.y;
            y0 = y0 * sigm(y0); y1 = y1 * sigm(y1);
            if (live) A2S[(size_t)(g0 + r) * (D / 2) + (c0 >> 1)] = pk2(y0, y1);
        }
        {
            f32x2 c2 = {0.f, 0.f}, c1 = {0.f, 0.f};
            if (t0 >= 2) { const unsigned wd = CVp[(size_t)(g0 - 2) * (DSC / 2) + (c0 >> 1)]; c2 = (f32x2){bf_lo(wd), bf_hi(wd)}; }
            if (t0 >= 1) { const unsigned wd = CVp[(size_t)(g0 - 1) * (DSC / 2) + (c0 >> 1)]; c1 = (f32x2){bf_lo(wd), bf_hi(wd)}; }
#pragma unroll 8
            for (int r = 0; r < CO_R; ++r) {
                const unsigned wc_ = CVp[(size_t)(g0 + r) * (DSC / 2) + (c0 >> 1)], wb_ = BSp[(size_t)(g0 + r) * (DSC / 2) + (c0 >> 1)];
                const f32x2 c = {bf_lo(wc_), bf_hi(wc_)}, b = {bf_lo(wb_), bf_hi(wb_)};
                const f32x2 o = b * (wb0 * c2 + wb1 * c1 + wb2 * c);
                if (live) A2S[(size_t)(g0 + r) * (D / 2) + (DC >> 1) + (c0 >> 1)] = pk2(o.x, o.y);
                c2 = c1; c1 = c;
            }
        }
        __syncthreads();
    }    if (layer + 1 < NLAYER) cv_p(F, layer + 1, p_);
}

__device__ __forceinline__ void final_phase(Frame& F, const float* g_final) {
    const int gw = F.vcu * NWAVES + F.wave, NGW = F.G * NWAVES;
    const float* SS = (const float*)(F.ws + ((NLAYER & 1) ? WS_SS1 : WS_SS0));
    const f32x4* gf = (const f32x4*)g_final + F.lane;
    f32x4 gv[4];
#pragma unroll
    for (int j = 0; j < 4; ++j) gv[j] = gf[64 * j];
    for (int m = gw; m < M; m += NGW) {
        const float rs = row_rs(SS, m);
        const GAS u32x2* xr = (const GAS u32x2*)(F.ws + WS_XB2 + (size_t)m * D * 2) + F.lane; GAS f32x4* orow = (GAS f32x4*)(F.out + (size_t)m * D) + F.lane;
#pragma unroll
        for (int j = 0; j < 4; ++j) orow[64 * j] = unpk4(xr[64 * j]) * rs * gv[j];
    }
}

struct Args { const float* in[22]; float* out; unsigned char* ws; int ph_lo, ph_hi, li, pad; };
__global__ void __launch_bounds__(NWAVES * 64, 2) fwd_kernel(Args args) {
    extern __shared__ __attribute__((aligned(16))) unsigned char lds[];
    Frame F;
    F.lds = (LAS unsigned char*)lds;
    F.MISC = (volatile LAS unsigned*)(F.lds + MISC_OFF);
    F.tid = threadIdx.x; F.lane = F.tid & 63; F.wave = __builtin_amdgcn_readfirstlane(F.tid >> 6);
    F.G = gridDim.x; { const int bx = blockIdx.x; F.vcu = (F.G % 8 == 0) ? (bx % 8) * (F.G / 8) + bx / 8 : bx; }
    unsigned char* ws = args.ws; F.ws = ws; F.out = args.out;
    F.ctl = (gu32*)(ws + WS_CTL);
    for (int u = F.tid; u < (LDS_BYTES - LDSCTL_OFF) / 4; u += NWAVES * 64) ((LAS unsigned*)(F.lds + LDSCTL_OFF))[u] = 0u;
    __syncthreads();
    XcdBarrier bar; bar.bar = (unsigned*)(F.ctl + CW_BAR); bar.x = 0; bar.st = nullptr;
    if (!MK_PER_PHASE) bar = xcd_barrier_post((unsigned*)(F.ctl + CW_BAR), F.MISC + 8);

    const int lo = args.ph_lo, hi = args.ph_hi;
#ifndef DUP_MASK
#define DUP_MASK 0u
#endif
    const int qlo = lo + __builtin_popcount((unsigned)DUP_MASK & ((1u << lo) - 1u)), qhi = hi + __builtin_popcount((unsigned)DUP_MASK & ((1u << hi) - 1u));
    for (int q = qlo; q < qhi; ++q) {
        int p = 0; while (p + 1 + __builtin_popcount((unsigned)DUP_MASK & ((1u << (p + 1)) - 1u)) <= q) ++p;
        const int layer = p == 0 ? 0 : (p - 1) / 7, k = p == 0 ? 0 : (p - 1) % 7 + 1;
        { int tv = threadIdx.x; asm volatile("" : "+v"(tv)); F.tid = tv; F.lane = tv & 63; F.wave = __builtin_amdgcn_readfirstlane(tv >> 6); }
        const bf16_t* WB = layer == 0 ? (const bf16_t*)(ws + WS_WB) : (const bf16_t*)((unsigned char*)F.out + OUT_WB1);
        float* SSa = (float*)(ws + ((layer & 1) ? WS_SS1 : WS_SS0));
        float* SSb = (float*)(ws + ((layer & 1) ? WS_SS0 : WS_SS1));
#ifndef PHMASK
#define PHMASK 0x1ff
#endif
        if (p == N_PHASES - 1) { if (PHMASK & 0x100) final_phase(F, args.in[21]); }
        else if (k == 0) { if (PHMASK & 1) { const CvPtrs P{args.in[0], args.in[1], args.in[2], args.in[3], args.in[9], args.in[11], args.in[12], args.in[13], args.in[14], args.in[17], args.in[18], args.in[19], args.in[20]}; cv_phase(F, P); } }
        else if (k == 1) { if (PHMASK & 2) {
#ifndef NO_EG
            {
                Gemm g{(const bf16_t*)(ws + WS_PB), WB + WB_WPL, PLE}; StaticOrder S; S.init(M / BM, D / BM, F.G, (int)blockIdx.x);
                EpiE E{(bf16_t*)(ws + WS_E)};
                gemm_phase<EpiE, StaticOrder, false, true, false>(F.lds + RING_OFF, g, S, E);
            }
#endif
#ifndef NO_IN
            {
                Gemm g{layer == 0 ? (const bf16_t*)(ws + WS_XB) : (const bf16_t*)F.out, WB + WB_WIN, D};   StaticOrder S; S.init(M / BM, NIN / BM, F.G, (int)blockIdx.x);
                EpiIn E{SSa, args.in[4] + (size_t)layer * 2 * D, (bf16_t*)(ws + WS_AGLU), (bf16_t*)(ws + WS_CV), (bf16_t*)(ws + WS_BS), (bf16_t*)(ws + WS_GR), (bf16_t*)(ws + WS_GB)};
                gemm_phase<EpiIn, StaticOrder, true, true, false>(F.lds + RING_OFF, g, S, E);
            }
#endif
        } }
        else if (k == 2) { if (PHMASK & 4) co_phase(F, layer, args.in[5], args.in[6], args.in[7], args.in[8], args.in[10], args.in[1]); }
        else if (k == 3) { if (PHMASK & 8) {
            Gemm g{(const bf16_t*)(ws + WS_A2S), WB + WB_WAB, D}; StaticOrder S; S.init(M / BM, D / BM, F.G, (int)blockIdx.x);
            EpiMerge E{(const bf16_t*)(ws + WS_GR), (const bf16_t*)(ws + WS_GB), (bf16_t*)(ws + WS_MG)};
            gemm_phase<EpiMerge, StaticOrder, false, true, false>(F.lds + RING_OFF, g, S, E);
        } }
        else if (k == 4) { if (PHMASK & 16) {
            Gemm g{(const bf16_t*)(ws + WS_MG), WB + WB_WO, D}; StaticOrder S; S.init(M / BM, D / BM, F.G, (int)blockIdx.x);
            EpiRes<0> E{layer == 0 ? (const bf16_t*)(ws + WS_XB) : (const bf16_t*)F.out, (bf16_t*)(ws + WS_XB), SSb, nullptr, nullptr};
            gemm_phase<EpiRes<0>, StaticOrder, false, true, false>(F.lds + RING_OFF, g, S, E);
        } }
        else if (k == 5) { if (PHMASK & 32) {
            Gemm g{(const bf16_t*)(ws + WS_XB) - 2 * D, WB + WB_WUP, D}; StaticOrder S; S.init(NT_UP, NUP / BM, F.G, (int)blockIdx.x);
            EpiUp E{SSb, args.in[15] + (size_t)layer * 3 * DFF, args.in[16] + (size_t)layer * DFF, (bf16_t*)(ws + WS_F)};
            gemm_phase<EpiUp, StaticOrder, true, true, true>(F.lds + RING_OFF, g, S, E);
        } }
        else if (k == 6) { if (PHMASK & 64) {
            Gemm g{(const bf16_t*)(ws + WS_F), WB + WB_WDN, DFF}; StaticOrder S; S.init(M / BM, D / BM, F.G, (int)blockIdx.x);
            EpiRes<0> E{(const bf16_t*)(ws + WS_XB), (bf16_t*)(ws + WS_XB), SSa, nullptr, nullptr};
            gemm_phase<EpiRes<0>, StaticOrder, false, true, false>(F.lds + RING_OFF, g, S, E);
        } }
        else { if (PHMASK & 128) {
            Gemm g{(const bf16_t*)(ws + WS_XB), WB + WB_WPG, D}; StaticOrder S; S.init(M / BM, D / BM, F.G, (int)blockIdx.x);
            EpiRes<1> E{(const bf16_t*)(ws + WS_XB), layer == NLAYER - 1 ? (bf16_t*)(ws + WS_XB2) : (bf16_t*)F.out, SSb, SSa, (const bf16_t*)(ws + WS_E)};
            gemm_phase<EpiRes<1>, StaticOrder, false, true, false>(F.lds + RING_OFF, g, S, E);
        } }
        if (q + 1 < qhi) xcd_barrier(bar);
    }
}

extern "C" void kernel_launch(void* const* d_in, const int* in_sizes, int n_in, void* d_out, int out_size, void* d_ws, size_t ws_size, hipStream_t stream) {
    static int grid = 0;
    if (grid == 0) {
        if (n_in != 22 || in_sizes[0] != M * D || out_size != M * D || ws_size < WS_END) { fprintf(stderr, "kernel_launch: built for 22 inputs, x and out of %d floats, >= %zu bytes of workspace; got n_in %d, in0 %d, out %d, ws %zu; nothing launched\n", M * D, (size_t)WS_END, n_in, n_in > 0 ? in_sizes[0] : -1, out_size, ws_size); grid = -1; return; }
        int dev = 0, cus = 0, per_cu = 0;
        if (hipGetDevice(&dev) != hipSuccess || hipDeviceGetAttribute(&cus, hipDeviceAttributeMultiprocessorCount, dev) != hipSuccess) { fprintf(stderr, "kernel_launch: hipGetDevice / hipDeviceGetAttribute failed; nothing launched\n"); grid = -1; return; }
        if (hipFuncSetAttribute((const void*)fwd_kernel, hipFuncAttributeMaxDynamicSharedMemorySize, LDS_BYTES) != hipSuccess) { fprintf(stderr, "kernel_launch: hipFuncSetAttribute failed\n"); grid = -1; return; }
        if (hipOccupancyMaxActiveBlocksPerMultiprocessor(&per_cu, (const void*)fwd_kernel, NWAVES * 64, LDS_BYTES) != hipSuccess || per_cu < 1)
            fprintf(stderr, "kernel_launch: note: the occupancy query reports %d workgroups per CU\n", per_cu);
        (void)hipGetLastError();
        grid = cus;
    }
    if (grid < 0) return;
    if (hipMemsetAsync((char*)d_ws + WS_CTL, 0, CTL_ZERO_BYTES, stream) != hipSuccess) { fprintf(stderr, "kernel_launch: hipMemsetAsync of the control words failed; nothing launched\n"); return; }
    Args a{};
    for (int i = 0; i < 22; ++i) a.in[i] = (const float*)d_in[i];
    a.out = (float*)d_out; a.ws = (unsigned char*)d_ws;
    const int nl = MK_PER_PHASE ? N_PHASES : 1;
    for (int li = 0; li < nl; ++li) {
        a.ph_lo = MK_PER_PHASE ? li : 0; a.ph_hi = MK_PER_PHASE ? li + 1 : N_PHASES; a.li = li;
        hipLaunchKernelGGL(fwd_kernel, dim3(grid), dim3(NWAVES * 64), LDS_BYTES, stream, a);
        const hipError_t le = hipPeekAtLastError();
        if (le != hipSuccess) { fprintf(stderr, "kernel_launch: launch %d failed: %s (grid %d x %d threads, %d B LDS)\n", li, hipGetErrorName(le), grid, NWAVES * 64, LDS_BYTES); break; }
    }
}
#endif
```

```cpp
#ifndef EMU
#include <hip/hip_runtime.h>
#include <cstdio>
#include <cstdint>
#define HD __host__ __device__ __forceinline__
#else
#include <cstdio>
#include <cstdint>
#include <cmath>
#include <cstring>
#define HD inline
#endif

#ifndef SEQ_LEN
#define SEQ_LEN 8192
#endif
constexpr int BATCH = 2, SEQ = SEQ_LEN, D = 1024, M = BATCH * SEQ;
constexpr int DC = 512, DSC = 512, NIN = 4608, DFF = 2816, NUP = 2 * DFF, PLE = 256, CKA = 31, NLAYER = 2;
constexpr float EPS = 1e-6f;
constexpr int NQ_UP = (M + 61) / 62;
constexpr int NT_UP = (NQ_UP + 3) / 4;

typedef unsigned short bf16_t;
typedef short bf16x8 __attribute__((ext_vector_type(8)));
typedef float f32x4 __attribute__((ext_vector_type(4)));
typedef float f32x2 __attribute__((ext_vector_type(2)));
typedef unsigned u32x4 __attribute__((ext_vector_type(4)));
typedef unsigned u32x2 __attribute__((ext_vector_type(2)));

HD float bits2f(unsigned u) { return __builtin_bit_cast(float, u); }
HD unsigned f2bits(float f) { return __builtin_bit_cast(unsigned, f); }
HD unsigned f2bf(float f) { unsigned u = f2bits(f); return (u + 0x7fffu + ((u >> 16) & 1u)) >> 16; }
HD unsigned pk2(float lo, float hi) {
#if defined(__HIP_DEVICE_COMPILE__)
    unsigned r; asm volatile("v_cvt_pk_bf16_f32 %0, %1, %2" : "=v"(r) : "v"(lo), "v"(hi)); return r;
#else
    return f2bf(lo) | (f2bf(hi) << 16);
#endif
}
HD float bf_lo(unsigned w) { return bits2f(w << 16); }
HD float bf_hi(unsigned w) { return bits2f(w & 0xffff0000u); }
HD float fexp2(float x) {
#if defined(__HIP_DEVICE_COMPILE__)
    return __builtin_amdgcn_exp2f(x);
#else
    return exp2f(x);
#endif
}
HD float frcp(float x) {
#if defined(__HIP_DEVICE_COMPILE__)
    return __builtin_amdgcn_rcpf(x);
#else
    return 1.0f / x;
#endif
}
HD float frsq(float x) {
#if defined(__HIP_DEVICE_COMPILE__)
    return __builtin_amdgcn_rsqf(x);
#else
    return 1.0f / sqrtf(x);
#endif
}
HD float sigm(float x) { return frcp(1.0f + fexp2(-1.44269504089f * x)); }
HD float gelu_tanh(float x) { const float y = x * (1.5957691216f + 0.0713548163f * x * x); return x * sigm(y); }
HD f32x4 sigm4(f32x4 v) { return (f32x4){sigm(v[0]), sigm(v[1]), sigm(v[2]), sigm(v[3])}; }
HD u32x4 pk8(f32x4 a, f32x4 b) { u32x4 w; w.x = pk2(a[0], a[1]); w.y = pk2(a[2], a[3]); w.z = pk2(b[0], b[1]); w.w = pk2(b[2], b[3]); return w; }
HD u32x2 pk4(f32x4 a) { u32x2 w; w.x = pk2(a[0], a[1]); w.y = pk2(a[2], a[3]); return w; }
HD f32x4 unpk_lo(u32x4 w) { return (f32x4){bf_lo(w.x), bf_hi(w.x), bf_lo(w.y), bf_hi(w.y)}; }
HD f32x4 unpk_hi(u32x4 w) { return (f32x4){bf_lo(w.z), bf_hi(w.z), bf_lo(w.w), bf_hi(w.w)}; }
HD f32x4 unpk4(u32x2 w) { return (f32x4){bf_lo(w.x), bf_hi(w.x), bf_lo(w.y), bf_hi(w.y)}; }
#if defined(__HIP_DEVICE_COMPILE__)
#define CFENCE() asm volatile("" ::: "memory")
#define LAUNDER(x) asm volatile("" : "+v"(x))
#else
#define CFENCE() do {} while (0)
#define LAUNDER(x) do {} while (0)
#endif
HD float hsum4(f32x4 a) { return (a[0] + a[1]) + (a[2] + a[3]); }

HD float row_rs(const float* SS, int g) {
    const f32x4* p = (const f32x4*)(SS + (size_t)g * 16);
    const f32x4 a = p[0], b = p[1], c = p[2], d = p[3];
    const float s = (hsum4(a) + hsum4(b)) + (hsum4(c) + hsum4(d));
    return frsq(s * (1.0f / (float)D) + EPS);
}

template <class Sh, class RowFn> HD void load_rs8(float (&rsv)[2][4], const float* SS, int fq, int lane, const Sh& sh, const RowFn& rowfn) {
    f32x4 q[2][4];
#pragma unroll
    for (int ai = 0; ai < 2; ++ai)
#pragma unroll
        for (int m = 0; m < 4; ++m) q[ai][m] = *(const f32x4*)(SS + (size_t)rowfn(ai, m) * 16 + fq * 4);
#pragma unroll
    for (int ai = 0; ai < 2; ++ai)
#pragma unroll
        for (int m = 0; m < 4; ++m) { float s = hsum4(q[ai][m]); s += sh(s, lane ^ 16); s += sh(s, lane ^ 32); rsv[ai][m] = frsq(s * (1.0f / (float)D) + EPS); }
}

HD int win_dst(int s) {
    if (s < 512) return 256 * (s >> 7) + (s & 127);
    if (s < 1024) { const int c = s - 512; return 256 * (c >> 7) + 128 + (c & 127); }
    if (s < 1536) return 2048 + (s - 1024);
    if (s < 2048) { const int c = s - 1536; return 256 * (4 + (c >> 7)) + (c & 127); }
    if (s < 2560) { const int c = s - 2048; return 256 * (4 + (c >> 7)) + 128 + (c & 127); }
    if (s < 3584) { const int c = s - 2560; return 256 * (10 + (c >> 7)) + (c & 127); }
    { const int c = s - 3584; return 256 * (10 + (c >> 7)) + 128 + (c & 127); }
}
HD int wup_dst(int s) { if (s < DFF) return 256 * (s >> 7) + (s & 127); const int c = s - DFF; return 256 * (c >> 7) + 128 + (c & 127); }

constexpr int BM = 256, BK = 64, HALF = 128, HTB = HALF * BK * 2  , STAGE_BYTES = 8 * HTB, NXCD = 8, WGM = 8;
struct Unit { int pm, pn; };
struct Gemm { const bf16_t* A; const bf16_t* Bt; int K; };
struct StaticOrder {
    int nM, nN, nwg, G, c;
    HD void init(int nM_, int nN_, int G_, int c_) { nM = nM_; nN = nN_; nwg = nM * nN; G = G_; c = c_; }
    HD bool next(int i, Unit& u) const {
        const long L = (long)i * G + c; if (L >= nwg) return false;
        int wgid = (int)L; { const int q = nwg / NXCD, r = nwg % NXCD, xcd = wgid % NXCD, off = wgid / NXCD; wgid = (xcd < r ? xcd * (q + 1) : r * (q + 1) + (xcd - r) * q) + off; }
        const int nig = WGM * nN, gid = wgid / nig, fm = gid * WGM, gsz = (nM - fm) < WGM ? (nM - fm) : WGM;
        u.pm = fm + ((wgid % nig) % gsz); u.pn = (wgid % nig) / gsz; return true;
    }
    HD void a_ready(const Unit&) const {}
    HD void done(const Unit&) const {}
};

typedef f32x4 Acc[2][2][4][2];

struct EpiE {
    static constexpr int EPI_ID = 1;
    static constexpr bool PERM = true, AFTER_DRAIN = false, HAS_MID = false; static constexpr int MID_T = -1;
    bf16_t* E;
    template <class Sh> HD void operator()(const Acc& acc, const Unit& u, int wr, int wc, int fr, int fq, const Sh&) const {
        const int cb = u.pn * 256 + wc * 32 + 8 * fq;
#pragma unroll
        for (int ai = 0; ai < 2; ++ai)
#pragma unroll
            for (int m = 0; m < 4; ++m) { const int g = u.pm * 256 + ai * 128 + wr * 64 + m * 16 + fr; bf16_t* rowp = E + (size_t)g * D + cb;
#pragma unroll
                for (int bj = 0; bj < 2; ++bj) *(u32x4*)(rowp + bj * 128) = pk8(acc[ai][bj][m][0], acc[ai][bj][m][1]); }
    }
    template <class Sh> HD void mid(Acc&, const Unit&, int, int, int, int, const Sh&) const {}
};

struct EpiIn {
    static constexpr int EPI_ID = 2;
    static constexpr bool PERM = true, AFTER_DRAIN = false, HAS_MID = false; static constexpr int MID_T = -1;
    const float* SS; const float* bgate; bf16_t *AGLU, *CV, *BS, *GR, *GB;
    template <class Sh> HD void operator()(const Acc& acc, const Unit& u, int wr, int wc, int fr, int fq, const Sh& sh) const {
        const int cb = wc * 32 + 8 * fq;
        const int pn = u.pn, grow = u.pm * 256 + wr * 64 + fr, lane = fq * 16 + fr;
        float rsv[2][4];
        load_rs8(rsv, SS, fq, lane, sh, [&](int ai, int m) { return grow + ai * 128 + m * 16; });
        if (pn < 4) {
#pragma unroll
            for (int ai = 0; ai < 2; ++ai)
#pragma unroll
                for (int m = 0; m < 4; ++m) { const int g = grow + ai * 128 + m * 16; const float rs = rsv[ai][m];
                    *(u32x4*)(AGLU + (size_t)g * DC + pn * 128 + cb) = pk8((acc[ai][0][m][0] * rs) * sigm4(acc[ai][1][m][0] * rs), (acc[ai][0][m][1] * rs) * sigm4(acc[ai][1][m][1] * rs)); }
        } else if (pn < 8) {
#pragma unroll
            for (int ai = 0; ai < 2; ++ai)
#pragma unroll
                for (int m = 0; m < 4; ++m) { const int g = grow + ai * 128 + m * 16; const float r2 = rsv[ai][m] * rsv[ai][m];
                    *(u32x4*)(CV + (size_t)g * DSC + (pn - 4) * 128 + cb) = pk8(acc[ai][0][m][0] * acc[ai][1][m][0] * r2, acc[ai][0][m][1] * acc[ai][1][m][1] * r2); }
        } else if (pn < 10) {
#pragma unroll
            for (int ai = 0; ai < 2; ++ai)
#pragma unroll
                for (int m = 0; m < 4; ++m) { const int g = grow + ai * 128 + m * 16; const float rs = rsv[ai][m];
                    bf16_t* rowp = BS + (size_t)g * DSC + (pn - 8) * 256 + cb;
                    *(u32x4*)rowp = pk8(acc[ai][0][m][0] * rs, acc[ai][0][m][1] * rs); *(u32x4*)(rowp + 128) = pk8(acc[ai][1][m][0] * rs, acc[ai][1][m][1] * rs); }
        } else {
            const int t = pn - 10; const float* pa = bgate + t * 128 + cb; const float* pb = bgate + D + t * 128 + cb;
            const f32x4 ba0 = *(const f32x4*)pa, ba1 = *(const f32x4*)(pa + 4), bb0 = *(const f32x4*)pb, bb1 = *(const f32x4*)(pb + 4);
#pragma unroll
            for (int ai = 0; ai < 2; ++ai)
#pragma unroll
                for (int m = 0; m < 4; ++m) { const int g = grow + ai * 128 + m * 16; const float rs = rsv[ai][m];
                    const size_t o = (size_t)g * D + t * 128 + cb;
                    const f32x4 la0 = acc[ai][0][m][0] * rs + ba0, la1 = acc[ai][0][m][1] * rs + ba1, lb0 = acc[ai][1][m][0] * rs + bb0, lb1 = acc[ai][1][m][1] * rs + bb1;
                    f32x4 r0, r1, g0, g1;
#pragma unroll
                    for (int j = 0; j < 4; ++j) {
                        const float ea0 = fexp2(-1.44269504089f * la0[j]), eb0 = fexp2(-1.44269504089f * lb0[j]), ea1 = fexp2(-1.44269504089f * la1[j]), eb1 = fexp2(-1.44269504089f * lb1[j]);
                        g0[j] = frcp(1.0f + eb0); r0[j] = (1.0f + eb0) * frcp(1.0f + ea0); g1[j] = frcp(1.0f + eb1); r1[j] = (1.0f + eb1) * frcp(1.0f + ea1); }
                    *(u32x4*)(GR + o) = pk8(r0, r1); *(u32x4*)(GB + o) = pk8(g0, g1); }
        }
    }
    template <class Sh> HD void mid(Acc&, const Unit&, int, int, int, int, const Sh&) const {}
};

struct EpiMerge {
    static constexpr int EPI_ID = 3;
    static constexpr bool PERM = true, AFTER_DRAIN = false, HAS_MID = true; static constexpr int MID_T = 8;
    const bf16_t *GR, *GB; bf16_t* MG;
    template <class Sh> HD void mid(Acc& acc, const Unit& u, int wr, int wc, int fr, int fq, const Sh&) const {
        LAUNDER(fr); LAUNDER(fq);
        const int cb = u.pn * 256 + wc * 32 + 8 * fq, grow = u.pm * 256 + wr * 64 + fr;
#pragma unroll
        for (int ai = 0; ai < 2; ++ai) {
            u32x4 w[4][2];
#pragma unroll
            for (int m = 0; m < 4; ++m)
#pragma unroll
                for (int bj = 0; bj < 2; ++bj) w[m][bj] = *(const u32x4*)(GR + (size_t)(grow + ai * 128 + m * 16) * D + cb + bj * 128);
#pragma unroll
            for (int m = 0; m < 4; ++m)
#pragma unroll
                for (int bj = 0; bj < 2; ++bj) { acc[ai][bj][m][0] *= unpk_lo(w[m][bj]); acc[ai][bj][m][1] *= unpk_hi(w[m][bj]); }
            CFENCE();
        }
    }
    template <class Sh> HD void operator()(const Acc& acc, const Unit& u, int wr, int wc, int fr, int fq, const Sh&) const {
        const int cb = u.pn * 256 + wc * 32 + 8 * fq, grow = u.pm * 256 + wr * 64 + fr;
#pragma unroll
        for (int ai = 0; ai < 2; ++ai) {
            u32x4 w[4][2];
#pragma unroll
            for (int m = 0; m < 4; ++m)
#pragma unroll
                for (int bj = 0; bj < 2; ++bj) w[m][bj] = *(const u32x4*)(GB + (size_t)(grow + ai * 128 + m * 16) * D + cb + bj * 128);
#pragma unroll
            for (int m = 0; m < 4; ++m)
#pragma unroll
                for (int bj = 0; bj < 2; ++bj) *(u32x4*)(MG + (size_t)(grow + ai * 128 + m * 16) * D + cb + bj * 128) = pk8(acc[ai][bj][m][0] * unpk_lo(w[m][bj]), acc[ai][bj][m][1] * unpk_hi(w[m][bj]));
            CFENCE();
        }
    }
};

template <int MODE> struct EpiRes {
    static constexpr int EPI_ID = 6 + MODE;
    static constexpr bool PERM = true, AFTER_DRAIN = false, HAS_MID = false; static constexpr int MID_T = -1;
    const bf16_t* xin; bf16_t* xout; float* ssout; const float* ssin; const bf16_t* E;
    template <class Sh> HD void operator()(const Acc& acc, const Unit& u, int wr, int wc, int fr, int fq, const Sh& sh) const {
        const int cb = u.pn * 256 + wc * 32 + 8 * fq; const int lane = fq * 16 + fr, grow = u.pm * 256 + wr * 64 + fr;
        float rsv[2][4];
        if (MODE == 1) load_rs8(rsv, ssin, fq, lane, sh, [&](int ai, int m) { return grow + ai * 128 + m * 16; });
        constexpr int MB = MODE == 1 ? 2 : 4;
#pragma unroll
        for (int ai = 0; ai < 2; ++ai)
#pragma unroll
        for (int mh = 0; mh < 4; mh += MB) {
            u32x4 xi[MB][2], ev[MB][2];
#pragma unroll
            for (int mm = 0; mm < MB; ++mm)
#pragma unroll
                for (int bj = 0; bj < 2; ++bj) { const size_t o = (size_t)(grow + ai * 128 + (mh + mm) * 16) * D + cb + bj * 128; xi[mm][bj] = *(const u32x4*)(xin + o); if (MODE == 1) ev[mm][bj] = *(const u32x4*)(E + o); }
#pragma unroll
            for (int mm = 0; mm < MB; ++mm) {
                const int m = mh + mm, g = grow + ai * 128 + m * 16; float sq = 0.f;
#pragma unroll
                for (int bj = 0; bj < 2; ++bj) { const size_t o = (size_t)g * D + cb + bj * 128;
                    f32x4 v0 = acc[ai][bj][m][0], v1 = acc[ai][bj][m][1];
                    if (MODE == 1) { const float rs = rsv[ai][m]; v0 = sigm4(v0 * rs) * unpk_lo(ev[mm][bj]); v1 = sigm4(v1 * rs) * unpk_hi(ev[mm][bj]); }
                    const f32x4 x0 = unpk_lo(xi[mm][bj]) + v0, x1 = unpk_hi(xi[mm][bj]) + v1;
                    *(u32x4*)(xout + o) = pk8(x0, x1);
                    sq += ((x0[0] * x0[0] + x0[1] * x0[1]) + (x0[2] * x0[2] + x0[3] * x0[3])) + ((x1[0] * x1[0] + x1[1] * x1[1]) + (x1[2] * x1[2] + x1[3] * x1[3])); }
                sq += sh(sq, lane ^ 16); sq += sh(sq, lane ^ 32);
                if (fq == 0) ssout[(size_t)g * 16 + u.pn * 4 + wc] = sq;
            }
            CFENCE();
        }
    }
    template <class Sh> HD void mid(Acc&, const Unit&, int, int, int, int, const Sh&) const {}
};

struct EpiUp {
    static constexpr int EPI_ID = 5;
    static constexpr bool PERM = true, AFTER_DRAIN = false, HAS_MID = false; static constexpr int MID_T = -1;
    const float* SS; const float* cw; const float* cb_; bf16_t* F;
    template <class Sh> HD void operator()(const Acc& acc, const Unit& u, int wr, int wc, int fr, int fq, const Sh& sh) const {
        const int ch = u.pn * 128 + wc * 32 + 8 * fq;
        const int lane = fq * 16 + fr;
        float rsv[2][4];
        load_rs8(rsv, SS, fq, lane, sh, [&](int ai, int m) { const int g = 62 * (4 * u.pm + 2 * ai + wr) - 2 + m * 16 + fr; return g < 0 ? 0 : (g > M - 1 ? M - 1 : g); });
        const f32x4 w0a = *(const f32x4*)(cw + ch), w0b = *(const f32x4*)(cw + ch + 4), w1a = *(const f32x4*)(cw + DFF + ch), w1b = *(const f32x4*)(cw + DFF + ch + 4);
        const f32x4 w2a = *(const f32x4*)(cw + 2 * DFF + ch), w2b = *(const f32x4*)(cw + 2 * DFF + ch + 4), bia = *(const f32x4*)(cb_ + ch), bib = *(const f32x4*)(cb_ + ch + 4);
#pragma unroll
        for (int ai = 0; ai < 2; ++ai) {
            const int q = 4 * u.pm + 2 * ai + wr;
            f32x4 pa = {0.f, 0.f, 0.f, 0.f}, pb = pa;
#pragma unroll
            for (int m = 0; m < 4; ++m) {
                const int rho = m * 16 + fr, g = 62 * q - 2 + rho; const int gc = g < 0 ? 0 : (g > M - 1 ? M - 1 : g);
                const float rs = rsv[ai][m];
                const f32x4 ga = acc[ai][0][m][0] * rs, gb = acc[ai][0][m][1] * rs, va = acc[ai][1][m][0] * rs, vb = acc[ai][1][m][1] * rs;
                f32x4 t1a, t1b, t2a, t2b;
#pragma unroll
                for (int j = 0; j < 4; ++j) {
                    t1a[j] = sh.ror1(fr == 15 ? pa[j] : ga[j]); t1b[j] = sh.ror1(fr == 15 ? pb[j] : gb[j]);
                    t2a[j] = sh.ror2(fr >= 14 ? pa[j] : ga[j]); t2b[j] = sh.ror2(fr >= 14 ? pb[j] : gb[j]);
                }
                pa = ga; pb = gb;
                const int t = gc % SEQ;
                if (t < 1) { t1a = (f32x4){0.f, 0.f, 0.f, 0.f}; t1b = t1a; }
                if (t < 2) { t2a = (f32x4){0.f, 0.f, 0.f, 0.f}; t2b = t2a; }
                const f32x4 fa = w2a * ga + w1a * t1a + w0a * t2a + bia, fb = w2b * gb + w1b * t1b + w0b * t2b + bib;
                f32x4 oa, ob;
#pragma unroll
                for (int j = 0; j < 4; ++j) { oa[j] = gelu_tanh(fa[j]) * va[j]; ob[j] = gelu_tanh(fb[j]) * vb[j]; }
                if (rho >= 2 && g < M) *(u32x4*)(F + (size_t)g * DFF + ch) = pk8(oa, ob);
            }
        }
    }
    template <class Sh> HD void mid(Acc&, const Unit&, int, int, int, int, const Sh&) const {}
};

#ifndef EMU
#define PG8_LAS __attribute__((address_space(3)))
#define GAS __attribute__((address_space(1)))
#define LAS __attribute__((address_space(3)))
typedef GAS unsigned gu32;
#define RLX_AGENT __ATOMIC_RELAXED, __HIP_MEMORY_SCOPE_AGENT
#define LDS_WAIT() asm volatile("s_waitcnt lgkmcnt(0)" ::: "memory")
#define VM_WAIT() asm volatile("s_waitcnt vmcnt(0)" ::: "memory")
#ifndef ROR_DPP
#define ROR_DPP 1
#endif
struct ShflDev {
    __device__ __forceinline__ float operator()(float v, int src) const { return __shfl(v, src, 64); }
#if ROR_DPP
    __device__ __forceinline__ float ror1(float v) const { return __builtin_bit_cast(float, __builtin_amdgcn_update_dpp(0, __builtin_bit_cast(int, v), 0x121, 0xf, 0xf, false)); }
    __device__ __forceinline__ float ror2(float v) const { return __builtin_bit_cast(float, __builtin_amdgcn_update_dpp(0, __builtin_bit_cast(int, v), 0x122, 0xf, 0xf, false)); }
#else
    __device__ __forceinline__ float ror1(float v) const { const int l = threadIdx.x & 63; return __shfl(v, (l & 48) | ((l + 15) & 15), 64); }
    __device__ __forceinline__ float ror2(float v) const { const int l = threadIdx.x & 63; return __shfl(v, (l & 48) | ((l + 14) & 15), 64); }
#endif
};

__host__ __device__ __forceinline__ int lds_byte(int r, int c) { const int st = (r >> 4) * 2 + (c >> 5), rr = r & 15, cc = c & 31, ob = rr * 64 + cc * 2; return st * 1024 + (ob ^ (((ob >> 9) & 1) << 5)); }
__host__ __device__ __forceinline__ void stage_rc(int b, int& R, int& C) { const int st = b / 1024, sb = b % 1024, swz = sb ^ (((sb >> 9) & 1) << 5); R = (st >> 1) * 16 + swz / 64; C = (st & 1) * 32 + (swz % 64) / 2; }
__host__ __device__ __forceinline__ int perm32(int rho) { const int n = rho >> 4, i = rho & 15; return 8 * (i >> 2) + 4 * n + (i & 3); }

template <class Epi, class Sched, bool ALIGN_EPI = false, bool SP2 = false, bool ACHUNK = false>
__device__ __forceinline__ void gemm_phase(PG8_LAS unsigned char* lds, const Gemm g, const Sched& S, const Epi& E) {
    int tid_ = threadIdx.x; asm volatile("" : "+v"(tid_));
    const int tid = tid_, wid = __builtin_amdgcn_readfirstlane(tid >> 6), lane = tid & 63, wr = wid >> 2, wc = wid & 3, fr = lane & 15, fq = lane >> 4;
    int K_ = g.K; asm volatile("" : "+s"(K_));
    const int K = K_, nt = K / BK;
    unsigned voffA[2], voffB[2];
#pragma unroll
    for (int i = 0; i < 2; ++i) { int R, C; stage_rc(tid * 16 + i * 8192, R, C); const int Rb = Epi::PERM ? ((R & ~31) + perm32(R & 31)) : R;
        const int Ra = ACHUNK ? ((R >> 6) * 62 + (R & 63)) : R; voffA[i] = (unsigned)(Ra * K + C) * 2u; voffB[i] = (unsigned)(Rb * K + C) * 2u; }
    const size_t kstep = (size_t)(BK * 2);
    const size_t hstepB = (size_t)HALF * K * 2, hstepA = ACHUNK ? (size_t)124 * K * 2 : hstepB;
    const size_t tstepA = 2 * hstepA, tstepB = 2 * hstepB;
    const unsigned ldsw = (unsigned)wid * 1024u;
    const int aoff = lds_byte(wr * 64 + fr, fq * 8), boff = lds_byte(wc * 32 + fr, fq * 8);
#define PG8_SA(b, h) (((b) * 2 + (h)) * HTB)
#define PG8_SB(b, h) ((4 + (b) * 2 + (h)) * HTB)
#define PG8_STAGE(bufoff, gbase, voff) do { _Pragma("unroll") for (int _i = 0; _i < 2; ++_i) \
        __builtin_amdgcn_global_load_lds((const unsigned*)((const char*)(gbase) + (voff)[_i]), (PG8_LAS unsigned*)(lds + (bufoff) + ldsw + _i * 8192), 16, 0, 0); } while (0)
#define PG8_LDA(dst, b, h) do { _Pragma("unroll") for (int m = 0; m < 4; ++m) _Pragma("unroll") for (int k = 0; k < 2; ++k) dst[m][k] = *(const PG8_LAS bf16x8*)(lds + PG8_SA(b, h) + aoff + m * 2048 + k * 1024); } while (0)
#define PG8_LDB(dst, b, h) do { _Pragma("unroll") for (int n = 0; n < 2; ++n) _Pragma("unroll") for (int k = 0; k < 2; ++k) dst[n][k] = *(const PG8_LAS bf16x8*)(lds + PG8_SB(b, h) + boff + n * 2048 + k * 1024); } while (0)
#define PG8_MMA(ai, bj, At, Bt) do { __builtin_amdgcn_s_setprio(1); _Pragma("unroll") for (int m = 0; m < 4; ++m) _Pragma("unroll") for (int n = 0; n < 2; ++n) _Pragma("unroll") for (int k = 0; k < 2; ++k) \
        acc[ai][bj][m][n] = __builtin_amdgcn_mfma_f32_16x16x32_bf16(Bt[n][k], At[m][k], acc[ai][bj][m][n], 0, 0, 0); __builtin_amdgcn_s_setprio(0); } while (0)
#define PG8_WAIT_V(n) asm volatile("s_waitcnt vmcnt(" #n ")" ::: "memory")
#define PG8_WAIT_L(n) asm volatile("s_waitcnt lgkmcnt(" #n ")" ::: "memory")
#define PG8_BAR __builtin_amdgcn_s_barrier()
#define PG8_SCHED __builtin_amdgcn_sched_barrier(0)
    Unit cur, nxt; int ui = 0;
    if (!S.next(0, cur)) return;
    f32x4 acc[2][2][4][2];
#pragma unroll
    for (int a = 0; a < 2; ++a)
#pragma unroll
        for (int b = 0; b < 2; ++b)
#pragma unroll
            for (int m = 0; m < 4; ++m)
#pragma unroll
                for (int n = 0; n < 2; ++n) acc[a][b][m][n] = (f32x4){0.f, 0.f, 0.f, 0.f};
    bf16x8 At[4][2], B0[2][2], B1[2][2];
    const char* cA = (const char*)g.A + (size_t)cur.pm * tstepA; const char* cB = (const char*)g.Bt + (size_t)cur.pn * tstepB;
    S.a_ready(cur);
    if constexpr (SP2) {
        PG8_STAGE(PG8_SB(0, 0), cB, voffB); PG8_STAGE(PG8_SB(0, 1), cB + hstepB, voffB); PG8_STAGE(PG8_SA(0, 0), cA, voffA); PG8_STAGE(PG8_SA(0, 1), cA + hstepA, voffA);
        if (wr == 1) PG8_BAR;
        PG8_WAIT_V(2); PG8_BAR;
        PG8_STAGE(PG8_SB(1, 0), cB + kstep, voffB); PG8_STAGE(PG8_SA(1, 0), cA + kstep, voffA); PG8_STAGE(PG8_SB(1, 1), cB + hstepB + kstep, voffB);
        PG8_WAIT_V(6); PG8_BAR;
    } else {
        PG8_STAGE(PG8_SB(0, 0), cB, voffB); PG8_STAGE(PG8_SA(0, 0), cA, voffA); PG8_STAGE(PG8_SB(0, 1), cB + hstepB, voffB); PG8_STAGE(PG8_SA(0, 1), cA + hstepA, voffA);
        if (wr == 1) PG8_BAR;
        PG8_WAIT_V(4); PG8_BAR;
        PG8_STAGE(PG8_SB(1, 0), cB + kstep, voffB); PG8_STAGE(PG8_SA(1, 0), cA + kstep, voffA); PG8_STAGE(PG8_SB(1, 1), cB + hstepB + kstep, voffB);
        PG8_WAIT_V(6); PG8_BAR;
    }
    for (;;) {
        const bool has_next = S.next(ui + 1, nxt);
        const char* nA = has_next ? (const char*)g.A + (size_t)nxt.pm * tstepA : cA; const char* nB = has_next ? (const char*)g.Bt + (size_t)nxt.pn * tstepB : cB;
        for (int t = 0; t < nt; t += 2) {
            const bool last = (t == nt - 2);
            if constexpr (Epi::HAS_MID) { if (t == Epi::MID_T) E.mid(acc, cur, wr, wc, fr, fq, ShflDev{}); }
            const char* a1 = cA + (size_t)(t + 1) * kstep;
            const char* a2 = last ? nA : cA + (size_t)(t + 2) * kstep; const char* b2 = last ? nB : cB + (size_t)(t + 2) * kstep;
            const char* a3 = a2 + kstep; const char* b3 = b2 + kstep;
            if (last && has_next) S.a_ready(nxt);
            if constexpr (SP2) {
            PG8_LDB(B0, 0, 0); PG8_LDB(B1, 0, 1); PG8_SCHED; PG8_LDA(At, 0, 0); PG8_STAGE(PG8_SA(1, 1), a1 + hstepA, voffA);
            PG8_WAIT_V(8); PG8_WAIT_L(0); PG8_BAR; PG8_MMA(0, 0, At, B0); PG8_MMA(0, 1, At, B1); PG8_BAR; PG8_SCHED;
            PG8_LDA(At, 0, 1); PG8_STAGE(PG8_SB(0, 0), b2, voffB); PG8_STAGE(PG8_SB(0, 1), b2 + hstepB, voffB); PG8_STAGE(PG8_SA(0, 0), a2, voffA);
            PG8_WAIT_V(8); PG8_WAIT_L(0); PG8_BAR; PG8_MMA(1, 0, At, B0); PG8_MMA(1, 1, At, B1); PG8_BAR; PG8_SCHED;
            PG8_LDB(B0, 1, 0); PG8_LDB(B1, 1, 1); PG8_SCHED; PG8_LDA(At, 1, 0); PG8_STAGE(PG8_SA(0, 1), a2 + hstepA, voffA);
            PG8_WAIT_V(8); PG8_WAIT_L(0); PG8_BAR; PG8_MMA(0, 0, At, B0); PG8_MMA(0, 1, At, B1); PG8_BAR; PG8_SCHED;
            PG8_LDA(At, 1, 1); PG8_STAGE(PG8_SB(1, 0), b3, voffB); PG8_STAGE(PG8_SB(1, 1), b3 + hstepB, voffB); PG8_STAGE(PG8_SA(1, 0), a3, voffA);
            PG8_WAIT_V(8); PG8_WAIT_L(0); PG8_BAR; PG8_MMA(1, 0, At, B0); PG8_MMA(1, 1, At, B1); PG8_BAR; PG8_SCHED;
            } else {
            PG8_LDB(B0, 0, 0); PG8_SCHED; PG8_LDA(At, 0, 0); PG8_STAGE(PG8_SA(1, 1), a1 + hstepA, voffA);
            PG8_WAIT_L(8); PG8_BAR; PG8_WAIT_L(0); PG8_MMA(0, 0, At, B0); PG8_BAR; PG8_SCHED;
            PG8_LDB(B1, 0, 1); PG8_STAGE(PG8_SB(0, 0), b2, voffB);
            PG8_BAR; PG8_WAIT_L(0); PG8_MMA(0, 1, At, B1); PG8_BAR;
            PG8_LDA(At, 0, 1); PG8_STAGE(PG8_SA(0, 0), a2, voffA);
            PG8_BAR; PG8_WAIT_L(0); PG8_MMA(1, 0, At, B0); PG8_BAR; PG8_SCHED;
            PG8_STAGE(PG8_SB(0, 1), b2 + hstepB, voffB);
            PG8_WAIT_V(6); PG8_BAR; PG8_MMA(1, 1, At, B1); PG8_BAR;
            PG8_LDB(B0, 1, 0); PG8_SCHED; PG8_LDA(At, 1, 0); PG8_STAGE(PG8_SA(0, 1), a2 + hstepA, voffA);
            PG8_WAIT_L(8); PG8_BAR; PG8_WAIT_L(0); PG8_MMA(0, 0, At, B0); PG8_BAR; PG8_SCHED;
            PG8_LDB(B1, 1, 1); PG8_STAGE(PG8_SB(1, 0), b3, voffB);
            PG8_BAR; PG8_WAIT_L(0); PG8_MMA(0, 1, At, B1); PG8_BAR;
            PG8_LDA(At, 1, 1); PG8_STAGE(PG8_SA(1, 0), a3, voffA);
            PG8_BAR; PG8_WAIT_L(0); PG8_MMA(1, 0, At, B0); PG8_BAR; PG8_SCHED;
            PG8_STAGE(PG8_SB(1, 1), b3 + hstepB, voffB);
            PG8_WAIT_V(6); PG8_BAR; PG8_MMA(1, 1, At, B1); PG8_BAR;
            }
        }
        if constexpr (ALIGN_EPI) { if (wr == 0) PG8_BAR; }
        if constexpr (!Epi::AFTER_DRAIN) { E(acc, cur, wr, wc, fr, fq, ShflDev{});
#ifdef EPI2X
            if (Epi::EPI_ID == EPI2X) { asm volatile("" ::: "memory"); E(acc, cur, wr, wc, fr, fq, ShflDev{}); }
#endif
            S.done(cur); }
        if (!has_next) break;
#pragma unroll
        for (int a = 0; a < 2; ++a)
#pragma unroll
            for (int b = 0; b < 2; ++b)
#pragma unroll
                for (int m = 0; m < 4; ++m)
#pragma unroll
                    for (int n = 0; n < 2; ++n) acc[a][b][m][n] = (f32x4){0.f, 0.f, 0.f, 0.f};
        cur = nxt; cA = nA; cB = nB; ++ui;
        if constexpr (ALIGN_EPI) { if (wr == 1) PG8_BAR; }
    }
    PG8_WAIT_V(0);
    if constexpr (!ALIGN_EPI) { if (wr == 0) PG8_BAR; }
    PG8_BAR;
#undef PG8_SA
#undef PG8_SB
#undef PG8_STAGE
#undef PG8_LDA
#undef PG8_LDB
#undef PG8_MMA
#undef PG8_WAIT_V
#undef PG8_WAIT_L
#undef PG8_BAR
#undef PG8_SCHED
}

constexpr int NWAVES = 8;
#ifndef MK_PER_PHASE
#define MK_PER_PHASE 0
#endif
constexpr int N_PHASES = 7 * NLAYER + 2;

constexpr size_t MiB = 1u << 20;
constexpr size_t WS_CTL = 0, CTL_ZERO_BYTES = 64 * 1024;
constexpr size_t WS_SS0 = 1 * MiB, WS_SS1 = 2 * MiB;
constexpr size_t WS_WB = 3 * MiB;
constexpr size_t WB_WIN = 0, WB_WAB = WB_WIN + (size_t)NIN * D, WB_WO = WB_WAB + (size_t)D * D, WB_WUP = WB_WO + (size_t)D * D, WB_WDN = WB_WUP + (size_t)NUP * D,
                 WB_WPG = WB_WDN + (size_t)D * DFF, WB_WPL = WB_WPG + (size_t)D * D, WB_END = WB_WPL + (size_t)D * PLE;
static_assert(WB_END * 2 == 32 * MiB, "weight copies fill 32 MiB");
constexpr size_t WS_PB = 35 * MiB;
constexpr size_t WS_XB = 44 * MiB;
constexpr size_t WS_ACT = 77 * MiB;
constexpr size_t WS_AGLU = WS_ACT, WS_CV = WS_ACT + 16 * MiB, WS_BS = WS_ACT + 32 * MiB, WS_GR = WS_ACT + 48 * MiB, WS_GB = WS_ACT + 80 * MiB,
                 WS_A2S = WS_ACT + 112 * MiB, WS_E = WS_ACT + 144 * MiB, WS_END = WS_ACT + 176 * MiB;
constexpr size_t WS_MG = WS_AGLU;
constexpr size_t WS_F = WS_ACT;
constexpr size_t WS_XB2 = WS_A2S;
static_assert(WS_END <= 256 * MiB && WS_F + (size_t)M * DFF * 2 <= WS_A2S && WS_XB + (size_t)(M + 256) * D * 2 <= WS_ACT, "d_ws map");
constexpr size_t OUT_XB2 = 0, OUT_WB1 = 32 * MiB;
static_assert(NLAYER == 2, "one layer's weight copies live in d_ws, the other's in d_out");
constexpr int CW_BAR = 4096;

constexpr int RING_OFF = 0, RING_BYTES = 131072;
constexpr int LDSCTL_OFF = RING_BYTES, MISC_OFF = LDSCTL_OFF + 320;
constexpr int LDS_BYTES = 147456;
static_assert(MISC_OFF + 128 <= LDS_BYTES, "LDS map");

#define XB_TMO      128
#define XB_XCNT(j)  (256  + 64 * (j))
#define XB_XSUB(j)  (1280 + 64 * (j))
#define XB_XGEN(j)  (2304 + 64 * (j))
#define XB_TOP      3328
#define XB_TOPGEN   3392
#define XCD_BAR_WORDS 3456
#define XB_SPIN_CAP (1u << 18)

__device__ __forceinline__ unsigned xb_ld(unsigned* p)              { return __hip_atomic_load(p, __ATOMIC_RELAXED, __HIP_MEMORY_SCOPE_AGENT); }
__device__ __forceinline__ unsigned xb_add(unsigned* p, unsigned v) { return __hip_atomic_fetch_add(p, v, __ATOMIC_RELAXED, __HIP_MEMORY_SCOPE_AGENT); }
__device__ __forceinline__ unsigned xb_xcc_id() { return (unsigned)__builtin_amdgcn_s_getreg((3 << 11) | 20) & 0xFu; }
#define XB_SPIN(cond, bar) do { unsigned _sp = 0; while (cond) { __builtin_amdgcn_s_sleep(1); \
    if ((++_sp & 255u) == 0u) { if (xb_ld(&(bar)[XB_TMO])) break; if (_sp > XB_SPIN_CAP) { atomicAdd(&(bar)[XB_TMO], 1u); break; } } } } while (0)

struct XcdBarrier {
    unsigned* bar; unsigned x;
    volatile LAS unsigned* st;
};

__device__ __forceinline__ XcdBarrier xcd_barrier_post(unsigned* bar, volatile LAS unsigned* st) {
    XcdBarrier b; b.bar = bar; b.x = xb_xcc_id(); b.st = st;
    if (threadIdx.x == 0) (void)xb_add(&bar[XB_XCNT(b.x)], 1u);
    return b;
}
__device__ __forceinline__ void xcd_barrier_complete(unsigned* bar, unsigned x, unsigned& nloc, unsigned& nx) {
    const unsigned G = gridDim.x * gridDim.y * gridDim.z;
    unsigned sum, cnt, mine, sp = 0u;
    for (;;) {
        sum = 0u; cnt = 0u; mine = 0u;
#pragma unroll
        for (unsigned j = 0; j < 16; ++j) { const unsigned c = xb_ld(&bar[XB_XCNT(j)]); sum += c; cnt += (c > 0u) ? 1u : 0u; mine = (j == x) ? c : mine; }
        if (sum == G) break;
        __builtin_amdgcn_s_sleep(1);
        if ((++sp & 255u) == 0u) { if (xb_ld(&bar[XB_TMO])) break; if (sp > XB_SPIN_CAP) { atomicAdd(&bar[XB_TMO], 1u); break; } }
    }
    nloc = mine > 0u ? mine : 1u; nx = cnt > 0u ? cnt : 1u;
}

__device__ __forceinline__ void xcd_barrier(const XcdBarrier& b) {
    asm volatile("s_waitcnt vmcnt(0)" ::: "memory");
    __syncthreads();
    if (threadIdx.x == 0) {
        unsigned* bar = b.bar;
        __builtin_amdgcn_s_waitcnt(0);
        unsigned nloc = b.st[0], nx = b.st[1];
        if (nloc == 0u) { xcd_barrier_complete(bar, b.x, nloc, nx); b.st[0] = nloc; b.st[1] = nx; }
        const unsigned old = xb_add(&bar[XB_XSUB(b.x)], 1u);
        const unsigned gen = old / nloc;
        if (old + 1u == (gen + 1u) * nloc) {
            __builtin_amdgcn_fence(__ATOMIC_RELEASE, "agent");
            asm volatile("s_waitcnt vmcnt(0)" ::: "memory");
            const unsigned og = xb_add(&bar[XB_TOP], 1u);
            const unsigned tg = og / nx;
            if (og + 1u == (tg + 1u) * nx) xb_add(&bar[XB_TOPGEN], 1u);
            else XB_SPIN(xb_ld(&bar[XB_TOPGEN]) == tg, bar);
            __builtin_amdgcn_fence(__ATOMIC_ACQUIRE, "agent");
            xb_add(&bar[XB_XGEN(b.x)], 1u);
            asm volatile("s_waitcnt vmcnt(0)" ::: "memory");
        } else {
            XB_SPIN(xb_ld(&bar[XB_XGEN(b.x)]) == gen, bar);
            __builtin_amdgcn_fence(__ATOMIC_ACQUIRE, "agent");
            asm volatile("s_waitcnt vmcnt(0)" ::: "memory");
        }
    }
    __syncthreads();
}

struct Frame {
    LAS unsigned char* lds;
    volatile LAS unsigned* MISC;
    gu32* ctl;
    int tid, lane, wave;
    int vcu, G;
    float* out; unsigned char* ws;
};
__device__ __forceinline__ float wave_sum(float v) {
#pragma unroll
    for (int o = 1; o < 64; o <<= 1) v += __shfl_xor(v, o, 64);
    return v;
}

__device__ __forceinline__ void cv_item(const float* W, int N, const float* gk, bf16_t* WT, int ldt, int kofs, int drow, int kb, int nb, LAS float* scr, int lane) {
    const int k0 = 64 * kb, n0 = 32 * nb, kq = lane >> 3, n4 = (lane & 7) * 4;
    f32x4 v[8]; float sc[8];
#pragma unroll
    for (int i = 0; i < 8; ++i) { v[i] = *(const GAS f32x4*)(W + (size_t)(k0 + 8 * i + kq) * N + n0 + n4); sc[i] = gk ? gk[k0 + 8 * i + kq] : 1.0f; }
#pragma unroll
    for (int i = 0; i < 8; ++i) { LAS float* d = scr + (8 * i + kq) * 33 + n4; const f32x4 t = v[i] * sc[i]; d[0] = t[0]; d[1] = t[1]; d[2] = t[2]; d[3] = t[3]; }
    LDS_WAIT(); asm volatile("" ::: "memory");
    const int c = lane & 7;
#pragma unroll
    for (int j = 0; j < 4; ++j) { const int n = (lane >> 3) + 8 * j; const LAS float* s = scr + (8 * c) * 33 + n;
        u32x4 o; o.x = pk2(s[0 * 33], s[1 * 33]); o.y = pk2(s[2 * 33], s[3 * 33]); o.z = pk2(s[4 * 33], s[5 * 33]); o.w = pk2(s[6 * 33], s[7 * 33]);
        *(GAS u32x4*)(WT + (size_t)(drow + n) * ldt + kofs + k0 + 8 * c) = o; }
    LDS_WAIT(); asm volatile("" ::: "memory");
}
struct CvPtrs { const float *x, *p, *g_mix, *w_in, *w_a, *w_b, *w_o, *g_ffn, *w_up, *w_dn, *g_ple, *w_pl, *w_pg; };
__device__ __forceinline__ void cv_p(Frame& F, int layer, const float* p) {
    const GAS f32x4* src = (const GAS f32x4*)(p + (size_t)layer * M * PLE); GAS u32x2* dst = (GAS u32x2*)(F.ws + WS_PB);
    const int gt = F.vcu * (NWAVES * 64) + F.tid, NT = F.G * NWAVES * 64;
    for (int i = gt; i < M * PLE / 4; i += 4 * NT) {
        f32x4 v[4];
#pragma unroll
        for (int j = 0; j < 4; ++j) { const int ii = i + j * NT; v[j] = src[ii < M * PLE / 4 ? ii : i]; }
#pragma unroll
        for (int j = 0; j < 4; ++j) { const int ii = i + j * NT; if (ii < M * PLE / 4) dst[ii] = pk4(v[j]); }
    }
}
__device__ __forceinline__ void cv_phase(Frame& F, const CvPtrs& P) {
    LAS float* scr = (LAS float*)(F.lds + RING_OFF + F.wave * 16384);
    const int gw = F.vcu * NWAVES + F.wave, NGW = F.G * NWAVES;
    constexpr int I_IN = (D / 64) * (NIN / 32), I_A = (DC / 64) * (D / 32), I_O = (D / 64) * (D / 32), I_UP = (D / 64) * (NUP / 32), I_DN = (DFF / 64) * (D / 32), I_PL = (PLE / 64) * (D / 32);
    constexpr int NITEMS = I_IN + 2 * I_A + I_O + I_UP + I_DN + I_O + I_PL;
    for (int it = gw; it < NLAYER * NITEMS; it += NGW) {
        const int layer = it / NITEMS; int r = it % NITEMS;
        bf16_t* WB = layer == 0 ? (bf16_t*)(F.ws + WS_WB) : (bf16_t*)((unsigned char*)F.out + OUT_WB1);
        if (r < I_IN) { const int nblk = NIN / 32, kb = r / nblk, nb = r % nblk; cv_item(P.w_in + (size_t)layer * D * NIN, NIN, P.g_mix + layer * D, WB + WB_WIN, D, 0, win_dst(32 * nb), kb, nb, scr, F.lane); continue; } r -= I_IN;
        if (r < I_A)  { const int nblk = D / 32, kb = r / nblk, nb = r % nblk; cv_item(P.w_a + (size_t)layer * DC * D, D, nullptr, WB + WB_WAB, D, 0, 32 * nb, kb, nb, scr, F.lane); continue; } r -= I_A;
        if (r < I_A)  { const int nblk = D / 32, kb = r / nblk, nb = r % nblk; cv_item(P.w_b + (size_t)layer * DSC * D, D, nullptr, WB + WB_WAB, D, DC, 32 * nb, kb, nb, scr, F.lane); continue; } r -= I_A;
        if (r < I_O)  { const int nblk = D / 32, kb = r / nblk, nb = r % nblk; cv_item(P.w_o + (size_t)layer * D * D, D, nullptr, WB + WB_WO, D, 0, 32 * nb, kb, nb, scr, F.lane); continue; } r -= I_O;
        if (r < I_UP) { const int nblk = NUP / 32, kb = r / nblk, nb = r % nblk; cv_item(P.w_up + (size_t)layer * D * NUP, NUP, P.g_ffn + layer * D, WB + WB_WUP, D, 0, wup_dst(32 * nb), kb, nb, scr, F.lane); continue; } r -= I_UP;
        if (r < I_DN) { const int nblk = D / 32, kb = r / nblk, nb = r % nblk; cv_item(P.w_dn + (size_t)layer * DFF * D, D, nullptr, WB + WB_WDN, DFF, 0, 32 * nb, kb, nb, scr, F.lane); continue; } r -= I_DN;
        if (r < I_O)  { const int nblk = D / 32, kb = r / nblk, nb = r % nblk; cv_item(P.w_pg + (size_t)layer * D * D, D, P.g_ple + layer * D, WB + WB_WPG, D, 0, 32 * nb, kb, nb, scr, F.lane); continue; } r -= I_O;
        { const int nblk = D / 32, kb = r / nblk, nb = r % nblk; cv_item(P.w_pl + (size_t)layer * PLE * D, D, nullptr, WB + WB_WPL, PLE, 0, 32 * nb, kb, nb, scr, F.lane); }
    }
    cv_p(F, 0, P.p);
    for (int m0 = gw * 4; m0 < M; m0 += NGW * 4) {
        f32x4 v[4][4];
#pragma unroll
        for (int r = 0; r < 4; ++r)
#pragma unroll
            for (int j = 0; j < 4; ++j) v[r][j] = ((const GAS f32x4*)(P.x + (size_t)(m0 + r) * D) + F.lane)[64 * j];
#pragma unroll
        for (int r = 0; r < 4; ++r) {
            GAS u32x2* o8 = (GAS u32x2*)(F.ws + WS_XB + (size_t)(m0 + r) * D * 2) + F.lane; float s = 0.f;
#pragma unroll
            for (int j = 0; j < 4; ++j) { const f32x4 t = v[r][j]; s += (t[0] * t[0] + t[1] * t[1]) + (t[2] * t[2] + t[3] * t[3]); o8[64 * j] = pk4(t); }
            s = wave_sum(s);
            if (F.lane < 16) ((GAS float*)(F.ws + WS_SS0))[(size_t)(m0 + r) * 16 + F.lane] = F.lane == 0 ? s : 0.f;
        }
    }
}

constexpr int CO_R = 16;
template <int S> struct CoStep {
    static __device__ __forceinline__ void run(f32x2 (&acc)[CO_R], const f32x2 (&w)[CKA], const unsigned (&in)[CO_R + CKA - 1], int t0) {
        const bool ok = t0 - (CKA - 1) + S >= 0;
        f32x2 a; a.x = ok ? bf_lo(in[S]) : 0.f; a.y = ok ? bf_hi(in[S]) : 0.f;
#pragma unroll
        for (int r = 0; r < CO_R; ++r) { const int k = S - r; if (k >= 0 && k < CKA) acc[r] += w[k] * a; }
        CoStep<S + 1>::run(acc, w, in, t0);
    }
};
template <> struct CoStep<CO_R + CKA - 1> { static __device__ __forceinline__ void run(f32x2 (&)[CO_R], const f32x2 (&)[CKA], const unsigned (&)[CO_R + CKA - 1], int) {} };
__device__ __forceinline__ void co_phase(Frame& F, int layer, const float* cwa_, const float* cba_, const float* lng_, const float* lnb_, const float* cwb_, const float* p_) {
    const int grp = F.tid >> 8, wv = (F.tid >> 6) & 3, c0 = wv * 128 + F.lane * 2;
    const float* cwa = cwa_ + (size_t)layer * CKA * DC; const float* cba = cba_ + layer * DC; const float* lng = lng_ + layer * DC; const float* lnb = lnb_ + layer * DC;
    const float* cwb = cwb_ + (size_t)layer * 3 * DSC;
    const GAS unsigned* AGLU = (const GAS unsigned*)(F.ws + WS_AGLU); const GAS unsigned* CVp = (const GAS unsigned*)(F.ws + WS_CV); const GAS unsigned* BSp = (const GAS unsigned*)(F.ws + WS_BS);
    GAS unsigned* A2S = (GAS unsigned*)(F.ws + WS_A2S);
    LAS f32x2* part = (LAS f32x2*)(F.lds + RING_OFF) + grp * (CO_R * 4);
    f32x2 w[CKA];
#pragma unroll
    for (int k = 0; k < CKA; ++k) w[k] = *(const f32x2*)(cwa + k * DC + c0);
    const f32x2 bias = *(const f32x2*)(cba + c0), lg = *(const f32x2*)(lng + c0), lb = *(const f32x2*)(lnb + c0);
    const f32x2 wb0 = *(const f32x2*)(cwb + c0), wb1 = *(const f32x2*)(cwb + DSC + c0), wb2 = *(const f32x2*)(cwb + 2 * DSC + c0);
    constexpr int NITEM = M / CO_R;
    const int ngrp = 2 * F.G;
    for (int it0 = 0; it0 < NITEM; it0 += ngrp) {
        const int it = it0 + F.vcu * 2 + grp; const bool live = it < NITEM;
        const int g0 = (live ? it : 0) * CO_R, t0 = g0 % SEQ;
        f32x2 acc[CO_R];
#pragma unroll
        for (int r = 0; r < CO_R; ++r) acc[r] = bias;
        {
            unsigned in[CO_R + CKA - 1];
#pragma unroll
            for (int s = 0; s < CO_R + CKA - 1; ++s) { const int gr = (t0 - (CKA - 1) + s >= 0) ? g0 - (CKA - 1) + s : g0; in[s] = AGLU[(size_t)gr * (DC / 2) + (c0 >> 1)]; }
            CoStep<0>::run(acc, w, in, t0);
        }
        {
            float vals[2 * CO_R];
#pragma unroll
            for (int r = 0; r < CO_R; ++r) { vals[r] = acc[r].x + acc[r].y; vals[CO_R + r] = acc[r].x * acc[r].x + acc[r].y * acc[r].y; }
#pragma unroll
            for (int half = CO_R, bit = 32; half >= 1; half >>= 1, bit >>= 1) {
                const bool up = (F.lane & bit) != 0;
#pragma unroll
                for (int i = 0; i < half; ++i) { const float send = up ? vals[i] : vals[i + half], keep = up ? vals[i + half] : vals[i]; vals[i] = keep + __shfl_xor(send, bit, 64); }
            }
            const float tot = vals[0] + __shfl_xor(vals[0], 1, 64);
            const int idx = (F.lane >> 1) & 31;
            if ((F.lane & 1) == 0) ((LAS float*)part)[((idx & (CO_R - 1)) * 4 + wv) * 2 + (idx >> 4)] = tot;
        }
        __syncthreads();
#pragma unroll
        for (int r = 0; r < CO_R; ++r) {
            const f32x2 p0 = part[r * 4 + 0], p1 = part[r * 4 + 1], p2 = part[r * 4 + 2], p3 = part[r * 4 + 3];
            const float mean = ((p0.x + p1.x) + (p2.x + p3.x)) * (1.0f / DC), ex2 = ((p0.y + p1.y) + (p2.y + p3.y)) * (1.0f / DC);
            const float var = fmaxf(ex2 - mean * mean, 0.f), rstd = frsq(var + EPS);
            float y0 = (acc[r].x - mean) * rstd * lg.x + lb.x, y1 = (acc[r].y - mean) * rstd * lg.y + lb.y;
            y0 = y0 * sigm(y0); y1 = y1 * sigm(y1);
            if (live) A2S[(size_t)(g0 + r) * (D / 2) + (c0 >> 1)] = pk2(y0, y1);
        }
        {
            unsigned cvr[CO_R + 2], bsr[CO_R];
#pragma unroll
            for (int r = 0; r < CO_R + 2; ++r) { const int gr = (t0 - 2 + r >= 0) ? g0 - 2 + r : g0; cvr[r] = CVp[(size_t)gr * (DSC / 2) + (c0 >> 1)]; }
#pragma unroll
            for (int r = 0; r < CO_R; ++r) bsr[r] = BSp[(size_t)(g0 + r) * (DSC / 2) + (c0 >> 1)];
#pragma unroll
            for (int r = 0; r < CO_R; ++r) {
                const bool ok2 = t0 + r >= 2, ok1 = t0 + r >= 1;
                const f32x2 c2 = {ok2 ? bf_lo(cvr[r]) : 0.f, ok2 ? bf_hi(cvr[r]) : 0.f}, c1 = {ok1 ? bf_lo(cvr[r + 1]) : 0.f, ok1 ? bf_hi(cvr[r + 1]) : 0.f};
                const f32x2 cc = {bf_lo(cvr[r + 2]), bf_hi(cvr[r + 2])}, b = {bf_lo(bsr[r]), bf_hi(bsr[r])};
                const f32x2 o = b * (wb0 * c2 + wb1 * c1 + wb2 * cc);
                if (live) A2S[(size_t)(g0 + r) * (D / 2) + (DC >> 1) + (c0 >> 1)] = pk2(o.x, o.y);
            }
        }
        __syncthreads();
    }    if (layer + 1 < NLAYER) cv_p(F, layer + 1, p_);
}

__device__ __forceinline__ void final_phase(Frame& F, const float* g_final) {
    const int gw = F.vcu * NWAVES + F.wave, NGW = F.G * NWAVES;
    const float* SS = (const float*)(F.ws + ((NLAYER & 1) ? WS_SS1 : WS_SS0));
    const f32x4* gf = (const f32x4*)g_final + F.lane;
    f32x4 gv[4];
#pragma unroll
    for (int j = 0; j < 4; ++j) gv[j] = gf[64 * j];
    for (int m0 = gw * 4; m0 < M; m0 += NGW * 4) {
        u32x2 xv[4][4]; f32x4 sv[4][4];
#pragma unroll
        for (int r = 0; r < 4; ++r)
#pragma unroll
            for (int j = 0; j < 4; ++j) { xv[r][j] = ((const GAS u32x2*)(F.ws + WS_XB2 + (size_t)(m0 + r) * D * 2) + F.lane)[64 * j]; sv[r][j] = ((const f32x4*)(SS + (size_t)(m0 + r) * 16))[j]; }
#pragma unroll
        for (int r = 0; r < 4; ++r) {
            const float s = (hsum4(sv[r][0]) + hsum4(sv[r][1])) + (hsum4(sv[r][2]) + hsum4(sv[r][3])); const float rs = frsq(s * (1.0f / (float)D) + EPS);
            GAS f32x4* orow = (GAS f32x4*)(F.out + (size_t)(m0 + r) * D) + F.lane;
#pragma unroll
            for (int j = 0; j < 4; ++j) orow[64 * j] = unpk4(xv[r][j]) * rs * gv[j];
        }
    }
}

struct Args { const float* in[22]; float* out; unsigned char* ws; int ph_lo, ph_hi, li, pad; };
__global__ void __launch_bounds__(NWAVES * 64, 2) fwd_kernel(Args args) {
    extern __shared__ __attribute__((aligned(16))) unsigned char lds[];
    Frame F;
    F.lds = (LAS unsigned char*)lds;
    F.MISC = (volatile LAS unsigned*)(F.lds + MISC_OFF);
    F.tid = threadIdx.x; F.lane = F.tid & 63; F.wave = __builtin_amdgcn_readfirstlane(F.tid >> 6);
    F.G = gridDim.x; { const int bx = blockIdx.x; F.vcu = (F.G % 8 == 0) ? (bx % 8) * (F.G / 8) + bx / 8 : bx; }
    unsigned char* ws = args.ws; F.ws = ws; F.out = args.out;
    F.ctl = (gu32*)(ws + WS_CTL);
    for (int u = F.tid; u < (LDS_BYTES - LDSCTL_OFF) / 4; u += NWAVES * 64) ((LAS unsigned*)(F.lds + LDSCTL_OFF))[u] = 0u;
    __syncthreads();
    XcdBarrier bar; bar.bar = (unsigned*)(F.ctl + CW_BAR); bar.x = 0; bar.st = nullptr;
    if (!MK_PER_PHASE) bar = xcd_barrier_post((unsigned*)(F.ctl + CW_BAR), F.MISC + 8);

    const int lo = args.ph_lo, hi = args.ph_hi;
#ifndef DUP_MASK
#define DUP_MASK 0u
#endif
    const int qlo = lo + __builtin_popcount((unsigned)DUP_MASK & ((1u << lo) - 1u)), qhi = hi + __builtin_popcount((unsigned)DUP_MASK & ((1u << hi) - 1u));
    for (int q = qlo; q < qhi; ++q) {
        int p = 0; while (p + 1 + __builtin_popcount((unsigned)DUP_MASK & ((1u << (p + 1)) - 1u)) <= q) ++p;
        const int layer = p == 0 ? 0 : (p - 1) / 7, k = p == 0 ? 0 : (p - 1) % 7 + 1;
        { int tv = threadIdx.x; asm volatile("" : "+v"(tv)); F.tid = tv; F.lane = tv & 63; F.wave = __builtin_amdgcn_readfirstlane(tv >> 6); }
        const bf16_t* WB = layer == 0 ? (const bf16_t*)(ws + WS_WB) : (const bf16_t*)((unsigned char*)F.out + OUT_WB1);
        float* SSa = (float*)(ws + ((layer & 1) ? WS_SS1 : WS_SS0));
        float* SSb = (float*)(ws + ((layer & 1) ? WS_SS0 : WS_SS1));
#ifndef PHMASK
#define PHMASK 0x1ff
#endif
        if (p == N_PHASES - 1) { if (PHMASK & 0x100) final_phase(F, args.in[21]); }
        else if (k == 0) { if (PHMASK & 1) { const CvPtrs P{args.in[0], args.in[1], args.in[2], args.in[3], args.in[9], args.in[11], args.in[12], args.in[13], args.in[14], args.in[17], args.in[18], args.in[19], args.in[20]}; cv_phase(F, P); } }
        else if (k == 1) { if (PHMASK & 2) {
#ifndef NO_EG
            {
                Gemm g{(const bf16_t*)(ws + WS_PB), WB + WB_WPL, PLE}; StaticOrder S; S.init(M / BM, D / BM, F.G, (int)blockIdx.x);
                EpiE E{(bf16_t*)(ws + WS_E)};
                gemm_phase<EpiE, StaticOrder, false, true, false>(F.lds + RING_OFF, g, S, E);
            }
#endif
#ifndef NO_IN
            {
                Gemm g{layer == 0 ? (const bf16_t*)(ws + WS_XB) : (const bf16_t*)F.out, WB + WB_WIN, D};   StaticOrder S; S.init(M / BM, NIN / BM, F.G, (int)blockIdx.x);
                EpiIn E{SSa, args.in[4] + (size_t)layer * 2 * D, (bf16_t*)(ws + WS_AGLU), (bf16_t*)(ws + WS_CV), (bf16_t*)(ws + WS_BS), (bf16_t*)(ws + WS_GR), (bf16_t*)(ws + WS_GB)};
                gemm_phase<EpiIn, StaticOrder, true, true, false>(F.lds + RING_OFF, g, S, E);
            }
#endif
        } }
        else if (k == 2) { if (PHMASK & 4) co_phase(F, layer, args.in[5], args.in[6], args.in[7], args.in[8], args.in[10], args.in[1]); }
        else if (k == 3) { if (PHMASK & 8) {
            Gemm g{(const bf16_t*)(ws + WS_A2S), WB + WB_WAB, D}; StaticOrder S; S.init(M / BM, D / BM, F.G, (int)blockIdx.x);
            EpiMerge E{(const bf16_t*)(ws + WS_GR), (const bf16_t*)(ws + WS_GB), (bf16_t*)(ws + WS_MG)};
            gemm_phase<EpiMerge, StaticOrder, false, true, false>(F.lds + RING_OFF, g, S, E);
        } }
        else if (k == 4) { if (PHMASK & 16) {
            Gemm g{(const bf16_t*)(ws + WS_MG), WB + WB_WO, D}; StaticOrder S; S.init(M / BM, D / BM, F.G, (int)blockIdx.x);
            EpiRes<0> E{layer == 0 ? (const bf16_t*)(ws + WS_XB) : (const bf16_t*)F.out, (bf16_t*)(ws + WS_XB), SSb, nullptr, nullptr};
            gemm_phase<EpiRes<0>, StaticOrder, false, true, false>(F.lds + RING_OFF, g, S, E);
        } }
        else if (k == 5) { if (PHMASK & 32) {
            Gemm g{(const bf16_t*)(ws + WS_XB) - 2 * D, WB + WB_WUP, D}; StaticOrder S; S.init(NT_UP, NUP / BM, F.G, (int)blockIdx.x);
            EpiUp E{SSb, args.in[15] + (size_t)layer * 3 * DFF, args.in[16] + (size_t)layer * DFF, (bf16_t*)(ws + WS_F)};
            gemm_phase<EpiUp, StaticOrder, true, true, true>(F.lds + RING_OFF, g, S, E);
        } }
        else if (k == 6) { if (PHMASK & 64) {
            Gemm g{(const bf16_t*)(ws + WS_F), WB + WB_WDN, DFF}; StaticOrder S; S.init(M / BM, D / BM, F.G, (int)blockIdx.x);
            EpiRes<0> E{(const bf16_t*)(ws + WS_XB), (bf16_t*)(ws + WS_XB), SSa, nullptr, nullptr};
            gemm_phase<EpiRes<0>, StaticOrder, false, true, false>(F.lds + RING_OFF, g, S, E);
        } }
        else { if (PHMASK & 128) {
            Gemm g{(const bf16_t*)(ws + WS_XB), WB + WB_WPG, D}; StaticOrder S; S.init(M / BM, D / BM, F.G, (int)blockIdx.x);
            EpiRes<1> E{(const bf16_t*)(ws + WS_XB), layer == NLAYER - 1 ? (bf16_t*)(ws + WS_XB2) : (bf16_t*)F.out, SSb, SSa, (const bf16_t*)(ws + WS_E)};
            gemm_phase<EpiRes<1>, StaticOrder, false, true, false>(F.lds + RING_OFF, g, S, E);
        } }
        if (q + 1 < qhi) xcd_barrier(bar);
    }
}

extern "C" void kernel_launch(void* const* d_in, const int* in_sizes, int n_in, void* d_out, int out_size, void* d_ws, size_t ws_size, hipStream_t stream) {
    static int grid = 0;
    if (grid == 0) {
        if (n_in != 22 || in_sizes[0] != M * D || out_size != M * D || ws_size < WS_END) { fprintf(stderr, "kernel_launch: built for 22 inputs, x and out of %d floats, >= %zu bytes of workspace; got n_in %d, in0 %d, out %d, ws %zu; nothing launched\n", M * D, (size_t)WS_END, n_in, n_in > 0 ? in_sizes[0] : -1, out_size, ws_size); grid = -1; return; }
        int dev = 0, cus = 0, per_cu = 0;
        if (hipGetDevice(&dev) != hipSuccess || hipDeviceGetAttribute(&cus, hipDeviceAttributeMultiprocessorCount, dev) != hipSuccess) { fprintf(stderr, "kernel_launch: hipGetDevice / hipDeviceGetAttribute failed; nothing launched\n"); grid = -1; return; }
        if (hipFuncSetAttribute((const void*)fwd_kernel, hipFuncAttributeMaxDynamicSharedMemorySize, LDS_BYTES) != hipSuccess) { fprintf(stderr, "kernel_launch: hipFuncSetAttribute failed\n"); grid = -1; return; }
        if (hipOccupancyMaxActiveBlocksPerMultiprocessor(&per_cu, (const void*)fwd_kernel, NWAVES * 64, LDS_BYTES) != hipSuccess || per_cu < 1)
            fprintf(stderr, "kernel_launch: note: the occupancy query reports %d workgroups per CU\n", per_cu);
        (void)hipGetLastError();
        grid = cus;
    }
    if (grid < 0) return;
    if (hipMemsetAsync((char*)d_ws + WS_CTL, 0, CTL_ZERO_BYTES, stream) != hipSuccess) { fprintf(stderr, "kernel_launch: hipMemsetAsync of the control words failed; nothing launched\n"); return; }
    Args a{};
    for (int i = 0; i < 22; ++i) a.in[i] = (const float*)d_in[i];
    a.out = (float*)d_out; a.ws = (unsigned char*)d_ws;
    const int nl = MK_PER_PHASE ? N_PHASES : 1;
    for (int li = 0; li < nl; ++li) {
        a.ph_lo = MK_PER_PHASE ? li : 0; a.ph_hi = MK_PER_PHASE ? li + 1 : N_PHASES; a.li = li;
        hipLaunchKernelGGL(fwd_kernel, dim3(grid), dim3(NWAVES * 64), LDS_BYTES, stream, a);
        const hipError_t le = hipPeekAtLastError();
        if (le != hipSuccess) { fprintf(stderr, "kernel_launch: launch %d failed: %s (grid %d x %d threads, %d B LDS)\n", li, hipGetErrorName(le), grid, NWAVES * 64, LDS_BYTES); break; }
    }
}
#endif
```

```cpp
#ifndef EMU
#include <hip/hip_runtime.h>
#include <cstdio>
#include <cstdint>
#define HD __host__ __device__ __forceinline__
#else
#include <cstdio>
#include <cstdint>
#include <cmath>
#include <cstring>
#define HD inline
#endif

#ifndef SEQ_LEN
#define SEQ_LEN 8192
#endif
constexpr int BATCH = 2, SEQ = SEQ_LEN, D = 1024, M = BATCH * SEQ;
constexpr int DC = 512, DSC = 512, NIN = 4608, DFF = 2816, NUP = 2 * DFF, PLE = 256, CKA = 31, NLAYER = 2;
constexpr float EPS = 1e-6f;
constexpr int NQ_UP = (M + 61) / 62;
constexpr int NT_UP = (NQ_UP + 3) / 4;

typedef unsigned short bf16_t;
typedef short bf16x8 __attribute__((ext_vector_type(8)));
typedef float f32x4 __attribute__((ext_vector_type(4)));
typedef float f32x2 __attribute__((ext_vector_type(2)));
typedef unsigned u32x4 __attribute__((ext_vector_type(4)));
typedef unsigned u32x2 __attribute__((ext_vector_type(2)));

HD float bits2f(unsigned u) { return __builtin_bit_cast(float, u); }
HD unsigned f2bits(float f) { return __builtin_bit_cast(unsigned, f); }
HD unsigned f2bf(float f) { unsigned u = f2bits(f); return (u + 0x7fffu + ((u >> 16) & 1u)) >> 16; }
HD unsigned pk2(float lo, float hi) {
#if defined(__HIP_DEVICE_COMPILE__)
    unsigned r; asm volatile("v_cvt_pk_bf16_f32 %0, %1, %2" : "=v"(r) : "v"(lo), "v"(hi)); return r;
#else
    return f2bf(lo) | (f2bf(hi) << 16);
#endif
}
HD float bf_lo(unsigned w) { return bits2f(w << 16); }
HD float bf_hi(unsigned w) { return bits2f(w & 0xffff0000u); }
HD float fexp2(float x) {
#if defined(__HIP_DEVICE_COMPILE__)
    return __builtin_amdgcn_exp2f(x);
#else
    return exp2f(x);
#endif
}
HD float frcp(float x) {
#if defined(__HIP_DEVICE_COMPILE__)
    return __builtin_amdgcn_rcpf(x);
#else
    return 1.0f / x;
#endif
}
HD float frsq(float x) {
#if defined(__HIP_DEVICE_COMPILE__)
    return __builtin_amdgcn_rsqf(x);
#else
    return 1.0f / sqrtf(x);
#endif
}
HD float sigm(float x) { return frcp(1.0f + fexp2(-1.44269504089f * x)); }
HD float gelu_tanh(float x) { const float e = fexp2(x * (-2.3022082f + -0.1029432f * x * x)); return x * frcp(1.0f + e); }
HD f32x4 exp2_4(f32x4 v) { return (f32x4){fexp2(v[0]), fexp2(v[1]), fexp2(v[2]), fexp2(v[3])}; }
HD f32x4 rcp4(f32x4 v) { return (f32x4){frcp(v[0]), frcp(v[1]), frcp(v[2]), frcp(v[3])}; }
HD f32x4 sigm4(f32x4 v) { return rcp4(exp2_4(v * -1.44269504089f) + 1.0f); }
HD f32x4 gelu4(f32x4 x) { const f32x4 e = exp2_4(x * (x * x * -0.1029432f + -2.3022082f)); return x * rcp4(e + 1.0f); }
HD u32x4 pk8(f32x4 a, f32x4 b) { u32x4 w; w.x = pk2(a[0], a[1]); w.y = pk2(a[2], a[3]); w.z = pk2(b[0], b[1]); w.w = pk2(b[2], b[3]); return w; }
HD u32x2 pk4(f32x4 a) { u32x2 w; w.x = pk2(a[0], a[1]); w.y = pk2(a[2], a[3]); return w; }
HD f32x4 unpk_lo(u32x4 w) { return (f32x4){bf_lo(w.x), bf_hi(w.x), bf_lo(w.y), bf_hi(w.y)}; }
HD f32x4 unpk_hi(u32x4 w) { return (f32x4){bf_lo(w.z), bf_hi(w.z), bf_lo(w.w), bf_hi(w.w)}; }
HD f32x4 unpk4(u32x2 w) { return (f32x4){bf_lo(w.x), bf_hi(w.x), bf_lo(w.y), bf_hi(w.y)}; }
#if defined(__HIP_DEVICE_COMPILE__)
#define CFENCE() asm volatile("" ::: "memory")
#define LAUNDER(x) asm volatile("" : "+v"(x))
#else
#define CFENCE() do {} while (0)
#define LAUNDER(x) do {} while (0)
#endif
HD float hsum4(f32x4 a) { return (a[0] + a[1]) + (a[2] + a[3]); }

HD float row_rs(const float* SS, int g) {
    const f32x4* p = (const f32x4*)(SS + (size_t)g * 16);
    const f32x4 a = p[0], b = p[1], c = p[2], d = p[3];
    const float s = (hsum4(a) + hsum4(b)) + (hsum4(c) + hsum4(d));
    return frsq(s * (1.0f / (float)D) + EPS);
}

template <class Sh, class RowFn> HD void load_rs8(float (&rsv)[2][4], const float* SS, int fq, int lane, const Sh& sh, const RowFn& rowfn) {
    f32x4 q[2][4];
#pragma unroll
    for (int ai = 0; ai < 2; ++ai)
#pragma unroll
        for (int m = 0; m < 4; ++m) q[ai][m] = *(const f32x4*)(SS + (size_t)rowfn(ai, m) * 16 + fq * 4);
#pragma unroll
    for (int ai = 0; ai < 2; ++ai)
#pragma unroll
        for (int m = 0; m < 4; ++m) { float s = hsum4(q[ai][m]); s += sh(s, lane ^ 16); s += sh(s, lane ^ 32); rsv[ai][m] = frsq(s * (1.0f / (float)D) + EPS); }
}

HD int win_dst(int s) {
    if (s < 512) return 256 * (s >> 7) + (s & 127);
    if (s < 1024) { const int c = s - 512; return 256 * (c >> 7) + 128 + (c & 127); }
    if (s < 1536) return 2048 + (s - 1024);
    if (s < 2048) { const int c = s - 1536; return 256 * (4 + (c >> 7)) + (c & 127); }
    if (s < 2560) { const int c = s - 2048; return 256 * (4 + (c >> 7)) + 128 + (c & 127); }
    if (s < 3584) { const int c = s - 2560; return 256 * (10 + (c >> 7)) + (c & 127); }
    { const int c = s - 3584; return 256 * (10 + (c >> 7)) + 128 + (c & 127); }
}
HD int wup_dst(int s) { if (s < DFF) return 256 * (s >> 7) + (s & 127); const int c = s - DFF; return 256 * (c >> 7) + 128 + (c & 127); }

#ifndef WGMV
#define WGMV 8
#endif
constexpr int BM = 256, BK = 64, HALF = 128, HTB = HALF * BK * 2  , STAGE_BYTES = 8 * HTB, NXCD = 8, WGM = WGMV;
struct Unit { int pm, pn; };
struct Gemm { const bf16_t* A; const bf16_t* Bt; int K; };
struct StaticOrder {
    int nM, nN, nwg, G, c, revn;
    HD void init(int nM_, int nN_, int G_, int c_, int revn_ = 0) { nM = nM_; nN = nN_; nwg = nM * nN; G = G_; c = c_; revn = revn_; }
    HD bool next(int i, Unit& u) const {
        const long L = (long)i * G + c; if (L >= nwg) return false;
        int wgid = (int)L; { const int q = nwg / NXCD, r = nwg % NXCD, xcd = wgid % NXCD, off = wgid / NXCD; wgid = (xcd < r ? xcd * (q + 1) : r * (q + 1) + (xcd - r) * q) + off; }
        const int nig = WGM * nN, gid = wgid / nig, fm = gid * WGM, gsz = (nM - fm) < WGM ? (nM - fm) : WGM;
        u.pm = fm + ((wgid % nig) % gsz); u.pn = (wgid % nig) / gsz; if (revn) u.pn = nN - 1 - u.pn; return true;
    }
    HD void a_ready(const Unit&) const {}
    HD void done(const Unit&) const {}
};

struct EgOrder {
    int G, c;
    HD bool next(int i, Unit& u) const {
        int L;
        if (G == 256) { if (c < 128 || i >= 2) return false; L = (c - 128) * 2 + i; }
        else { L = i * G + c; if (L >= 256) return false; }
        u.pm = L >> 2; u.pn = L & 3; return true;
    }
    HD void a_ready(const Unit&) const {}
    HD void done(const Unit&) const {}
};

typedef f32x4 Acc[2][2][4][2];
#ifdef EMU
typedef const float* rsl_t;
#define LDS4(p) (*(const f32x4*)(p))
#else
typedef const __attribute__((address_space(3))) float* rsl_t;
#define LDS4(p) (*(const __attribute__((address_space(3))) f32x4*)(p))
#endif
#ifndef RS_IN
#define RS_IN 1
#endif
#ifndef RS_UP
#define RS_UP 1
#endif
constexpr int RSBUF_OFF = 131072 + 1024, RSRAW_OFF = 131072 + 4096, CSTBUF_OFF = 131072 + 20480;

struct EpiE {
    static constexpr int EPI_ID = 1; static constexpr bool HAS_RS = false;
    HD int cst_n(const Unit&) const { return 0; }
    HD const float* cst_src(const Unit&, int) const { return nullptr; }
    static constexpr bool PERM = true, AFTER_DRAIN = false, HAS_MID = false, HAS_INIT = false; static constexpr int MID_T = -1;
    bf16_t* E;
    template <class Sh> HD void operator()(const Acc& acc, const Unit& u, int wr, int wc, int fr, int fq, const Sh&, rsl_t, rsl_t) const {
        const int cb = u.pn * 256 + wc * 32 + 8 * fq;
#pragma unroll
        for (int ai = 0; ai < 2; ++ai)
#pragma unroll
            for (int m = 0; m < 4; ++m) { const int g = u.pm * 256 + ai * 128 + wr * 64 + m * 16 + fr; bf16_t* rowp = E + (size_t)g * D + cb;
#pragma unroll
                for (int bj = 0; bj < 2; ++bj) *(u32x4*)(rowp + bj * 128) = pk8(acc[ai][bj][m][0], acc[ai][bj][m][1]); }
    }
    template <class Sh> HD void mid(Acc&, const Unit&, int, int, int, int, const Sh&) const {}
};

struct EpiIn {
    static constexpr int EPI_ID = 2; static constexpr bool HAS_RS = RS_IN;
    HD const float* rs_src() const { return SS; }
    HD int rs_row(const Unit& u, int R) const { return u.pm * 256 + R; }
    HD int cst_n(const Unit& u) const { return u.pn >= 10 ? 64 : 0; }
    HD const float* cst_src(const Unit& u, int i) const { return bgate + (i >> 5) * D + (u.pn - 10) * 128 + 4 * (i & 31); }
    static constexpr bool PERM = true, AFTER_DRAIN = false, HAS_MID = false, HAS_INIT = false; static constexpr int MID_T = -1;
    const float* SS; const float* bgate; bf16_t *AGLU, *CV, *BS, *GR, *GB;
    template <class Sh> HD void operator()(const Acc& acc, const Unit& u, int wr, int wc, int fr, int fq, const Sh& sh, rsl_t rsl, rsl_t cst) const {
        const int cb = wc * 32 + 8 * fq;
        const int pn = u.pn, grow = u.pm * 256 + wr * 64 + fr, lane = fq * 16 + fr;
        float rsv[2][4];
        if constexpr (HAS_RS) { _Pragma("unroll") for (int ai = 0; ai < 2; ++ai) _Pragma("unroll") for (int m = 0; m < 4; ++m) rsv[ai][m] = rsl[128 * ai + 64 * wr + 16 * m + fr]; }
        else load_rs8(rsv, SS, fq, lane, sh, [&](int ai, int m) { return grow + ai * 128 + m * 16; });
        if (pn < 4) {
#pragma unroll
            for (int ai = 0; ai < 2; ++ai)
#pragma unroll
                for (int m = 0; m < 4; ++m) { const int g = grow + ai * 128 + m * 16; const float rs = rsv[ai][m];
                    *(u32x4*)(AGLU + (size_t)g * DC + pn * 128 + cb) = pk8((acc[ai][0][m][0] * rs) * sigm4(acc[ai][1][m][0] * rs), (acc[ai][0][m][1] * rs) * sigm4(acc[ai][1][m][1] * rs)); }
        } else if (pn < 8) {
#pragma unroll
            for (int ai = 0; ai < 2; ++ai)
#pragma unroll
                for (int m = 0; m < 4; ++m) { const int g = grow + ai * 128 + m * 16; const float r2 = rsv[ai][m] * rsv[ai][m];
                    *(u32x4*)(CV + (size_t)g * DSC + (pn - 4) * 128 + cb) = pk8(acc[ai][0][m][0] * acc[ai][1][m][0] * r2, acc[ai][0][m][1] * acc[ai][1][m][1] * r2); }
        } else if (pn < 10) {
#pragma unroll
            for (int ai = 0; ai < 2; ++ai)
#pragma unroll
                for (int m = 0; m < 4; ++m) { const int g = grow + ai * 128 + m * 16; const float rs = rsv[ai][m];
                    bf16_t* rowp = BS + (size_t)g * DSC + (pn - 8) * 256 + cb;
                    *(u32x4*)rowp = pk8(acc[ai][0][m][0] * rs, acc[ai][0][m][1] * rs); *(u32x4*)(rowp + 128) = pk8(acc[ai][1][m][0] * rs, acc[ai][1][m][1] * rs); }
        } else {
            const int t = pn - 10; const rsl_t pa = cst + cb, pb = cst + 128 + cb;
            constexpr float NL2E = -1.44269504089f;
            const f32x4 ba0 = LDS4(pa) * NL2E, ba1 = LDS4(pa + 4) * NL2E, bb0 = LDS4(pb) * NL2E, bb1 = LDS4(pb + 4) * NL2E;
#pragma unroll
            for (int ai = 0; ai < 2; ++ai)
#pragma unroll
                for (int m = 0; m < 4; ++m) { const int g = grow + ai * 128 + m * 16; const float rs = rsv[ai][m] * NL2E;
                    const size_t o = (size_t)g * D + t * 128 + cb;
                    const f32x4 da0 = exp2_4(acc[ai][0][m][0] * rs + ba0) + 1.0f, da1 = exp2_4(acc[ai][0][m][1] * rs + ba1) + 1.0f, db0 = exp2_4(acc[ai][1][m][0] * rs + bb0) + 1.0f, db1 = exp2_4(acc[ai][1][m][1] * rs + bb1) + 1.0f;
                    const f32x4 q0 = rcp4(da0 * db0), q1 = rcp4(da1 * db1);
                    const f32x4 g0 = q0 * da0, g1 = q1 * da1, r0 = q0 * db0 * db0, r1 = q1 * db1 * db1;
                    *(u32x4*)(GR + o) = pk8(r0, r1); *(u32x4*)(GB + o) = pk8(g0, g1); }
        }
    }
    template <class Sh> HD void mid(Acc&, const Unit&, int, int, int, int, const Sh&) const {}
};

struct EpiMerge {
    static constexpr int EPI_ID = 3; static constexpr bool HAS_RS = false;
    HD int cst_n(const Unit&) const { return 0; }
    HD const float* cst_src(const Unit&, int) const { return nullptr; }
    static constexpr bool PERM = true, AFTER_DRAIN = false, HAS_MID = true, HAS_INIT = false; static constexpr int MID_T = 8;
    const bf16_t *GR, *GB; bf16_t* MG;
    template <class Sh> HD void mid(Acc& acc, const Unit& u, int wr, int wc, int fr, int fq, const Sh&) const {
        LAUNDER(fr); LAUNDER(fq);
        const int cb = u.pn * 256 + wc * 32 + 8 * fq, grow = u.pm * 256 + wr * 64 + fr;
#pragma unroll
        for (int ai = 0; ai < 2; ++ai) {
            u32x4 w[4][2];
#pragma unroll
            for (int m = 0; m < 4; ++m)
#pragma unroll
                for (int bj = 0; bj < 2; ++bj) w[m][bj] = *(const u32x4*)(GR + (size_t)(grow + ai * 128 + m * 16) * D + cb + bj * 128);
#pragma unroll
            for (int m = 0; m < 4; ++m)
#pragma unroll
                for (int bj = 0; bj < 2; ++bj) { acc[ai][bj][m][0] *= unpk_lo(w[m][bj]); acc[ai][bj][m][1] *= unpk_hi(w[m][bj]); }
            CFENCE();
        }
    }
    template <class Sh> HD void operator()(const Acc& acc, const Unit& u, int wr, int wc, int fr, int fq, const Sh&, rsl_t, rsl_t) const {
        const int cb = u.pn * 256 + wc * 32 + 8 * fq, grow = u.pm * 256 + wr * 64 + fr;
#pragma unroll
        for (int ai = 0; ai < 2; ++ai) {
            u32x4 w[4][2];
#pragma unroll
            for (int m = 0; m < 4; ++m)
#pragma unroll
                for (int bj = 0; bj < 2; ++bj) w[m][bj] = *(const u32x4*)(GB + (size_t)(grow + ai * 128 + m * 16) * D + cb + bj * 128);
#pragma unroll
            for (int m = 0; m < 4; ++m)
#pragma unroll
                for (int bj = 0; bj < 2; ++bj) *(u32x4*)(MG + (size_t)(grow + ai * 128 + m * 16) * D + cb + bj * 128) = pk8(acc[ai][bj][m][0] * unpk_lo(w[m][bj]), acc[ai][bj][m][1] * unpk_hi(w[m][bj]));
            CFENCE();
        }
    }
};

#ifndef RES_INIT
#define RES_INIT 1
#endif
template <int MODE> struct EpiRes {
    static constexpr int EPI_ID = 6 + MODE; static constexpr bool HAS_RS = false;
    HD int cst_n(const Unit&) const { return 0; }
    HD const float* cst_src(const Unit&, int) const { return nullptr; }
    static constexpr bool PERM = true, AFTER_DRAIN = false, HAS_MID = false, HAS_INIT = (MODE == 0 && RES_INIT); static constexpr int MID_T = -1;
    const bf16_t* xin; bf16_t* xout; float* ssout; const float* ssin; const bf16_t* E; int nostore;
    HD void init(Acc& acc, const Unit& u, int wr, int wc, int fr, int fq) const {
        const int cb = u.pn * 256 + wc * 32 + 8 * fq, grow = u.pm * 256 + wr * 64 + fr;
#pragma unroll
        for (int ai = 0; ai < 2; ++ai)
#pragma unroll
            for (int m = 0; m < 4; ++m)
#pragma unroll
                for (int bj = 0; bj < 2; ++bj) { const u32x4 w = *(const u32x4*)(xin + (size_t)(grow + ai * 128 + m * 16) * D + cb + bj * 128); acc[ai][bj][m][0] = unpk_lo(w); acc[ai][bj][m][1] = unpk_hi(w); }
    }
    template <class Sh> HD void operator()(const Acc& acc, const Unit& u, int wr, int wc, int fr, int fq, const Sh& sh, rsl_t, rsl_t) const {
        const int cb = u.pn * 256 + wc * 32 + 8 * fq; const int lane = fq * 16 + fr, grow = u.pm * 256 + wr * 64 + fr;
#if defined(__HIP_DEVICE_COMPILE__)
        if (nostore) {
#pragma unroll
            for (int ai = 0; ai < 2; ++ai)
#pragma unroll
                for (int bj = 0; bj < 2; ++bj)
#pragma unroll
                    for (int m = 0; m < 4; ++m) { asm volatile("" :: "v"(acc[ai][bj][m][0]), "v"(acc[ai][bj][m][1])); }
            return;
        }
#endif
        float rsv[2][4];
        if (MODE == 1) load_rs8(rsv, ssin, fq, lane, sh, [&](int ai, int m) { return grow + ai * 128 + m * 16; });
        constexpr int MB = MODE == 1 ? 2 : 4;
#pragma unroll
        for (int ai = 0; ai < 2; ++ai)
#pragma unroll
        for (int mh = 0; mh < 4; mh += MB) {
            u32x4 xi[MB][2], ev[MB][2];
#pragma unroll
            for (int mm = 0; mm < MB; ++mm)
#pragma unroll
                for (int bj = 0; bj < 2; ++bj) { const size_t o = (size_t)(grow + ai * 128 + (mh + mm) * 16) * D + cb + bj * 128; if (!HAS_INIT) xi[mm][bj] = *(const u32x4*)(xin + o); if (MODE == 1) ev[mm][bj] = *(const u32x4*)(E + o); }
#pragma unroll
            for (int mm = 0; mm < MB; ++mm) {
                const int m = mh + mm, g = grow + ai * 128 + m * 16; float sq = 0.f;
#pragma unroll
                for (int bj = 0; bj < 2; ++bj) { const size_t o = (size_t)g * D + cb + bj * 128;
                    f32x4 v0 = acc[ai][bj][m][0], v1 = acc[ai][bj][m][1];
                    if (MODE == 1) { const float rs = rsv[ai][m]; v0 = sigm4(v0 * rs) * unpk_lo(ev[mm][bj]); v1 = sigm4(v1 * rs) * unpk_hi(ev[mm][bj]); }
                    const f32x4 x0 = HAS_INIT ? v0 : unpk_lo(xi[mm][bj]) + v0, x1 = HAS_INIT ? v1 : unpk_hi(xi[mm][bj]) + v1;
                    *(u32x4*)(xout + o) = pk8(x0, x1);
                    sq += ((x0[0] * x0[0] + x0[1] * x0[1]) + (x0[2] * x0[2] + x0[3] * x0[3])) + ((x1[0] * x1[0] + x1[1] * x1[1]) + (x1[2] * x1[2] + x1[3] * x1[3])); }
                sq += sh(sq, lane ^ 16); sq += sh(sq, lane ^ 32);
                if (fq == 0) ssout[(size_t)g * 16 + u.pn * 4 + wc] = sq;
            }
            CFENCE();
        }
    }
    template <class Sh> HD void mid(Acc&, const Unit&, int, int, int, int, const Sh&) const {}
};

template <bool V> struct BoolC { static constexpr bool value = V; };
struct EpiUp {
    static constexpr int EPI_ID = 5; static constexpr bool HAS_RS = RS_UP;
    HD const float* rs_src() const { return SS; }
    HD int rs_row(const Unit& u, int R) const { const int g = 62 * (4 * u.pm + (R >> 6)) - 2 + (R & 63); return g < 0 ? 0 : (g > M - 1 ? M - 1 : g); }
    HD int cst_n(const Unit&) const { return 128; }
    HD const float* cst_src(const Unit& u, int i) const { return ((i >> 5) < 3 ? cw + (i >> 5) * DFF : cb_) + u.pn * 128 + 4 * (i & 31); }
    static constexpr bool PERM = true, AFTER_DRAIN = false, HAS_MID = false, HAS_INIT = false; static constexpr int MID_T = -1;
    const float* SS; const float* cw; const float* cb_; bf16_t* F;
    template <class Sh> HD void operator()(const Acc& acc, const Unit& u, int wr, int wc, int fr, int fq, const Sh& sh, rsl_t rsl, rsl_t cst) const {
        const int ch = u.pn * 128 + wc * 32 + 8 * fq;
        const int lane = fq * 16 + fr;
        float rsv[2][4];
        if constexpr (HAS_RS) { _Pragma("unroll") for (int ai = 0; ai < 2; ++ai) _Pragma("unroll") for (int m = 0; m < 4; ++m) rsv[ai][m] = rsl[128 * ai + 64 * wr + 16 * m + fr]; }
        else load_rs8(rsv, SS, fq, lane, sh, [&](int ai, int m) { const int g = 62 * (4 * u.pm + 2 * ai + wr) - 2 + m * 16 + fr; return g < 0 ? 0 : (g > M - 1 ? M - 1 : g); });
        const rsl_t cp = cst + wc * 32 + 8 * fq;
        const f32x4 w0a = LDS4(cp), w0b = LDS4(cp + 4), w1a = LDS4(cp + 128), w1b = LDS4(cp + 132), w2a = LDS4(cp + 256), w2b = LDS4(cp + 260), bia = LDS4(cp + 384), bib = LDS4(cp + 388);
        auto chunk = [&](auto gen_tag, int ai) {
            constexpr bool GEN = decltype(gen_tag)::value;
            const int q = 4 * u.pm + 2 * ai + wr;
            f32x4 pa = {0.f, 0.f, 0.f, 0.f}, pb = pa;
#pragma unroll
            for (int m = 0; m < 4; ++m) {
                const int rho = m * 16 + fr, g = 62 * q - 2 + rho; const int gc = g < 0 ? 0 : (g > M - 1 ? M - 1 : g);
                const float rs = rsv[ai][m];
                const f32x4 ga = acc[ai][0][m][0] * rs, gb = acc[ai][0][m][1] * rs, va = acc[ai][1][m][0] * rs, vb = acc[ai][1][m][1] * rs;
                f32x4 t1a, t1b, t2a, t2b;
#pragma unroll
                for (int j = 0; j < 4; ++j) {
                    t1a[j] = sh.ror1(fr == 15 ? pa[j] : ga[j]); t1b[j] = sh.ror1(fr == 15 ? pb[j] : gb[j]);
                    t2a[j] = sh.ror2(fr >= 14 ? pa[j] : ga[j]); t2b[j] = sh.ror2(fr >= 14 ? pb[j] : gb[j]);
                }
                pa = ga; pb = gb;
                if (GEN) {
                    const int t = gc % SEQ;
                    if (sh.any(t < 2)) {
                        if (t < 1) { t1a = (f32x4){0.f, 0.f, 0.f, 0.f}; t1b = t1a; }
                        if (t < 2) { t2a = (f32x4){0.f, 0.f, 0.f, 0.f}; t2b = t2a; }
                    }
                }
                const f32x4 fa = w2a * ga + w1a * t1a + w0a * t2a + bia, fb = w2b * gb + w1b * t1b + w0b * t2b + bib;
                const f32x4 oa = gelu4(fa) * va, ob = gelu4(fb) * vb;
                if (GEN ? (rho >= 2 && g < M) : (m > 0 || fr >= 2)) *(u32x4*)(F + (size_t)g * DFF + ch) = pk8(oa, ob);
            }
        };
#pragma unroll
        for (int ai = 0; ai < 2; ++ai) {
            const int q = 4 * u.pm + 2 * ai + wr, a = 62 * q - 2, b = a + 63, s0 = (b / SEQ) * SEQ;
            if (sh.any(a <= 0 || s0 + 1 >= a || b >= M)) chunk(BoolC<true>{}, ai); else chunk(BoolC<false>{}, ai);
        }
    }
    template <class Sh> HD void mid(Acc&, const Unit&, int, int, int, int, const Sh&) const {}
};

#ifndef EMU
#define PG8_LAS __attribute__((address_space(3)))
#define GAS __attribute__((address_space(1)))
#define LAS __attribute__((address_space(3)))
typedef GAS unsigned gu32;
#define RLX_AGENT __ATOMIC_RELAXED, __HIP_MEMORY_SCOPE_AGENT
#define LDS_WAIT() asm volatile("s_waitcnt lgkmcnt(0)" ::: "memory")
#define VM_WAIT() asm volatile("s_waitcnt vmcnt(0)" ::: "memory")
#ifndef ROR_DPP
#define ROR_DPP 1
#endif
struct ShflDev {
    __device__ __forceinline__ float operator()(float v, int src) const { return __shfl(v, src, 64); }
    __device__ __forceinline__ bool any(bool p) const { return __any(p) != 0; }
#if ROR_DPP
    __device__ __forceinline__ float ror1(float v) const { return __builtin_bit_cast(float, __builtin_amdgcn_update_dpp(0, __builtin_bit_cast(int, v), 0x121, 0xf, 0xf, true)); }
    __device__ __forceinline__ float ror2(float v) const { return __builtin_bit_cast(float, __builtin_amdgcn_update_dpp(0, __builtin_bit_cast(int, v), 0x122, 0xf, 0xf, true)); }
#else
    __device__ __forceinline__ float ror1(float v) const { const int l = threadIdx.x & 63; return __shfl(v, (l & 48) | ((l + 15) & 15), 64); }
    __device__ __forceinline__ float ror2(float v) const { const int l = threadIdx.x & 63; return __shfl(v, (l & 48) | ((l + 14) & 15), 64); }
#endif
};

__host__ __device__ __forceinline__ int lds_byte(int r, int c) { const int st = (r >> 4) * 2 + (c >> 5), rr = r & 15, cc = c & 31, ob = rr * 64 + cc * 2; return st * 1024 + (ob ^ (((ob >> 9) & 1) << 5)); }
__host__ __device__ __forceinline__ void stage_rc(int b, int& R, int& C) { const int st = b / 1024, sb = b % 1024, swz = sb ^ (((sb >> 9) & 1) << 5); R = (st >> 1) * 16 + swz / 64; C = (st & 1) * 32 + (swz % 64) / 2; }
__host__ __device__ __forceinline__ int perm32(int rho) { const int n = rho >> 4, i = rho & 15; return 8 * (i >> 2) + 4 * n + (i & 3); }

template <class Epi, class Sched, bool ALIGN_EPI = false, bool SP2 = false, bool ACHUNK = false>
__device__ __forceinline__ void gemm_phase(PG8_LAS unsigned char* lds, const Gemm g, const Sched& S, const Epi& E) {
    int tid_ = threadIdx.x; asm volatile("" : "+v"(tid_));
    const int tid = tid_, wid = __builtin_amdgcn_readfirstlane(tid >> 6), lane = tid & 63, wr = wid >> 2, wc = wid & 3, fr = lane & 15, fq = lane >> 4;
    int K_ = g.K; asm volatile("" : "+s"(K_));
    const int K = K_, nt = K / BK;
    unsigned voffA[2], voffB[2];
#pragma unroll
    for (int i = 0; i < 2; ++i) { int R, C; stage_rc(tid * 16 + i * 8192, R, C); const int Rb = Epi::PERM ? ((R & ~31) + perm32(R & 31)) : R;
        const int Ra = ACHUNK ? ((R >> 6) * 62 + (R & 63)) : R; voffA[i] = (unsigned)(Ra * K + C) * 2u; voffB[i] = (unsigned)(Rb * K + C) * 2u; }
    const size_t kstep = (size_t)(BK * 2);
    const size_t hstepB = (size_t)HALF * K * 2, hstepA = ACHUNK ? (size_t)124 * K * 2 : hstepB;
    const size_t tstepA = 2 * hstepA, tstepB = 2 * hstepB;
    const unsigned ldsw = (unsigned)wid * 1024u;
    const int aoff = lds_byte(wr * 64 + fr, fq * 8), boff = lds_byte(wc * 32 + fr, fq * 8);
#define PG8_SA(b, h) (((b) * 2 + (h)) * HTB)
#define PG8_SB(b, h) ((4 + (b) * 2 + (h)) * HTB)
#define PG8_STAGE(bufoff, gbase, voff) do { _Pragma("unroll") for (int _i = 0; _i < 2; ++_i) \
        __builtin_amdgcn_global_load_lds((const unsigned*)((const char*)(gbase) + (voff)[_i]), (PG8_LAS unsigned*)(lds + (bufoff) + ldsw + _i * 8192), 16, 0, 0); } while (0)
#define PG8_LDA(dst, b, h) do { _Pragma("unroll") for (int m = 0; m < 4; ++m) _Pragma("unroll") for (int k = 0; k < 2; ++k) dst[m][k] = *(const PG8_LAS bf16x8*)(lds + PG8_SA(b, h) + aoff + m * 2048 + k * 1024); } while (0)
#define PG8_LDB(dst, b, h) do { _Pragma("unroll") for (int n = 0; n < 2; ++n) _Pragma("unroll") for (int k = 0; k < 2; ++k) dst[n][k] = *(const PG8_LAS bf16x8*)(lds + PG8_SB(b, h) + boff + n * 2048 + k * 1024); } while (0)
#define PG8_MMA(ai, bj, At, Bt) do { __builtin_amdgcn_s_setprio(1); _Pragma("unroll") for (int m = 0; m < 4; ++m) _Pragma("unroll") for (int n = 0; n < 2; ++n) _Pragma("unroll") for (int k = 0; k < 2; ++k) \
        acc[ai][bj][m][n] = __builtin_amdgcn_mfma_f32_16x16x32_bf16(Bt[n][k], At[m][k], acc[ai][bj][m][n], 0, 0, 0); __builtin_amdgcn_s_setprio(0); } while (0)
#define PG8_WAIT_V(n) asm volatile("s_waitcnt vmcnt(" #n ")" ::: "memory")
#define PG8_WAIT_L(n) asm volatile("s_waitcnt lgkmcnt(" #n ")" ::: "memory")
#define PG8_BAR __builtin_amdgcn_s_barrier()
#define PG8_SCHED __builtin_amdgcn_sched_barrier(0)
    Unit cur, nxt; int ui = 0;
    if (!S.next(0, cur)) return;
    f32x4 acc[2][2][4][2];
    if constexpr (Epi::HAS_INIT) E.init(acc, cur, wr, wc, fr, fq);
    else {
#pragma unroll
    for (int a = 0; a < 2; ++a)
#pragma unroll
        for (int b = 0; b < 2; ++b)
#pragma unroll
            for (int m = 0; m < 4; ++m)
#pragma unroll
                for (int n = 0; n < 2; ++n) acc[a][b][m][n] = (f32x4){0.f, 0.f, 0.f, 0.f};
    }
    PG8_LAS float* const rsbuf = (PG8_LAS float*)(lds + RSBUF_OFF);
    float rfence = 0.f;
#define PG8_RS_ISSUE(un, cb_) do { int t_ = tid; asm volatile("" : "+v"(t_));   \
        const float* p_ = E.rs_src() + (size_t)E.rs_row(un, t_ >> 1) * 16 + (t_ & 1) * 8; \
        __builtin_amdgcn_global_load_lds((const unsigned*)p_, (PG8_LAS unsigned*)(lds + RSRAW_OFF + wid * 2048), 16, 0, 0); \
        __builtin_amdgcn_global_load_lds((const unsigned*)(p_ + 4), (PG8_LAS unsigned*)(lds + RSRAW_OFF + wid * 2048 + 1024), 16, 0, 0); \
        { const int nc_ = E.cst_n(un); if (t_ < nc_) __builtin_amdgcn_global_load_lds((const unsigned*)E.cst_src(un, t_), (PG8_LAS unsigned*)(lds + CSTBUF_OFF + (cb_) * 2048 + wid * 1024), 16, 0, 0); } \
        asm volatile("" ::: "memory"); rfence = *(const GAS float*)p_; asm volatile("" ::: "memory"); } while (0)
#define PG8_RS_COMMIT(buf) do { asm volatile("" :: "v"(rfence)); int t_ = tid; asm volatile("" : "+v"(t_)); const int lane_ = t_ & 63; \
        const f32x4 a_ = *(const PG8_LAS f32x4*)(lds + RSRAW_OFF + wid * 2048 + lane_ * 16), b_ = *(const PG8_LAS f32x4*)(lds + RSRAW_OFF + wid * 2048 + 1024 + lane_ * 16); \
        float s_ = hsum4(a_) + hsum4(b_); s_ += __shfl_xor(s_, 1, 64); if (!(t_ & 1)) rsbuf[(buf) * 256 + (t_ >> 1)] = frsq(s_ * (1.0f / (float)D) + EPS); } while (0)
    if constexpr (Epi::HAS_RS) PG8_RS_ISSUE(cur, 0);
    bf16x8 At[4][2], B0[2][2], B1[2][2];
    const char* cA = (const char*)g.A + (size_t)cur.pm * tstepA; const char* cB = (const char*)g.Bt + (size_t)cur.pn * tstepB;
    S.a_ready(cur);
    if constexpr (SP2) {
        PG8_STAGE(PG8_SB(0, 0), cB, voffB); PG8_STAGE(PG8_SB(0, 1), cB + hstepB, voffB); PG8_STAGE(PG8_SA(0, 0), cA, voffA); PG8_STAGE(PG8_SA(0, 1), cA + hstepA, voffA);
        if (wr == 1) PG8_BAR;
        PG8_WAIT_V(2); PG8_BAR;
        PG8_STAGE(PG8_SB(1, 0), cB + kstep, voffB); PG8_STAGE(PG8_SA(1, 0), cA + kstep, voffA); PG8_STAGE(PG8_SB(1, 1), cB + hstepB + kstep, voffB);
        PG8_WAIT_V(6); PG8_BAR;
    } else {
        PG8_STAGE(PG8_SB(0, 0), cB, voffB); PG8_STAGE(PG8_SA(0, 0), cA, voffA); PG8_STAGE(PG8_SB(0, 1), cB + hstepB, voffB); PG8_STAGE(PG8_SA(0, 1), cA + hstepA, voffA);
        if (wr == 1) PG8_BAR;
        PG8_WAIT_V(4); PG8_BAR;
        PG8_STAGE(PG8_SB(1, 0), cB + kstep, voffB); PG8_STAGE(PG8_SA(1, 0), cA + kstep, voffA); PG8_STAGE(PG8_SB(1, 1), cB + hstepB + kstep, voffB);
        PG8_WAIT_V(6); PG8_BAR;
    }
    if constexpr (Epi::HAS_RS) PG8_RS_COMMIT(0);
    for (;;) {
        const bool has_next = S.next(ui + 1, nxt);
        const char* nA = has_next ? (const char*)g.A + (size_t)nxt.pm * tstepA : cA; const char* nB = has_next ? (const char*)g.Bt + (size_t)nxt.pn * tstepB : cB;
        for (int t = 0; t < nt; t += 2) {
            const bool last = (t == nt - 2);
            if constexpr (Epi::HAS_MID) { if (t == Epi::MID_T) E.mid(acc, cur, wr, wc, fr, fq, ShflDev{}); }
            const char* a1 = cA + (size_t)(t + 1) * kstep;
            const char* a2 = last ? nA : cA + (size_t)(t + 2) * kstep; const char* b2 = last ? nB : cB + (size_t)(t + 2) * kstep;
            const char* a3 = a2 + kstep; const char* b3 = b2 + kstep;
            if (last && has_next) S.a_ready(nxt);
            if constexpr (SP2) {
            PG8_LDB(B0, 0, 0); PG8_LDB(B1, 0, 1); PG8_SCHED; PG8_LDA(At, 0, 0); PG8_STAGE(PG8_SA(1, 1), a1 + hstepA, voffA);
            PG8_WAIT_V(8); PG8_WAIT_L(0); PG8_BAR; PG8_MMA(0, 0, At, B0); PG8_MMA(0, 1, At, B1); PG8_BAR; PG8_SCHED;
            PG8_LDA(At, 0, 1); PG8_STAGE(PG8_SB(0, 0), b2, voffB); PG8_STAGE(PG8_SB(0, 1), b2 + hstepB, voffB); PG8_STAGE(PG8_SA(0, 0), a2, voffA);
            PG8_WAIT_V(8); PG8_WAIT_L(0); PG8_BAR; PG8_MMA(1, 0, At, B0); PG8_MMA(1, 1, At, B1); PG8_BAR; PG8_SCHED;
            PG8_LDB(B0, 1, 0); PG8_LDB(B1, 1, 1); PG8_SCHED; PG8_LDA(At, 1, 0); PG8_STAGE(PG8_SA(0, 1), a2 + hstepA, voffA);
            PG8_WAIT_V(8); PG8_WAIT_L(0); PG8_BAR; PG8_MMA(0, 0, At, B0); PG8_MMA(0, 1, At, B1); PG8_BAR; PG8_SCHED;
            PG8_LDA(At, 1, 1); PG8_STAGE(PG8_SB(1, 0), b3, voffB); PG8_STAGE(PG8_SB(1, 1), b3 + hstepB, voffB); PG8_STAGE(PG8_SA(1, 0), a3, voffA);
            PG8_WAIT_V(8); PG8_WAIT_L(0); PG8_BAR; PG8_MMA(1, 0, At, B0); PG8_MMA(1, 1, At, B1); PG8_BAR; PG8_SCHED;
            } else {
            PG8_LDB(B0, 0, 0); PG8_SCHED; PG8_LDA(At, 0, 0); PG8_STAGE(PG8_SA(1, 1), a1 + hstepA, voffA);
            PG8_WAIT_L(8); PG8_BAR; PG8_WAIT_L(0); PG8_MMA(0, 0, At, B0); PG8_BAR; PG8_SCHED;
            PG8_LDB(B1, 0, 1); PG8_STAGE(PG8_SB(0, 0), b2, voffB);
            PG8_BAR; PG8_WAIT_L(0); PG8_MMA(0, 1, At, B1); PG8_BAR;
            PG8_LDA(At, 0, 1); PG8_STAGE(PG8_SA(0, 0), a2, voffA);
            PG8_BAR; PG8_WAIT_L(0); PG8_MMA(1, 0, At, B0); PG8_BAR; PG8_SCHED;
            PG8_STAGE(PG8_SB(0, 1), b2 + hstepB, voffB);
            PG8_WAIT_V(6); PG8_BAR; PG8_MMA(1, 1, At, B1); PG8_BAR;
            PG8_LDB(B0, 1, 0); PG8_SCHED; PG8_LDA(At, 1, 0); PG8_STAGE(PG8_SA(0, 1), a2 + hstepA, voffA);
            PG8_WAIT_L(8); PG8_BAR; PG8_WAIT_L(0); PG8_MMA(0, 0, At, B0); PG8_BAR; PG8_SCHED;
            PG8_LDB(B1, 1, 1); PG8_STAGE(PG8_SB(1, 0), b3, voffB);
            PG8_BAR; PG8_WAIT_L(0); PG8_MMA(0, 1, At, B1); PG8_BAR;
            PG8_LDA(At, 1, 1); PG8_STAGE(PG8_SA(1, 0), a3, voffA);
            PG8_BAR; PG8_WAIT_L(0); PG8_MMA(1, 0, At, B0); PG8_BAR; PG8_SCHED;
            PG8_STAGE(PG8_SB(1, 1), b3 + hstepB, voffB);
            PG8_WAIT_V(6); PG8_BAR; PG8_MMA(1, 1, At, B1); PG8_BAR;
            }
        }
        if constexpr (ALIGN_EPI) { if (wr == 0) PG8_BAR; }
        if constexpr (Epi::HAS_RS) { if (has_next) PG8_RS_ISSUE(nxt, (ui + 1) & 1); }
        if constexpr (!Epi::AFTER_DRAIN) { E(acc, cur, wr, wc, fr, fq, ShflDev{}, rsbuf + (ui & 1) * 256, (PG8_LAS float*)(lds + CSTBUF_OFF + (ui & 1) * 2048));
#ifdef EPI2X
            if (Epi::EPI_ID == EPI2X) { asm volatile("" ::: "memory"); E(acc, cur, wr, wc, fr, fq, ShflDev{}, rsbuf + (ui & 1) * 256, (PG8_LAS float*)(lds + CSTBUF_OFF + (ui & 1) * 2048)); }
#endif
            S.done(cur); }
        if (!has_next) break;
        if constexpr (Epi::HAS_RS) PG8_RS_COMMIT((ui + 1) & 1);
        if constexpr (Epi::HAS_INIT) E.init(acc, nxt, wr, wc, fr, fq);
        else {
#pragma unroll
        for (int a = 0; a < 2; ++a)
#pragma unroll
            for (int b = 0; b < 2; ++b)
#pragma unroll
                for (int m = 0; m < 4; ++m)
#pragma unroll
                    for (int n = 0; n < 2; ++n) acc[a][b][m][n] = (f32x4){0.f, 0.f, 0.f, 0.f};
        }
        cur = nxt; cA = nA; cB = nB; ++ui;
        if constexpr (ALIGN_EPI) { if (wr == 1) PG8_BAR; }
    }
    PG8_WAIT_V(0);
    if constexpr (!ALIGN_EPI) { if (wr == 0) PG8_BAR; }
    PG8_BAR;
#undef PG8_RS_ISSUE
#undef PG8_RS_COMMIT
#undef PG8_SA
#undef PG8_SB
#undef PG8_STAGE
#undef PG8_LDA
#undef PG8_LDB
#undef PG8_MMA
#undef PG8_WAIT_V
#undef PG8_WAIT_L
#undef PG8_BAR
#undef PG8_SCHED
}

constexpr int NWAVES = 8;
#ifndef MK_PER_PHASE
#define MK_PER_PHASE 0
#endif
constexpr int N_PHASES = 7 * NLAYER + 2;

constexpr size_t MiB = 1u << 20;
constexpr size_t WS_CTL = 0, CTL_ZERO_BYTES = 64 * 1024;
constexpr size_t WS_SS0 = 1 * MiB, WS_SS1 = 2 * MiB;
constexpr size_t WS_WB = 3 * MiB;
constexpr size_t WB_WIN = 0, WB_WAB = WB_WIN + (size_t)NIN * D, WB_WO = WB_WAB + (size_t)D * D, WB_WUP = WB_WO + (size_t)D * D, WB_WDN = WB_WUP + (size_t)NUP * D,
                 WB_WPG = WB_WDN + (size_t)D * DFF, WB_WPL = WB_WPG + (size_t)D * D, WB_END = WB_WPL + (size_t)D * PLE;
static_assert(WB_END * 2 == 32 * MiB, "weight copies fill 32 MiB");
constexpr size_t WS_PB = 35 * MiB;
constexpr size_t WS_XB = 44 * MiB;
constexpr size_t WS_ACT = 77 * MiB;
constexpr size_t WS_AGLU = WS_ACT, WS_CV = WS_ACT + 16 * MiB, WS_BS = WS_ACT + 32 * MiB, WS_GR = WS_ACT + 48 * MiB, WS_GB = WS_ACT + 80 * MiB,
                 WS_A2S = WS_ACT + 112 * MiB, WS_E = WS_ACT + 144 * MiB, WS_END = WS_ACT + 176 * MiB;
constexpr size_t WS_MG = WS_AGLU;
constexpr size_t WS_F = WS_ACT;
constexpr size_t WS_XB2 = WS_A2S;
static_assert(WS_END <= 256 * MiB && WS_F + (size_t)M * DFF * 2 <= WS_A2S && WS_XB + (size_t)(M + 256) * D * 2 <= WS_ACT, "d_ws map");
constexpr size_t OUT_XB2 = 0, OUT_WB1 = 32 * MiB;
static_assert(NLAYER == 2, "one layer's weight copies live in d_ws, the other's in d_out");
constexpr int CW_BAR = 4096;

constexpr int RING_OFF = 0, RING_BYTES = 131072;
constexpr int LDSCTL_OFF = RING_BYTES, MISC_OFF = LDSCTL_OFF + 320;
constexpr int LDS_BYTES = 155648;
static_assert(MISC_OFF + 128 <= RSBUF_OFF && RSBUF_OFF >= LDSCTL_OFF && RSBUF_OFF + 2 * 256 * 4 <= RSRAW_OFF && RSRAW_OFF + 16384 <= CSTBUF_OFF && CSTBUF_OFF + 2 * 2048 <= LDS_BYTES, "LDS map");

#define XB_TMO      128
#define XB_XCNT(j)  (256  + 64 * (j))
#define XB_XSUB(j)  (1280 + 64 * (j))
#define XB_XGEN(j)  (2304 + 64 * (j))
#define XB_TOP      3328
#define XB_TOPGEN   3392
#define XCD_BAR_WORDS 3456
#define XL_SUB(j)   (3456 + 64 * (j))
#define XL_GEN(j)   (4480 + 64 * (j))
#define XB_SPIN_CAP (1u << 18)

__device__ __forceinline__ unsigned xb_ld(unsigned* p)              { return __hip_atomic_load(p, __ATOMIC_RELAXED, __HIP_MEMORY_SCOPE_AGENT); }
__device__ __forceinline__ unsigned xb_add(unsigned* p, unsigned v) { return __hip_atomic_fetch_add(p, v, __ATOMIC_RELAXED, __HIP_MEMORY_SCOPE_AGENT); }
__device__ __forceinline__ unsigned xb_xcc_id() { return (unsigned)__builtin_amdgcn_s_getreg((3 << 11) | 20) & 0xFu; }
#define XB_SPIN(cond, bar) do { unsigned _sp = 0; while (cond) { __builtin_amdgcn_s_sleep(1); \
    if ((++_sp & 255u) == 0u) { if (xb_ld(&(bar)[XB_TMO])) break; if (_sp > XB_SPIN_CAP) { atomicAdd(&(bar)[XB_TMO], 1u); break; } } } } while (0)

struct XcdBarrier {
    unsigned* bar; unsigned x;
    volatile LAS unsigned* st;
};

__device__ __forceinline__ XcdBarrier xcd_barrier_post(unsigned* bar, volatile LAS unsigned* st) {
    XcdBarrier b; b.bar = bar; b.x = xb_xcc_id(); b.st = st;
    if (threadIdx.x == 0) st[2] = xb_add(&bar[XB_XCNT(b.x)], 1u);
    return b;
}
__device__ __forceinline__ void xcd_barrier_complete(unsigned* bar, unsigned x, unsigned& nloc, unsigned& nx, unsigned& bal) {
    const unsigned G = gridDim.x * gridDim.y * gridDim.z;
    unsigned sum, cnt, mine, even, sp = 0u;
    for (;;) {
        sum = 0u; cnt = 0u; mine = 0u; even = 1u;
#pragma unroll
        for (unsigned j = 0; j < 16; ++j) { const unsigned c = xb_ld(&bar[XB_XCNT(j)]); sum += c; cnt += (c > 0u) ? 1u : 0u; mine = (j == x) ? c : mine; even &= (c == 0u || c * 8u == G) ? 1u : 0u; }
        if (sum == G) break;
        __builtin_amdgcn_s_sleep(1);
        if ((++sp & 255u) == 0u) { if (xb_ld(&bar[XB_TMO])) break; if (sp > XB_SPIN_CAP) { atomicAdd(&bar[XB_TMO], 1u); break; } }
    }
    nloc = mine > 0u ? mine : 1u; nx = cnt > 0u ? cnt : 1u;
    bal = (sum == G && cnt == 8u && even) ? 1u : 0u;
}

__device__ __forceinline__ void xcd_barrier_thread0(const XcdBarrier& b) {
    {
        unsigned* bar = b.bar;
        __builtin_amdgcn_s_waitcnt(0);
        unsigned nloc = b.st[0], nx = b.st[1];
        if (nloc == 0u) { unsigned bal; xcd_barrier_complete(bar, b.x, nloc, nx, bal); b.st[0] = nloc; b.st[1] = nx; b.st[3] = bal; }
        const unsigned old = xb_add(&bar[XB_XSUB(b.x)], 1u);
        const unsigned gen = old / nloc;
        if (old + 1u == (gen + 1u) * nloc) {
            __builtin_amdgcn_fence(__ATOMIC_RELEASE, "agent");
            asm volatile("s_waitcnt vmcnt(0)" ::: "memory");
            const unsigned og = xb_add(&bar[XB_TOP], 1u);
            const unsigned tg = og / nx;
            if (og + 1u == (tg + 1u) * nx) xb_add(&bar[XB_TOPGEN], 1u);
            else XB_SPIN(xb_ld(&bar[XB_TOPGEN]) == tg, bar);
            __builtin_amdgcn_fence(__ATOMIC_ACQUIRE, "agent");
            xb_add(&bar[XB_XGEN(b.x)], 1u);
            asm volatile("s_waitcnt vmcnt(0)" ::: "memory");
        } else {
            XB_SPIN(xb_ld(&bar[XB_XGEN(b.x)]) == gen, bar);
            __builtin_amdgcn_fence(__ATOMIC_ACQUIRE, "agent");
            asm volatile("s_waitcnt vmcnt(0)" ::: "memory");
        }
    }
}
__device__ __forceinline__ void xcc_barrier_thread0(const XcdBarrier& b) {
    unsigned* bar = b.bar;
    __builtin_amdgcn_s_waitcnt(0);
    const unsigned nloc = b.st[0];
    const unsigned old = xb_add(&bar[XL_SUB(b.x)], 1u);
    const unsigned gen = old / nloc;
    if (old + 1u == (gen + 1u) * nloc) xb_add(&bar[XL_GEN(b.x)], 1u);
    else XB_SPIN(xb_ld(&bar[XL_GEN(b.x)]) == gen, bar);
    __builtin_amdgcn_fence(__ATOMIC_ACQUIRE, "agent");
    asm volatile("s_waitcnt vmcnt(0)" ::: "memory");
}
__device__ __forceinline__ void xcd_barrier(const XcdBarrier& b) {
    asm volatile("s_waitcnt vmcnt(0)" ::: "memory");
    __syncthreads();
    if (threadIdx.x == 0) xcd_barrier_thread0(b);
    __syncthreads();
}

struct Frame {
    LAS unsigned char* lds;
    volatile LAS unsigned* MISC;
    gu32* ctl;
    int tid, lane, wave;
    int vcu, G;
    float* out; unsigned char* ws;
};
__device__ __forceinline__ float wave_sum(float v) {
#pragma unroll
    for (int o = 1; o < 64; o <<= 1) v += __shfl_xor(v, o, 64);
    return v;
}

#ifndef NT_SRC
#define NT_SRC 1
#endif
#if NT_SRC
#define NTLOAD(p) __builtin_nontemporal_load(p)
#else
#define NTLOAD(p) (*(p))
#endif
__device__ __forceinline__ void cv_item(const float* W, int N, const float* gk, bf16_t* WT, int ldt, int kofs, int drow, int kb, int nb, LAS float* scr, int lane) {
    const int k0 = 64 * kb, n0 = 32 * nb, kq = lane >> 3, n4 = (lane & 7) * 4;
    f32x4 v[8]; float sc[8];
#pragma unroll
    for (int i = 0; i < 8; ++i) { v[i] = NTLOAD((const GAS f32x4*)(W + (size_t)(k0 + 8 * i + kq) * N + n0 + n4)); sc[i] = gk ? gk[k0 + 8 * i + kq] : 1.0f; }
#pragma unroll
    for (int i = 0; i < 8; ++i) { LAS float* d = scr + (8 * i + kq) * 33 + n4; const f32x4 t = v[i] * sc[i]; d[0] = t[0]; d[1] = t[1]; d[2] = t[2]; d[3] = t[3]; }
    LDS_WAIT(); asm volatile("" ::: "memory");
    const int c = lane & 7;
#pragma unroll
    for (int j = 0; j < 4; ++j) { const int n = (lane >> 3) + 8 * j; const LAS float* s = scr + (8 * c) * 33 + n;
        u32x4 o; o.x = pk2(s[0 * 33], s[1 * 33]); o.y = pk2(s[2 * 33], s[3 * 33]); o.z = pk2(s[4 * 33], s[5 * 33]); o.w = pk2(s[6 * 33], s[7 * 33]);
        *(GAS u32x4*)(WT + (size_t)(drow + n) * ldt + kofs + k0 + 8 * c) = o; }
    LDS_WAIT(); asm volatile("" ::: "memory");
}
struct CvPtrs { const float *x, *p, *g_mix, *w_in, *w_a, *w_b, *w_o, *g_ffn, *w_up, *w_dn, *g_ple, *w_pl, *w_pg; };
__device__ __forceinline__ void cv_p(Frame& F, int layer, const float* p) {
    const GAS f32x4* src = (const GAS f32x4*)(p + (size_t)layer * M * PLE); GAS u32x2* dst = (GAS u32x2*)(F.ws + WS_PB);
    const int gt = F.vcu * (NWAVES * 64) + F.tid, NT = F.G * NWAVES * 64;
    for (int i = gt; i < M * PLE / 4; i += 4 * NT) {
        f32x4 v[4];
#pragma unroll
        for (int j = 0; j < 4; ++j) { const int ii = i + j * NT; v[j] = NTLOAD(src + (ii < M * PLE / 4 ? ii : i)); }
#pragma unroll
        for (int j = 0; j < 4; ++j) { const int ii = i + j * NT; if (ii < M * PLE / 4) dst[ii] = pk4(v[j]); }
    }
}
constexpr int CI_IN = (D / 64) * (NIN / 32), CI_A = (DC / 64) * (D / 32), CI_O = (D / 64) * (D / 32), CI_UP = (D / 64) * (NUP / 32), CI_DN = (DFF / 64) * (D / 32), CI_PL = (PLE / 64) * (D / 32);
constexpr int CV_NITEMS = CI_IN + 2 * CI_A + CI_O + CI_UP + CI_DN + CI_O + CI_PL;
constexpr int CV_BG0 = CI_IN, CV_BG0_N = CV_NITEMS - CI_IN - CI_PL;
constexpr int CV_BG_TOTAL = CV_BG0_N + (NLAYER - 1) * CV_NITEMS, CV_BG_PER = 1200, CV_BG_SLOTS = (CV_BG_TOTAL + CV_BG_PER - 1) / CV_BG_PER;
constexpr int cv_bg_done(int items) { return (items + CV_BG_PER - 1) / CV_BG_PER - 1; }
static_assert(cv_bg_done(2 * CI_A + CI_O) <= 1   && cv_bg_done(2 * CI_A + CI_O + CI_UP) <= 3   && cv_bg_done(2 * CI_A + CI_O + CI_UP + CI_DN) <= 4   && cv_bg_done(CV_BG0_N) <= 5
           && cv_bg_done(CV_BG0_N + CI_IN + CI_PL) <= 6   && cv_bg_done(CV_BG0_N + CI_IN + CI_PL + 2 * CI_A) <= 8   && cv_bg_done(CV_BG0_N + CI_IN + CI_PL + 2 * CI_A + CI_O) <= 9
           && cv_bg_done(CV_BG0_N + CI_IN + CI_PL + 2 * CI_A + CI_O + CI_UP) <= 10   && cv_bg_done(CV_BG0_N + CI_IN + CI_PL + 2 * CI_A + CI_O + CI_UP + CI_DN) <= 11   && cv_bg_done(CV_BG_TOTAL) <= 12  , "background conversion deadlines");
__device__ __forceinline__ void cv_dispatch(const CvPtrs& P, unsigned char* ws, float* out, int layer, int r, LAS float* scr, int lane) {
    bf16_t* WB = layer == 0 ? (bf16_t*)(ws + WS_WB) : (bf16_t*)((unsigned char*)out + OUT_WB1);
    if (r < CI_IN) { const int nblk = NIN / 32, kb = r / nblk, nb = r % nblk; cv_item(P.w_in + (size_t)layer * D * NIN, NIN, P.g_mix + layer * D, WB + WB_WIN, D, 0, win_dst(32 * nb), kb, nb, scr, lane); return; } r -= CI_IN;
    if (r < CI_A)  { const int nblk = D / 32, kb = r / nblk, nb = r % nblk; cv_item(P.w_a + (size_t)layer * DC * D, D, nullptr, WB + WB_WAB, D, 0, 32 * nb, kb, nb, scr, lane); return; } r -= CI_A;
    if (r < CI_A)  { const int nblk = D / 32, kb = r / nblk, nb = r % nblk; cv_item(P.w_b + (size_t)layer * DSC * D, D, nullptr, WB + WB_WAB, D, DC, 32 * nb, kb, nb, scr, lane); return; } r -= CI_A;
    if (r < CI_O)  { const int nblk = D / 32, kb = r / nblk, nb = r % nblk; cv_item(P.w_o + (size_t)layer * D * D, D, nullptr, WB + WB_WO, D, 0, 32 * nb, kb, nb, scr, lane); return; } r -= CI_O;
    if (r < CI_UP) { const int nblk = NUP / 32, kb = r / nblk, nb = r % nblk; cv_item(P.w_up + (size_t)layer * D * NUP, NUP, P.g_ffn + layer * D, WB + WB_WUP, D, 0, wup_dst(32 * nb), kb, nb, scr, lane); return; } r -= CI_UP;
    if (r < CI_DN) { const int nblk = D / 32, kb = r / nblk, nb = r % nblk; cv_item(P.w_dn + (size_t)layer * DFF * D, D, nullptr, WB + WB_WDN, DFF, 0, 32 * nb, kb, nb, scr, lane); return; } r -= CI_DN;
    if (r < CI_O)  { const int nblk = D / 32, kb = r / nblk, nb = r % nblk; cv_item(P.w_pg + (size_t)layer * D * D, D, P.g_ple + layer * D, WB + WB_WPG, D, 0, 32 * nb, kb, nb, scr, lane); return; } r -= CI_O;
    { const int nblk = D / 32, kb = r / nblk, nb = r % nblk; cv_item(P.w_pl + (size_t)layer * PLE * D, D, nullptr, WB + WB_WPL, PLE, 0, 32 * nb, kb, nb, scr, lane); }
}
__device__ __forceinline__ void cv_background(Frame& F, const CvPtrs& P, int s) {
    int tv = threadIdx.x; asm volatile("" : "+v"(tv));
    const int w = __builtin_amdgcn_readfirstlane(tv >> 6) - 1, lane = tv & 63, nbw = F.G * (NWAVES - 1);
    LAS float* scr = (LAS float*)(F.lds + RING_OFF + (w + 1) * 16384);
    const int hi = (s + 1) * CV_BG_PER < CV_BG_TOTAL ? (s + 1) * CV_BG_PER : CV_BG_TOTAL;
    for (int j = s * CV_BG_PER + F.vcu * (NWAVES - 1) + w; j < hi; j += nbw) {
        if (j < CV_BG0_N) cv_dispatch(P, F.ws, F.out, 0, CV_BG0 + j, scr, lane);
        else { const int jj = j - CV_BG0_N; cv_dispatch(P, F.ws, F.out, 1, jj < CI_IN ? jj : (jj < CI_IN + CI_PL ? CV_NITEMS - CI_PL + (jj - CI_IN) : jj - CI_PL), scr, lane); }
    }
}
__device__ __forceinline__ void xcd_barrier_cv(const XcdBarrier& b, Frame& F, const CvPtrs& P, int s, bool local) {
    asm volatile("s_waitcnt vmcnt(0)" ::: "memory");
    __syncthreads();
    if (threadIdx.x < 64) { if (threadIdx.x == 0) { if (local) xcc_barrier_thread0(b); else xcd_barrier_thread0(b); } }
    else if (s < CV_BG_SLOTS) cv_background(F, P, s);
    __syncthreads();
}
__device__ __forceinline__ void cv_phase(Frame& F, const CvPtrs& P) {
    LAS float* scr = (LAS float*)(F.lds + RING_OFF + F.wave * 16384);
    const int gw = F.vcu * NWAVES + F.wave, NGW = F.G * NWAVES;
    for (int it = gw; it < CI_IN + CI_PL; it += NGW) cv_dispatch(P, F.ws, F.out, 0, it < CI_IN ? it : CV_NITEMS - CI_PL + (it - CI_IN), scr, F.lane);
    cv_p(F, 0, P.p);
    for (int m0 = gw * 4; m0 < M; m0 += NGW * 4) {
        f32x4 v[4][4];
#pragma unroll
        for (int r = 0; r < 4; ++r)
#pragma unroll
            for (int j = 0; j < 4; ++j) v[r][j] = NTLOAD((const GAS f32x4*)(P.x + (size_t)(m0 + r) * D) + F.lane + 64 * j);
#pragma unroll
        for (int r = 0; r < 4; ++r) {
            GAS u32x2* o8 = (GAS u32x2*)(F.ws + WS_XB + (size_t)(m0 + r) * D * 2) + F.lane; float s = 0.f;
#pragma unroll
            for (int j = 0; j < 4; ++j) { const f32x4 t = v[r][j]; s += (t[0] * t[0] + t[1] * t[1]) + (t[2] * t[2] + t[3] * t[3]); o8[64 * j] = pk4(t); }
            s = wave_sum(s);
            if (F.lane < 16) ((GAS float*)(F.ws + WS_SS0))[(size_t)(m0 + r) * 16 + F.lane] = F.lane == 0 ? s : 0.f;
        }
    }
}

#ifndef CO_ROWS
#define CO_ROWS 16
#endif
constexpr int CO_R = CO_ROWS;
template <int S> struct CoStep {
    static __device__ __forceinline__ void run(f32x2 (&acc)[CO_R], const f32x2 (&w)[CKA], const unsigned (&in)[CO_R + CKA - 1], int t0) {
        const bool ok = t0 - (CKA - 1) + S >= 0;
        f32x2 a; a.x = ok ? bf_lo(in[S]) : 0.f; a.y = ok ? bf_hi(in[S]) : 0.f;
#pragma unroll
        for (int r = 0; r < CO_R; ++r) { const int k = S - r; if (k >= 0 && k < CKA) acc[r] += w[k] * a; }
        CoStep<S + 1>::run(acc, w, in, t0);
    }
};
template <> struct CoStep<CO_R + CKA - 1> { static __device__ __forceinline__ void run(f32x2 (&)[CO_R], const f32x2 (&)[CKA], const unsigned (&)[CO_R + CKA - 1], int) {} };
__device__ __forceinline__ void co_phase(Frame& F, int layer, const float* cwa_, const float* cba_, const float* lng_, const float* lnb_, const float* cwb_, const float* p_) {
    const int grp = F.tid >> 8, wv = (F.tid >> 6) & 3, c0 = wv * 128 + F.lane * 2;
    const float* cwa = cwa_ + (size_t)layer * CKA * DC; const float* cba = cba_ + layer * DC; const float* lng = lng_ + layer * DC; const float* lnb = lnb_ + layer * DC;
    const float* cwb = cwb_ + (size_t)layer * 3 * DSC;
    const GAS unsigned* AGLU = (const GAS unsigned*)(F.ws + WS_AGLU); const GAS unsigned* CVp = (const GAS unsigned*)(F.ws + WS_CV); const GAS unsigned* BSp = (const GAS unsigned*)(F.ws + WS_BS);
    GAS unsigned* A2S = (GAS unsigned*)(F.ws + WS_A2S);
    LAS f32x2* part = (LAS f32x2*)(F.lds + RING_OFF) + grp * (CO_R * 4);
    f32x2 w[CKA];
#pragma unroll
    for (int k = 0; k < CKA; ++k) w[k] = *(const f32x2*)(cwa + k * DC + c0);
    const f32x2 bias = *(const f32x2*)(cba + c0), lg = *(const f32x2*)(lng + c0), lb = *(const f32x2*)(lnb + c0);
    const f32x2 wb0 = *(const f32x2*)(cwb + c0), wb1 = *(const f32x2*)(cwb + DSC + c0), wb2 = *(const f32x2*)(cwb + 2 * DSC + c0);
    constexpr int NITEM = M / CO_R;
    const int ngrp = 2 * F.G;
    for (int it0 = 0; it0 < NITEM; it0 += ngrp) {
        const int it = it0 + F.vcu * 2 + grp; const bool live = it < NITEM;
        const int g0 = (live ? it : 0) * CO_R, t0 = g0 % SEQ;
        f32x2 acc[CO_R];
#pragma unroll
        for (int r = 0; r < CO_R; ++r) acc[r] = bias;
        {
            unsigned in[CO_R + CKA - 1];
#pragma unroll
            for (int s = 0; s < CO_R + CKA - 1; ++s) { const int gr = (t0 - (CKA - 1) + s >= 0) ? g0 - (CKA - 1) + s : g0; in[s] = AGLU[(size_t)gr * (DC / 2) + (c0 >> 1)]; }
            CoStep<0>::run(acc, w, in, t0);
        }
        {
            float vals[2 * CO_R];
#pragma unroll
            for (int r = 0; r < CO_R; ++r) { vals[r] = acc[r].x + acc[r].y; vals[CO_R + r] = acc[r].x * acc[r].x + acc[r].y * acc[r].y; }
#pragma unroll
            for (int half = CO_R, bit = 32; half >= 1; half >>= 1, bit >>= 1) {
                const bool up = (F.lane & bit) != 0;
#pragma unroll
                for (int i = 0; i < half; ++i) { const float send = up ? vals[i] : vals[i + half], keep = up ? vals[i + half] : vals[i]; vals[i] = keep + __shfl_xor(send, bit, 64); }
            }
            static_assert(CO_R == 16 || CO_R == 32, "the butterfly below ends with 2 (CO_R = 16) or 1 (CO_R = 32) lanes per value");
            const float tot = CO_R == 16 ? vals[0] + __shfl_xor(vals[0], 1, 64) : vals[0];
            const int idx = CO_R == 16 ? ((F.lane >> 1) & 31) : F.lane;
            if (CO_R == 32 || (F.lane & 1) == 0) ((LAS float*)part)[((idx & (CO_R - 1)) * 4 + wv) * 2 + (idx >= CO_R ? 1 : 0)] = tot;
        }
        __syncthreads();
#pragma unroll
        for (int r = 0; r < CO_R; ++r) {
            const f32x2 p0 = part[r * 4 + 0], p1 = part[r * 4 + 1], p2 = part[r * 4 + 2], p3 = part[r * 4 + 3];
            const float mean = ((p0.x + p1.x) + (p2.x + p3.x)) * (1.0f / DC), ex2 = ((p0.y + p1.y) + (p2.y + p3.y)) * (1.0f / DC);
            const float var = fmaxf(ex2 - mean * mean, 0.f), rstd = frsq(var + EPS);
            float y0 = (acc[r].x - mean) * rstd * lg.x + lb.x, y1 = (acc[r].y - mean) * rstd * lg.y + lb.y;
            y0 = y0 * sigm(y0); y1 = y1 * sigm(y1);
            if (live) A2S[(size_t)(g0 + r) * (D / 2) + (c0 >> 1)] = pk2(y0, y1);
        }
        {
            unsigned cvr[CO_R + 2], bsr[CO_R];
#pragma unroll
            for (int r = 0; r < CO_R + 2; ++r) { const int gr = (t0 - 2 + r >= 0) ? g0 - 2 + r : g0; cvr[r] = CVp[(size_t)gr * (DSC / 2) + (c0 >> 1)]; }
#pragma unroll
            for (int r = 0; r < CO_R; ++r) bsr[r] = BSp[(size_t)(g0 + r) * (DSC / 2) + (c0 >> 1)];
#pragma unroll
            for (int r = 0; r < CO_R; ++r) {
                const bool ok2 = t0 + r >= 2, ok1 = t0 + r >= 1;
                const f32x2 c2 = {ok2 ? bf_lo(cvr[r]) : 0.f, ok2 ? bf_hi(cvr[r]) : 0.f}, c1 = {ok1 ? bf_lo(cvr[r + 1]) : 0.f, ok1 ? bf_hi(cvr[r + 1]) : 0.f};
                const f32x2 cc = {bf_lo(cvr[r + 2]), bf_hi(cvr[r + 2])}, b = {bf_lo(bsr[r]), bf_hi(bsr[r])};
                const f32x2 o = b * (wb0 * c2 + wb1 * c1 + wb2 * cc);
                if (live) A2S[(size_t)(g0 + r) * (D / 2) + (DC >> 1) + (c0 >> 1)] = pk2(o.x, o.y);
            }
        }
        __syncthreads();
    }    if (layer + 1 < NLAYER) cv_p(F, layer + 1, p_);
}

__device__ __forceinline__ void final_phase(Frame& F, const float* g_final) {
    const int gw = F.vcu * NWAVES + F.wave, NGW = F.G * NWAVES;
    const float* SS = (const float*)(F.ws + ((NLAYER & 1) ? WS_SS1 : WS_SS0));
    const f32x4* gf = (const f32x4*)g_final + F.lane;
    f32x4 gv[4];
#pragma unroll
    for (int j = 0; j < 4; ++j) gv[j] = gf[64 * j];
    for (int m0 = gw * 4; m0 < M; m0 += NGW * 4) {
        u32x2 xv[4][4]; f32x4 sv[4][4];
#pragma unroll
        for (int r = 0; r < 4; ++r)
#pragma unroll
            for (int j = 0; j < 4; ++j) { xv[r][j] = NTLOAD((const GAS u32x2*)(F.ws + WS_XB2 + (size_t)(m0 + r) * D * 2) + F.lane + 64 * j); sv[r][j] = ((const f32x4*)(SS + (size_t)(m0 + r) * 16))[j]; }
#pragma unroll
        for (int r = 0; r < 4; ++r) {
            const float s = (hsum4(sv[r][0]) + hsum4(sv[r][1])) + (hsum4(sv[r][2]) + hsum4(sv[r][3])); const float rs = frsq(s * (1.0f / (float)D) + EPS);
            GAS f32x4* orow = (GAS f32x4*)(F.out + (size_t)(m0 + r) * D) + F.lane;
#pragma unroll
            for (int j = 0; j < 4; ++j) __builtin_nontemporal_store(unpk4(xv[r][j]) * rs * gv[j], orow + 64 * j);
        }
    }
}

struct Args { const float* in[22]; float* out; unsigned char* ws; int ph_lo, ph_hi, li, pad; };
__global__ void __launch_bounds__(NWAVES * 64, 2) fwd_kernel(Args args) {
    extern __shared__ __attribute__((aligned(16))) unsigned char lds[];
    Frame F;
    F.lds = (LAS unsigned char*)lds;
    F.MISC = (volatile LAS unsigned*)(F.lds + MISC_OFF);
    F.tid = threadIdx.x; F.lane = F.tid & 63; F.wave = __builtin_amdgcn_readfirstlane(F.tid >> 6);
    F.G = gridDim.x; { const int bx = blockIdx.x; F.vcu = (F.G % 8 == 0) ? (bx % 8) * (F.G / 8) + bx / 8 : bx; }
    unsigned char* ws = args.ws; F.ws = ws; F.out = args.out;
    F.ctl = (gu32*)(ws + WS_CTL);
    for (int u = F.tid; u < (LDS_BYTES - LDSCTL_OFF) / 4; u += NWAVES * 64) ((LAS unsigned*)(F.lds + LDSCTL_OFF))[u] = 0u;
    __syncthreads();
    XcdBarrier bar; bar.bar = (unsigned*)(F.ctl + CW_BAR); bar.x = 0; bar.st = nullptr;
    if (!MK_PER_PHASE) bar = xcd_barrier_post((unsigned*)(F.ctl + CW_BAR), F.MISC + 8);

    const int lo = args.ph_lo, hi = args.ph_hi;
#ifndef DUP_MASK
#define DUP_MASK 0u
#endif
#ifndef ALIGNM
#define ALIGNM true
#endif
#ifndef SP2V
#define SP2V true
#endif
#ifndef ALIGN1
#define ALIGN1 false
#endif
#ifndef NOSTORE
#define NOSTORE 0
#endif
#ifndef IN_REV
#define IN_REV 1
#endif
#ifndef NO_BG
#define NO_BG 0
#endif
    const int qlo = lo + __builtin_popcount((unsigned)DUP_MASK & ((1u << lo) - 1u)), qhi = hi + __builtin_popcount((unsigned)DUP_MASK & ((1u << hi) - 1u));
    for (int q = qlo; q < qhi; ++q) {
        int p = 0; while (p + 1 + __builtin_popcount((unsigned)DUP_MASK & ((1u << (p + 1)) - 1u)) <= q) ++p;
        const bool dupfirst = (((unsigned)DUP_MASK >> p) & 1u) && q == p + __builtin_popcount((unsigned)DUP_MASK & ((1u << p) - 1u));
        const int layer = p == 0 ? 0 : (p - 1) / 7, k = p == 0 ? 0 : (p - 1) % 7 + 1;
        { int tv = threadIdx.x; asm volatile("" : "+v"(tv)); F.tid = tv; F.lane = tv & 63; F.wave = __builtin_amdgcn_readfirstlane(tv >> 6); }
        int moff = MISC_OFF; asm volatile("" : "+s"(moff));
        const volatile LAS unsigned* mw = (const volatile LAS unsigned*)(F.lds + moff);
        const int bal = __builtin_amdgcn_readfirstlane((int)mw[11]);
        const int cid = bal ? __builtin_amdgcn_readfirstlane((int)mw[10]) * 8 + (int)bar.x : (int)blockIdx.x;
        F.vcu = (F.G % 8 == 0) ? (cid % 8) * (F.G / 8) + cid / 8 : cid;
        const bf16_t* WB = layer == 0 ? (const bf16_t*)(ws + WS_WB) : (const bf16_t*)((unsigned char*)F.out + OUT_WB1);
        float* SSa = (float*)(ws + ((layer & 1) ? WS_SS1 : WS_SS0));
        float* SSb = (float*)(ws + ((layer & 1) ? WS_SS0 : WS_SS1));
#ifndef PHMASK
#define PHMASK 0x1ff
#endif
        if (p == N_PHASES - 1) { if (PHMASK & 0x100) final_phase(F, args.in[21]); }
        else if (k == 0) { if (PHMASK & 1) { const CvPtrs P{args.in[0], args.in[1], args.in[2], args.in[3], args.in[9], args.in[11], args.in[12], args.in[13], args.in[14], args.in[17], args.in[18], args.in[19], args.in[20]}; cv_phase(F, P); } }
        else if (k == 1) { if (PHMASK & 2) {
#ifndef NO_EG
            {
                Gemm g{(const bf16_t*)(ws + WS_PB), WB + WB_WPL, PLE}; EgOrder S{F.G, cid};
                EpiE E{(bf16_t*)(ws + WS_E)};
                gemm_phase<EpiE, EgOrder, false, SP2V, false>(F.lds + RING_OFF, g, S, E);
            }
#endif
#ifndef NO_IN
            {
                Gemm g{layer == 0 ? (const bf16_t*)(ws + WS_XB) : (const bf16_t*)F.out, WB + WB_WIN, D};   StaticOrder S; S.init(M / BM, NIN / BM, F.G, cid, IN_REV);
                EpiIn E{SSa, args.in[4] + (size_t)layer * 2 * D, (bf16_t*)(ws + WS_AGLU), (bf16_t*)(ws + WS_CV), (bf16_t*)(ws + WS_BS), (bf16_t*)(ws + WS_GR), (bf16_t*)(ws + WS_GB)};
                gemm_phase<EpiIn, StaticOrder, ALIGNM, SP2V, false>(F.lds + RING_OFF, g, S, E);
            }
#endif
        } }
        else if (k == 2) { if (PHMASK & 4) co_phase(F, layer, args.in[5], args.in[6], args.in[7], args.in[8], args.in[10], args.in[1]); }
        else if (k == 3) { if (PHMASK & 8) {
            Gemm g{(const bf16_t*)(ws + WS_A2S), WB + WB_WAB, D}; StaticOrder S; S.init(M / BM, D / BM, F.G, cid);
            EpiMerge E{(const bf16_t*)(ws + WS_GR), (const bf16_t*)(ws + WS_GB), (bf16_t*)(ws + WS_MG)};
            gemm_phase<EpiMerge, StaticOrder, ALIGN1, SP2V, false>(F.lds + RING_OFF, g, S, E);
        } }
        else if (k == 4) { if (PHMASK & 16) {
            Gemm g{(const bf16_t*)(ws + WS_MG), WB + WB_WO, D}; StaticOrder S; S.init(M / BM, D / BM, F.G, cid);
            EpiRes<0> E{layer == 0 ? (const bf16_t*)(ws + WS_XB) : (const bf16_t*)F.out, dupfirst ? (bf16_t*)(ws + WS_A2S) : (bf16_t*)(ws + WS_XB), dupfirst ? (float*)(ws + 76 * MiB) : SSb, nullptr, nullptr, (dupfirst && NOSTORE) ? 1 : 0};
            gemm_phase<EpiRes<0>, StaticOrder, ALIGN1, SP2V, false>(F.lds + RING_OFF, g, S, E);
        } }
        else if (k == 5) { if (PHMASK & 32) {
#ifdef UP_STAGGER
            if (F.vcu & 1) { const unsigned long long t0_ = __builtin_amdgcn_s_memrealtime(); while (__builtin_amdgcn_s_memrealtime() - t0_ < (unsigned long long)(UP_STAGGER)) __builtin_amdgcn_s_sleep(8); }
#endif
            Gemm g{(const bf16_t*)(ws + WS_XB) - 2 * D, WB + WB_WUP, D}; StaticOrder S; S.init(NT_UP, NUP / BM, F.G, cid);
            EpiUp E{SSb, args.in[15] + (size_t)layer * 3 * DFF, args.in[16] + (size_t)layer * DFF, (bf16_t*)(ws + WS_F)};
            gemm_phase<EpiUp, StaticOrder, ALIGNM, SP2V, true>(F.lds + RING_OFF, g, S, E);
        } }
        else if (k == 6) { if (PHMASK & 64) {
            Gemm g{(const bf16_t*)(ws + WS_F), WB + WB_WDN, DFF}; StaticOrder S; S.init(M / BM, D / BM, F.G, cid);
            EpiRes<0> E{(const bf16_t*)(ws + WS_XB), dupfirst ? (bf16_t*)(ws + WS_A2S) : (bf16_t*)(ws + WS_XB), dupfirst ? (float*)(ws + 76 * MiB) : SSa, nullptr, nullptr, (dupfirst && NOSTORE) ? 1 : 0};
            gemm_phase<EpiRes<0>, StaticOrder, ALIGN1, SP2V, false>(F.lds + RING_OFF, g, S, E);
        } }
        else { if (PHMASK & 128) {
            Gemm g{(const bf16_t*)(ws + WS_XB), WB + WB_WPG, D}; StaticOrder S; S.init(M / BM, D / BM, F.G, cid);
            EpiRes<1> E{(const bf16_t*)(ws + WS_XB), layer == NLAYER - 1 ? (bf16_t*)(ws + WS_XB2) : (bf16_t*)F.out, SSb, SSa, (const bf16_t*)(ws + WS_E), 0};
            gemm_phase<EpiRes<1>, StaticOrder, ALIGN1, SP2V, false>(F.lds + RING_OFF, g, S, E);
        } }
        if (q + 1 < qhi) {
#ifndef XLOCAL
#define XLOCAL 1
#endif
            const bool local = XLOCAL && bal && !DUP_MASK && (k == 3 || k == 6);
            if (!NO_BG && (p < CV_BG_SLOTS || local) && !dupfirst) {
                const CvPtrs P{args.in[0], args.in[1], args.in[2], args.in[3], args.in[9], args.in[11], args.in[12], args.in[13], args.in[14], args.in[17], args.in[18], args.in[19], args.in[20]};
                xcd_barrier_cv(bar, F, P, p, local);
            } else xcd_barrier(bar);
        }
#ifdef BAR2X
        if (q + 1 < qhi) xcd_barrier(bar);
#endif
    }
}

extern "C" void kernel_launch(void* const* d_in, const int* in_sizes, int n_in, void* d_out, int out_size, void* d_ws, size_t ws_size, hipStream_t stream) {
    static int grid = 0;
    if (grid == 0) {
        if (n_in != 22 || in_sizes[0] != M * D || out_size != M * D || ws_size < WS_END) { fprintf(stderr, "kernel_launch: built for 22 inputs, x and out of %d floats, >= %zu bytes of workspace; got n_in %d, in0 %d, out %d, ws %zu; nothing launched\n", M * D, (size_t)WS_END, n_in, n_in > 0 ? in_sizes[0] : -1, out_size, ws_size); grid = -1; return; }
        int dev = 0, cus = 0, per_cu = 0;
        if (hipGetDevice(&dev) != hipSuccess || hipDeviceGetAttribute(&cus, hipDeviceAttributeMultiprocessorCount, dev) != hipSuccess) { fprintf(stderr, "kernel_launch: hipGetDevice / hipDeviceGetAttribute failed; nothing launched\n"); grid = -1; return; }
        if (hipFuncSetAttribute((const void*)fwd_kernel, hipFuncAttributeMaxDynamicSharedMemorySize, LDS_BYTES) != hipSuccess) { fprintf(stderr, "kernel_launch: hipFuncSetAttribute failed\n"); grid = -1; return; }
        if (hipOccupancyMaxActiveBlocksPerMultiprocessor(&per_cu, (const void*)fwd_kernel, NWAVES * 64, LDS_BYTES) != hipSuccess || per_cu < 1)
            fprintf(stderr, "kernel_launch: note: the occupancy query reports %d workgroups per CU\n", per_cu);
        (void)hipGetLastError();
        grid = cus;
    }
    if (grid < 0) return;
    if (hipMemsetAsync((char*)d_ws + WS_CTL, 0, CTL_ZERO_BYTES, stream) != hipSuccess) { fprintf(stderr, "kernel_launch: hipMemsetAsync of the control words failed; nothing launched\n"); return; }
    Args a{};
    for (int i = 0; i < 22; ++i) a.in[i] = (const float*)d_in[i];
    a.out = (float*)d_out; a.ws = (unsigned char*)d_ws;
    const int nl = MK_PER_PHASE ? N_PHASES : 1;
    for (int li = 0; li < nl; ++li) {
        a.ph_lo = MK_PER_PHASE ? li : 0; a.ph_hi = MK_PER_PHASE ? li + 1 : N_PHASES; a.li = li;
        hipLaunchKernelGGL(fwd_kernel, dim3(grid), dim3(NWAVES * 64), LDS_BYTES, stream, a);
        const hipError_t le = hipPeekAtLastError();
        if (le != hipSuccess) { fprintf(stderr, "kernel_launch: launch %d failed: %s (grid %d x %d threads, %d B LDS)\n", li, hipGetErrorName(le), grid, NWAVES * 64, LDS_BYTES); break; }
    }
}
#endif
```

```cpp
#ifndef EMU
#include <hip/hip_runtime.h>
#include <cstdio>
#include <cstdint>
#define HD __host__ __device__ __forceinline__
#else
#include <cstdio>
#include <cstdint>
#include <cmath>
#include <cstring>
#define HD inline
#endif

#ifndef SEQ_LEN
#define SEQ_LEN 8192
#endif
constexpr int BATCH = 2, SEQ = SEQ_LEN, D = 1024, M = BATCH * SEQ;
constexpr int DC = 512, DSC = 512, NIN = 4608, DFF = 2816, NUP = 2 * DFF, PLE = 256, CKA = 31, NLAYER = 2;
constexpr float EPS = 1e-6f;
constexpr int NQ_UP = (M + 61) / 62;
constexpr int NT_UP = (NQ_UP + 3) / 4;

typedef unsigned short bf16_t;
typedef short bf16x8 __attribute__((ext_vector_type(8)));
typedef float f32x4 __attribute__((ext_vector_type(4)));
typedef float f32x2 __attribute__((ext_vector_type(2)));
typedef unsigned u32x4 __attribute__((ext_vector_type(4)));
typedef unsigned u32x2 __attribute__((ext_vector_type(2)));

HD float bits2f(unsigned u) { return __builtin_bit_cast(float, u); }
HD unsigned f2bits(float f) { return __builtin_bit_cast(unsigned, f); }
HD unsigned f2bf(float f) { unsigned u = f2bits(f); return (u + 0x7fffu + ((u >> 16) & 1u)) >> 16; }
HD unsigned pk2(float lo, float hi) {
#if defined(__HIP_DEVICE_COMPILE__)
    unsigned r; asm volatile("v_cvt_pk_bf16_f32 %0, %1, %2" : "=v"(r) : "v"(lo), "v"(hi)); return r;
#else
    return f2bf(lo) | (f2bf(hi) << 16);
#endif
}
HD float bf_lo(unsigned w) { return bits2f(w << 16); }
HD float bf_hi(unsigned w) { return bits2f(w & 0xffff0000u); }
HD float fexp2(float x) {
#if defined(__HIP_DEVICE_COMPILE__)
    return __builtin_amdgcn_exp2f(x);
#else
    return exp2f(x);
#endif
}
HD float frcp(float x) {
#if defined(__HIP_DEVICE_COMPILE__)
    return __builtin_amdgcn_rcpf(x);
#else
    return 1.0f / x;
#endif
}
HD float frsq(float x) {
#if defined(__HIP_DEVICE_COMPILE__)
    return __builtin_amdgcn_rsqf(x);
#else
    return 1.0f / sqrtf(x);
#endif
}
HD float sigm(float x) { return frcp(1.0f + fexp2(-1.44269504089f * x)); }
HD float gelu_tanh(float x) { const float e = fexp2(x * (-2.3022082f + -0.1029432f * x * x)); return x * frcp(1.0f + e); }
HD f32x4 exp2_4(f32x4 v) { return (f32x4){fexp2(v[0]), fexp2(v[1]), fexp2(v[2]), fexp2(v[3])}; }
HD f32x4 rcp4(f32x4 v) { return (f32x4){frcp(v[0]), frcp(v[1]), frcp(v[2]), frcp(v[3])}; }
HD f32x4 sigm4(f32x4 v) { return rcp4(exp2_4(v * -1.44269504089f) + 1.0f); }
HD f32x4 gelu4(f32x4 x) { const f32x4 e = exp2_4(x * (x * x * -0.1029432f + -2.3022082f)); return x * rcp4(e + 1.0f); }
HD u32x4 pk8(f32x4 a, f32x4 b) { u32x4 w; w.x = pk2(a[0], a[1]); w.y = pk2(a[2], a[3]); w.z = pk2(b[0], b[1]); w.w = pk2(b[2], b[3]); return w; }
HD u32x2 pk4(f32x4 a) { u32x2 w; w.x = pk2(a[0], a[1]); w.y = pk2(a[2], a[3]); return w; }
HD f32x4 unpk_lo(u32x4 w) { return (f32x4){bf_lo(w.x), bf_hi(w.x), bf_lo(w.y), bf_hi(w.y)}; }
HD f32x4 unpk_hi(u32x4 w) { return (f32x4){bf_lo(w.z), bf_hi(w.z), bf_lo(w.w), bf_hi(w.w)}; }
HD f32x4 unpk4(u32x2 w) { return (f32x4){bf_lo(w.x), bf_hi(w.x), bf_lo(w.y), bf_hi(w.y)}; }
#if defined(__HIP_DEVICE_COMPILE__)
#define CFENCE() asm volatile("" ::: "memory")
#define LAUNDER(x) asm volatile("" : "+v"(x))
#else
#define CFENCE() do {} while (0)
#define LAUNDER(x) do {} while (0)
#endif
HD float hsum4(f32x4 a) { return (a[0] + a[1]) + (a[2] + a[3]); }

HD float row_rs(const float* SS, int g) {
    const f32x4* p = (const f32x4*)(SS + (size_t)g * 16);
    const f32x4 a = p[0], b = p[1], c = p[2], d = p[3];
    const float s = (hsum4(a) + hsum4(b)) + (hsum4(c) + hsum4(d));
    return frsq(s * (1.0f / (float)D) + EPS);
}

template <class Sh, class RowFn> HD void load_rs8(float (&rsv)[2][4], const float* SS, int fq, int lane, const Sh& sh, const RowFn& rowfn) {
    f32x4 q[2][4];
#pragma unroll
    for (int ai = 0; ai < 2; ++ai)
#pragma unroll
        for (int m = 0; m < 4; ++m) q[ai][m] = *(const f32x4*)(SS + (size_t)rowfn(ai, m) * 16 + fq * 4);
#pragma unroll
    for (int ai = 0; ai < 2; ++ai)
#pragma unroll
        for (int m = 0; m < 4; ++m) { float s = hsum4(q[ai][m]); s += sh(s, lane ^ 16); s += sh(s, lane ^ 32); rsv[ai][m] = frsq(s * (1.0f / (float)D) + EPS); }
}

HD int win_dst(int s) {
    if (s < 512) return 256 * (s >> 7) + (s & 127);
    if (s < 1024) { const int c = s - 512; return 256 * (c >> 7) + 128 + (c & 127); }
    if (s < 1536) return 2048 + (s - 1024);
    if (s < 2048) { const int c = s - 1536; return 256 * (4 + (c >> 7)) + (c & 127); }
    if (s < 2560) { const int c = s - 2048; return 256 * (4 + (c >> 7)) + 128 + (c & 127); }
    if (s < 3584) { const int c = s - 2560; return 256 * (10 + (c >> 7)) + (c & 127); }
    { const int c = s - 3584; return 256 * (10 + (c >> 7)) + 128 + (c & 127); }
}
HD int wup_dst(int s) { if (s < DFF) return 256 * (s >> 7) + (s & 127); const int c = s - DFF; return 256 * (c >> 7) + 128 + (c & 127); }

#ifndef WGMV
#define WGMV 8
#endif
constexpr int BM = 256, BK = 64, HALF = 128, HTB = HALF * BK * 2  , STAGE_BYTES = 8 * HTB, NXCD = 8, WGM = WGMV;
struct Unit { int pm, pn; };
struct Gemm { const bf16_t* A; const bf16_t* Bt; int K; };
struct StaticOrder {
    int nM, nN, nwg, G, c, revn;
    HD void init(int nM_, int nN_, int G_, int c_, int revn_ = 0) { nM = nM_; nN = nN_; nwg = nM * nN; G = G_; c = c_; revn = revn_; }
    HD bool next(int i, Unit& u) const {
        const long L = (long)i * G + c; if (L >= nwg) return false;
        int wgid = (int)L; { const int q = nwg / NXCD, r = nwg % NXCD, xcd = wgid % NXCD, off = wgid / NXCD; wgid = (xcd < r ? xcd * (q + 1) : r * (q + 1) + (xcd - r) * q) + off; }
        const int nig = WGM * nN, gid = wgid / nig, fm = gid * WGM, gsz = (nM - fm) < WGM ? (nM - fm) : WGM;
        u.pm = fm + ((wgid % nig) % gsz); u.pn = (wgid % nig) / gsz; if (revn) u.pn = nN - 1 - u.pn; return true;
    }
    HD void a_ready(const Unit&) const {}
    HD void done(const Unit&) const {}
};

struct EgOrder {
    int G, c;
    HD bool next(int i, Unit& u) const {
        int L;
        if (G == 256) { if (c < 128 || i >= 2) return false; L = (c - 128) * 2 + i; }
        else { L = i * G + c; if (L >= 256) return false; }
        u.pm = L >> 2; u.pn = L & 3; return true;
    }
    HD void a_ready(const Unit&) const {}
    HD void done(const Unit&) const {}
};

typedef f32x4 Acc[2][2][4][2];
#ifdef EMU
typedef const float* rsl_t;
#define LDS4(p) (*(const f32x4*)(p))
#else
typedef const __attribute__((address_space(3))) float* rsl_t;
#define LDS4(p) (*(const __attribute__((address_space(3))) f32x4*)(p))
#endif
#ifndef RS_IN
#define RS_IN 1
#endif
#ifndef RS_UP
#define RS_UP 1
#endif
constexpr int RSBUF_OFF = 131072 + 1024, RSRAW_OFF = 131072 + 4096, CSTBUF_OFF = 131072 + 20480;

struct EpiE {
    static constexpr int EPI_ID = 1; static constexpr bool HAS_RS = false;
    HD int cst_n(const Unit&) const { return 0; }
    HD const float* cst_src(const Unit&, int) const { return nullptr; }
    static constexpr bool PERM = true, AFTER_DRAIN = false, HAS_MID = false, HAS_INIT = false; static constexpr int MID_T = -1;
    bf16_t* E;
    template <class Sh> HD void operator()(const Acc& acc, const Unit& u, int wr, int wc, int fr, int fq, const Sh&, rsl_t, rsl_t) const {
        const int cb = u.pn * 256 + wc * 32 + 8 * fq;
#pragma unroll
        for (int ai = 0; ai < 2; ++ai)
#pragma unroll
            for (int m = 0; m < 4; ++m) { const int g = u.pm * 256 + ai * 128 + wr * 64 + m * 16 + fr; bf16_t* rowp = E + (size_t)g * D + cb;
#pragma unroll
                for (int bj = 0; bj < 2; ++bj) *(u32x4*)(rowp + bj * 128) = pk8(acc[ai][bj][m][0], acc[ai][bj][m][1]); }
    }
    template <class Sh> HD void mid(Acc&, const Unit&, int, int, int, int, const Sh&) const {}
};

struct EpiIn {
    static constexpr int EPI_ID = 2; static constexpr bool HAS_RS = RS_IN;
    HD const float* rs_src() const { return SS; }
    HD int rs_row(const Unit& u, int R) const { return u.pm * 256 + R; }
    HD int cst_n(const Unit& u) const { return u.pn >= 10 ? 64 : 0; }
    HD const float* cst_src(const Unit& u, int i) const { return bgate + (i >> 5) * D + (u.pn - 10) * 128 + 4 * (i & 31); }
    static constexpr bool PERM = true, AFTER_DRAIN = false, HAS_MID = false, HAS_INIT = false; static constexpr int MID_T = -1;
    const float* SS; const float* bgate; bf16_t *AGLU, *CV, *BS, *GR, *GB;
    template <class Sh> HD void operator()(const Acc& acc, const Unit& u, int wr, int wc, int fr, int fq, const Sh& sh, rsl_t rsl, rsl_t cst) const {
        const int cb = wc * 32 + 8 * fq;
        const int pn = u.pn, grow = u.pm * 256 + wr * 64 + fr, lane = fq * 16 + fr;
        float rsv[2][4];
        if constexpr (HAS_RS) { _Pragma("unroll") for (int ai = 0; ai < 2; ++ai) _Pragma("unroll") for (int m = 0; m < 4; ++m) rsv[ai][m] = rsl[128 * ai + 64 * wr + 16 * m + fr]; }
        else load_rs8(rsv, SS, fq, lane, sh, [&](int ai, int m) { return grow + ai * 128 + m * 16; });
        if (pn < 4) {
#pragma unroll
            for (int ai = 0; ai < 2; ++ai)
#pragma unroll
                for (int m = 0; m < 4; ++m) { const int g = grow + ai * 128 + m * 16; const float rs = rsv[ai][m];
                    *(u32x4*)(AGLU + (size_t)g * DC + pn * 128 + cb) = pk8((acc[ai][0][m][0] * rs) * sigm4(acc[ai][1][m][0] * rs), (acc[ai][0][m][1] * rs) * sigm4(acc[ai][1][m][1] * rs)); }
        } else if (pn < 8) {
#pragma unroll
            for (int ai = 0; ai < 2; ++ai)
#pragma unroll
                for (int m = 0; m < 4; ++m) { const int g = grow + ai * 128 + m * 16; const float r2 = rsv[ai][m] * rsv[ai][m];
                    *(u32x4*)(CV + (size_t)g * DSC + (pn - 4) * 128 + cb) = pk8(acc[ai][0][m][0] * acc[ai][1][m][0] * r2, acc[ai][0][m][1] * acc[ai][1][m][1] * r2); }
        } else if (pn < 10) {
#pragma unroll
            for (int ai = 0; ai < 2; ++ai)
#pragma unroll
                for (int m = 0; m < 4; ++m) { const int g = grow + ai * 128 + m * 16; const float rs = rsv[ai][m];
                    bf16_t* rowp = BS + (size_t)g * DSC + (pn - 8) * 256 + cb;
                    *(u32x4*)rowp = pk8(acc[ai][0][m][0] * rs, acc[ai][0][m][1] * rs); *(u32x4*)(rowp + 128) = pk8(acc[ai][1][m][0] * rs, acc[ai][1][m][1] * rs); }
        } else {
            const int t = pn - 10; const rsl_t pa = cst + cb, pb = cst + 128 + cb;
            constexpr float NL2E = -1.44269504089f;
            const f32x4 ba0 = LDS4(pa) * NL2E, ba1 = LDS4(pa + 4) * NL2E, bb0 = LDS4(pb) * NL2E, bb1 = LDS4(pb + 4) * NL2E;
#pragma unroll
            for (int ai = 0; ai < 2; ++ai)
#pragma unroll
                for (int m = 0; m < 4; ++m) { const int g = grow + ai * 128 + m * 16; const float rs = rsv[ai][m] * NL2E;
                    const size_t o = (size_t)g * D + t * 128 + cb;
                    const f32x4 da0 = exp2_4(acc[ai][0][m][0] * rs + ba0) + 1.0f, da1 = exp2_4(acc[ai][0][m][1] * rs + ba1) + 1.0f, db0 = exp2_4(acc[ai][1][m][0] * rs + bb0) + 1.0f, db1 = exp2_4(acc[ai][1][m][1] * rs + bb1) + 1.0f;
                    const f32x4 q0 = rcp4(da0 * db0), q1 = rcp4(da1 * db1);
                    const f32x4 g0 = q0 * da0, g1 = q1 * da1, r0 = q0 * db0 * db0, r1 = q1 * db1 * db1;
                    *(u32x4*)(GR + o) = pk8(r0, r1); *(u32x4*)(GB + o) = pk8(g0, g1); }
        }
    }
    template <class Sh> HD void mid(Acc&, const Unit&, int, int, int, int, const Sh&) const {}
};

struct EpiMerge {
    static constexpr int EPI_ID = 3; static constexpr bool HAS_RS = false;
    HD int cst_n(const Unit&) const { return 0; }
    HD const float* cst_src(const Unit&, int) const { return nullptr; }
    static constexpr bool PERM = true, AFTER_DRAIN = false, HAS_MID = true, HAS_INIT = false; static constexpr int MID_T = 8;
    const bf16_t *GR, *GB; bf16_t* MG;
    template <class Sh> HD void mid(Acc& acc, const Unit& u, int wr, int wc, int fr, int fq, const Sh&) const {
        LAUNDER(fr); LAUNDER(fq);
        const int cb = u.pn * 256 + wc * 32 + 8 * fq, grow = u.pm * 256 + wr * 64 + fr;
#pragma unroll
        for (int ai = 0; ai < 2; ++ai) {
            u32x4 w[4][2];
#pragma unroll
            for (int m = 0; m < 4; ++m)
#pragma unroll
                for (int bj = 0; bj < 2; ++bj) w[m][bj] = *(const u32x4*)(GR + (size_t)(grow + ai * 128 + m * 16) * D + cb + bj * 128);
#pragma unroll
            for (int m = 0; m < 4; ++m)
#pragma unroll
                for (int bj = 0; bj < 2; ++bj) { acc[ai][bj][m][0] *= unpk_lo(w[m][bj]); acc[ai][bj][m][1] *= unpk_hi(w[m][bj]); }
            CFENCE();
        }
    }
    template <class Sh> HD void operator()(const Acc& acc, const Unit& u, int wr, int wc, int fr, int fq, const Sh&, rsl_t, rsl_t) const {
        const int cb = u.pn * 256 + wc * 32 + 8 * fq, grow = u.pm * 256 + wr * 64 + fr;
#pragma unroll
        for (int ai = 0; ai < 2; ++ai) {
            u32x4 w[4][2];
#pragma unroll
            for (int m = 0; m < 4; ++m)
#pragma unroll
                for (int bj = 0; bj < 2; ++bj) w[m][bj] = *(const u32x4*)(GB + (size_t)(grow + ai * 128 + m * 16) * D + cb + bj * 128);
#pragma unroll
            for (int m = 0; m < 4; ++m)
#pragma unroll
                for (int bj = 0; bj < 2; ++bj) *(u32x4*)(MG + (size_t)(grow + ai * 128 + m * 16) * D + cb + bj * 128) = pk8(acc[ai][bj][m][0] * unpk_lo(w[m][bj]), acc[ai][bj][m][1] * unpk_hi(w[m][bj]));
            CFENCE();
        }
    }
};

#ifndef RES_INIT
#define RES_INIT 1
#endif
template <int MODE> struct EpiRes {
    static constexpr int EPI_ID = 6 + MODE; static constexpr bool HAS_RS = false;
    HD int cst_n(const Unit&) const { return 0; }
    HD const float* cst_src(const Unit&, int) const { return nullptr; }
    static constexpr bool PERM = true, AFTER_DRAIN = false, HAS_MID = false, HAS_INIT = (MODE == 0 && RES_INIT); static constexpr int MID_T = -1;
    const bf16_t* xin; bf16_t* xout; float* ssout; const float* ssin; const bf16_t* E; int nostore;
    HD void init(Acc& acc, const Unit& u, int wr, int wc, int fr, int fq) const {
        const int cb = u.pn * 256 + wc * 32 + 8 * fq, grow = u.pm * 256 + wr * 64 + fr;
#pragma unroll
        for (int ai = 0; ai < 2; ++ai)
#pragma unroll
            for (int m = 0; m < 4; ++m)
#pragma unroll
                for (int bj = 0; bj < 2; ++bj) { const u32x4 w = *(const u32x4*)(xin + (size_t)(grow + ai * 128 + m * 16) * D + cb + bj * 128); acc[ai][bj][m][0] = unpk_lo(w); acc[ai][bj][m][1] = unpk_hi(w); }
    }
    template <class Sh> HD void operator()(const Acc& acc, const Unit& u, int wr, int wc, int fr, int fq, const Sh& sh, rsl_t, rsl_t) const {
        const int cb = u.pn * 256 + wc * 32 + 8 * fq; const int lane = fq * 16 + fr, grow = u.pm * 256 + wr * 64 + fr;
#if defined(__HIP_DEVICE_COMPILE__)
        if (nostore) {
#pragma unroll
            for (int ai = 0; ai < 2; ++ai)
#pragma unroll
                for (int bj = 0; bj < 2; ++bj)
#pragma unroll
                    for (int m = 0; m < 4; ++m) { asm volatile("" :: "v"(acc[ai][bj][m][0]), "v"(acc[ai][bj][m][1])); }
            return;
        }
#endif
        float rsv[2][4];
        if (MODE == 1) load_rs8(rsv, ssin, fq, lane, sh, [&](int ai, int m) { return grow + ai * 128 + m * 16; });
        constexpr int MB = MODE == 1 ? 2 : 4;
#pragma unroll
        for (int ai = 0; ai < 2; ++ai)
#pragma unroll
        for (int mh = 0; mh < 4; mh += MB) {
            u32x4 xi[MB][2], ev[MB][2];
#pragma unroll
            for (int mm = 0; mm < MB; ++mm)
#pragma unroll
                for (int bj = 0; bj < 2; ++bj) { const size_t o = (size_t)(grow + ai * 128 + (mh + mm) * 16) * D + cb + bj * 128; if (!HAS_INIT) xi[mm][bj] = *(const u32x4*)(xin + o); if (MODE == 1) ev[mm][bj] = *(const u32x4*)(E + o); }
#pragma unroll
            for (int mm = 0; mm < MB; ++mm) {
                const int m = mh + mm, g = grow + ai * 128 + m * 16; float sq = 0.f;
#pragma unroll
                for (int bj = 0; bj < 2; ++bj) { const size_t o = (size_t)g * D + cb + bj * 128;
                    f32x4 v0 = acc[ai][bj][m][0], v1 = acc[ai][bj][m][1];
                    if (MODE == 1) { const float rs = rsv[ai][m]; v0 = sigm4(v0 * rs) * unpk_lo(ev[mm][bj]); v1 = sigm4(v1 * rs) * unpk_hi(ev[mm][bj]); }
                    const f32x4 x0 = HAS_INIT ? v0 : unpk_lo(xi[mm][bj]) + v0, x1 = HAS_INIT ? v1 : unpk_hi(xi[mm][bj]) + v1;
                    *(u32x4*)(xout + o) = pk8(x0, x1);
                    sq += ((x0[0] * x0[0] + x0[1] * x0[1]) + (x0[2] * x0[2] + x0[3] * x0[3])) + ((x1[0] * x1[0] + x1[1] * x1[1]) + (x1[2] * x1[2] + x1[3] * x1[3])); }
                sq += sh(sq, lane ^ 16); sq += sh(sq, lane ^ 32);
                if (fq == 0) ssout[(size_t)g * 16 + u.pn * 4 + wc] = sq;
            }
            CFENCE();
        }
    }
    template <class Sh> HD void mid(Acc&, const Unit&, int, int, int, int, const Sh&) const {}
};

template <bool V> struct BoolC { static constexpr bool value = V; };
struct EpiUp {
    static constexpr int EPI_ID = 5; static constexpr bool HAS_RS = RS_UP;
    HD const float* rs_src() const { return SS; }
    HD int rs_row(const Unit& u, int R) const { const int g = 62 * (4 * u.pm + (R >> 6)) - 2 + (R & 63); return g < 0 ? 0 : (g > M - 1 ? M - 1 : g); }
    HD int cst_n(const Unit&) const { return 128; }
    HD const float* cst_src(const Unit& u, int i) const { return ((i >> 5) < 3 ? cw + (i >> 5) * DFF : cb_) + u.pn * 128 + 4 * (i & 31); }
    static constexpr bool PERM = true, AFTER_DRAIN = false, HAS_MID = false, HAS_INIT = false; static constexpr int MID_T = -1;
    const float* SS; const float* cw; const float* cb_; bf16_t* F;
    template <class Sh> HD void operator()(const Acc& acc, const Unit& u, int wr, int wc, int fr, int fq, const Sh& sh, rsl_t rsl, rsl_t cst) const {
        const int ch = u.pn * 128 + wc * 32 + 8 * fq;
        const int lane = fq * 16 + fr;
        float rsv[2][4];
        if constexpr (HAS_RS) { _Pragma("unroll") for (int ai = 0; ai < 2; ++ai) _Pragma("unroll") for (int m = 0; m < 4; ++m) rsv[ai][m] = rsl[128 * ai + 64 * wr + 16 * m + fr]; }
        else load_rs8(rsv, SS, fq, lane, sh, [&](int ai, int m) { const int g = 62 * (4 * u.pm + 2 * ai + wr) - 2 + m * 16 + fr; return g < 0 ? 0 : (g > M - 1 ? M - 1 : g); });
        const rsl_t cp = cst + wc * 32 + 8 * fq;
        const f32x4 w0a = LDS4(cp), w0b = LDS4(cp + 4), w1a = LDS4(cp + 128), w1b = LDS4(cp + 132), w2a = LDS4(cp + 256), w2b = LDS4(cp + 260), bia = LDS4(cp + 384), bib = LDS4(cp + 388);
        auto chunk = [&](auto gen_tag, int ai) {
            constexpr bool GEN = decltype(gen_tag)::value;
            const int q = 4 * u.pm + 2 * ai + wr;
            f32x4 pa = {0.f, 0.f, 0.f, 0.f}, pb = pa;
#pragma unroll
            for (int m = 0; m < 4; ++m) {
                const int rho = m * 16 + fr, g = 62 * q - 2 + rho; const int gc = g < 0 ? 0 : (g > M - 1 ? M - 1 : g);
                const float rs = rsv[ai][m];
                const f32x4 ga = acc[ai][0][m][0] * rs, gb = acc[ai][0][m][1] * rs, va = acc[ai][1][m][0] * rs, vb = acc[ai][1][m][1] * rs;
                f32x4 t1a, t1b, t2a, t2b;
#pragma unroll
                for (int j = 0; j < 4; ++j) {
                    t1a[j] = sh.ror1(fr == 15 ? pa[j] : ga[j]); t1b[j] = sh.ror1(fr == 15 ? pb[j] : gb[j]);
                    t2a[j] = sh.ror2(fr >= 14 ? pa[j] : ga[j]); t2b[j] = sh.ror2(fr >= 14 ? pb[j] : gb[j]);
                }
                pa = ga; pb = gb;
                if (GEN) {
                    const int t = gc % SEQ;
                    if (sh.any(t < 2)) {
                        if (t < 1) { t1a = (f32x4){0.f, 0.f, 0.f, 0.f}; t1b = t1a; }
                        if (t < 2) { t2a = (f32x4){0.f, 0.f, 0.f, 0.f}; t2b = t2a; }
                    }
                }
                const f32x4 fa = w2a * ga + w1a * t1a + w0a * t2a + bia, fb = w2b * gb + w1b * t1b + w0b * t2b + bib;
                const f32x4 oa = gelu4(fa) * va, ob = gelu4(fb) * vb;
                if (GEN ? (rho >= 2 && g < M) : (m > 0 || fr >= 2)) *(u32x4*)(F + (size_t)g * DFF + ch) = pk8(oa, ob);
            }
        };
#pragma unroll
        for (int ai = 0; ai < 2; ++ai) {
            const int q = 4 * u.pm + 2 * ai + wr, a = 62 * q - 2, b = a + 63, s0 = (b / SEQ) * SEQ;
            if (sh.any(a <= 0 || s0 + 1 >= a || b >= M)) chunk(BoolC<true>{}, ai); else chunk(BoolC<false>{}, ai);
        }
    }
    template <class Sh> HD void mid(Acc&, const Unit&, int, int, int, int, const Sh&) const {}
};

#ifndef EMU
#define PG8_LAS __attribute__((address_space(3)))
#define GAS __attribute__((address_space(1)))
#define LAS __attribute__((address_space(3)))
typedef GAS unsigned gu32;
#define RLX_AGENT __ATOMIC_RELAXED, __HIP_MEMORY_SCOPE_AGENT
#define LDS_WAIT() asm volatile("s_waitcnt lgkmcnt(0)" ::: "memory")
#define VM_WAIT() asm volatile("s_waitcnt vmcnt(0)" ::: "memory")
#ifndef ROR_DPP
#define ROR_DPP 1
#endif
struct ShflDev {
    __device__ __forceinline__ float operator()(float v, int src) const { return __shfl(v, src, 64); }
    __device__ __forceinline__ bool any(bool p) const { return __any(p) != 0; }
#if ROR_DPP
    __device__ __forceinline__ float ror1(float v) const { return __builtin_bit_cast(float, __builtin_amdgcn_update_dpp(0, __builtin_bit_cast(int, v), 0x121, 0xf, 0xf, true)); }
    __device__ __forceinline__ float ror2(float v) const { return __builtin_bit_cast(float, __builtin_amdgcn_update_dpp(0, __builtin_bit_cast(int, v), 0x122, 0xf, 0xf, true)); }
#else
    __device__ __forceinline__ float ror1(float v) const { const int l = threadIdx.x & 63; return __shfl(v, (l & 48) | ((l + 15) & 15), 64); }
    __device__ __forceinline__ float ror2(float v) const { const int l = threadIdx.x & 63; return __shfl(v, (l & 48) | ((l + 14) & 15), 64); }
#endif
};

__host__ __device__ __forceinline__ int lds_byte(int r, int c) { const int st = (r >> 4) * 2 + (c >> 5), rr = r & 15, cc = c & 31, ob = rr * 64 + cc * 2; return st * 1024 + (ob ^ (((ob >> 9) & 1) << 5)); }
__host__ __device__ __forceinline__ void stage_rc(int b, int& R, int& C) { const int st = b / 1024, sb = b % 1024, swz = sb ^ (((sb >> 9) & 1) << 5); R = (st >> 1) * 16 + swz / 64; C = (st & 1) * 32 + (swz % 64) / 2; }
__host__ __device__ __forceinline__ int perm32(int rho) { const int n = rho >> 4, i = rho & 15; return 8 * (i >> 2) + 4 * n + (i & 3); }

template <class Epi, class Sched, bool ALIGN_EPI = false, bool SP2 = false, bool ACHUNK = false>
__device__ __forceinline__ void gemm_phase(PG8_LAS unsigned char* lds, const Gemm g, const Sched& S, const Epi& E) {
    int tid_ = threadIdx.x; asm volatile("" : "+v"(tid_));
    const int tid = tid_, wid = __builtin_amdgcn_readfirstlane(tid >> 6), lane = tid & 63, wr = wid >> 2, wc = wid & 3, fr = lane & 15, fq = lane >> 4;
    int K_ = g.K; asm volatile("" : "+s"(K_));
    const int K = K_, nt = K / BK;
    unsigned voffA[2], voffB[2];
#pragma unroll
    for (int i = 0; i < 2; ++i) { int R, C; stage_rc(tid * 16 + i * 8192, R, C); const int Rb = Epi::PERM ? ((R & ~31) + perm32(R & 31)) : R;
        const int Ra = ACHUNK ? ((R >> 6) * 62 + (R & 63)) : R; voffA[i] = (unsigned)(Ra * K + C) * 2u; voffB[i] = (unsigned)(Rb * K + C) * 2u; }
    const size_t kstep = (size_t)(BK * 2);
    const size_t hstepB = (size_t)HALF * K * 2, hstepA = ACHUNK ? (size_t)124 * K * 2 : hstepB;
    const size_t tstepA = 2 * hstepA, tstepB = 2 * hstepB;
    const unsigned ldsw = (unsigned)wid * 1024u;
    const int aoff = lds_byte(wr * 64 + fr, fq * 8), boff = lds_byte(wc * 32 + fr, fq * 8);
#define PG8_SA(b, h) (((b) * 2 + (h)) * HTB)
#define PG8_SB(b, h) ((4 + (b) * 2 + (h)) * HTB)
#define PG8_STAGE(bufoff, gbase, voff) do { _Pragma("unroll") for (int _i = 0; _i < 2; ++_i) \
        __builtin_amdgcn_global_load_lds((const unsigned*)((const char*)(gbase) + (voff)[_i]), (PG8_LAS unsigned*)(lds + (bufoff) + ldsw + _i * 8192), 16, 0, 0); } while (0)
#define PG8_LDA(dst, b, h) do { _Pragma("unroll") for (int m = 0; m < 4; ++m) _Pragma("unroll") for (int k = 0; k < 2; ++k) dst[m][k] = *(const PG8_LAS bf16x8*)(lds + PG8_SA(b, h) + aoff + m * 2048 + k * 1024); } while (0)
#define PG8_LDB(dst, b, h) do { _Pragma("unroll") for (int n = 0; n < 2; ++n) _Pragma("unroll") for (int k = 0; k < 2; ++k) dst[n][k] = *(const PG8_LAS bf16x8*)(lds + PG8_SB(b, h) + boff + n * 2048 + k * 1024); } while (0)
#define PG8_MMA(ai, bj, At, Bt) do { __builtin_amdgcn_s_setprio(1); _Pragma("unroll") for (int m = 0; m < 4; ++m) _Pragma("unroll") for (int n = 0; n < 2; ++n) _Pragma("unroll") for (int k = 0; k < 2; ++k) \
        acc[ai][bj][m][n] = __builtin_amdgcn_mfma_f32_16x16x32_bf16(Bt[n][k], At[m][k], acc[ai][bj][m][n], 0, 0, 0); __builtin_amdgcn_s_setprio(0); } while (0)
#define PG8_WAIT_V(n) asm volatile("s_waitcnt vmcnt(" #n ")" ::: "memory")
#define PG8_WAIT_L(n) asm volatile("s_waitcnt lgkmcnt(" #n ")" ::: "memory")
#define PG8_BAR __builtin_amdgcn_s_barrier()
#define PG8_SCHED __builtin_amdgcn_sched_barrier(0)
    Unit cur, nxt; int ui = 0;
    if (!S.next(0, cur)) return;
    f32x4 acc[2][2][4][2];
    if constexpr (Epi::HAS_INIT) E.init(acc, cur, wr, wc, fr, fq);
    else {
#pragma unroll
    for (int a = 0; a < 2; ++a)
#pragma unroll
        for (int b = 0; b < 2; ++b)
#pragma unroll
            for (int m = 0; m < 4; ++m)
#pragma unroll
                for (int n = 0; n < 2; ++n) acc[a][b][m][n] = (f32x4){0.f, 0.f, 0.f, 0.f};
    }
    PG8_LAS float* const rsbuf = (PG8_LAS float*)(lds + RSBUF_OFF);
#define PG8_RS_ISSUE(un, cb_) do { int t_ = tid; asm volatile("" : "+v"(t_));   \
        const float* p_ = E.rs_src() + (size_t)E.rs_row(un, t_ >> 1) * 16 + (t_ & 1) * 8; \
        __builtin_amdgcn_global_load_lds((const unsigned*)p_, (PG8_LAS unsigned*)(lds + RSRAW_OFF + wid * 2048), 16, 0, 0); \
        __builtin_amdgcn_global_load_lds((const unsigned*)(p_ + 4), (PG8_LAS unsigned*)(lds + RSRAW_OFF + wid * 2048 + 1024), 16, 0, 0); \
        { const int nc_ = E.cst_n(un); if (t_ < nc_) __builtin_amdgcn_global_load_lds((const unsigned*)E.cst_src(un, t_), (PG8_LAS unsigned*)(lds + CSTBUF_OFF + (cb_) * 2048 + wid * 1024), 16, 0, 0); } \
        } while (0)
#define PG8_RS_COMMIT(buf) do { int t_ = tid; asm volatile("" : "+v"(t_)); const int lane_ = t_ & 63; \
        const f32x4 a_ = *(const PG8_LAS f32x4*)(lds + RSRAW_OFF + wid * 2048 + lane_ * 16), b_ = *(const PG8_LAS f32x4*)(lds + RSRAW_OFF + wid * 2048 + 1024 + lane_ * 16); \
        float s_ = hsum4(a_) + hsum4(b_); s_ += __shfl_xor(s_, 1, 64); if (!(t_ & 1)) rsbuf[(buf) * 256 + (t_ >> 1)] = frsq(s_ * (1.0f / (float)D) + EPS); } while (0)
    if constexpr (Epi::HAS_RS) PG8_RS_ISSUE(cur, 0);
    bf16x8 At[4][2], B0[2][2], B1[2][2];
    const char* cA = (const char*)g.A + (size_t)cur.pm * tstepA; const char* cB = (const char*)g.Bt + (size_t)cur.pn * tstepB;
    S.a_ready(cur);
    if constexpr (SP2) {
        PG8_STAGE(PG8_SB(0, 0), cB, voffB); PG8_STAGE(PG8_SB(0, 1), cB + hstepB, voffB); PG8_STAGE(PG8_SA(0, 0), cA, voffA); PG8_STAGE(PG8_SA(0, 1), cA + hstepA, voffA);
        if (wr == 1) PG8_BAR;
        PG8_WAIT_V(2); PG8_BAR;
        PG8_STAGE(PG8_SB(1, 0), cB + kstep, voffB); PG8_STAGE(PG8_SA(1, 0), cA + kstep, voffA); PG8_STAGE(PG8_SB(1, 1), cB + hstepB + kstep, voffB);
        PG8_WAIT_V(6); PG8_BAR;
    } else {
        PG8_STAGE(PG8_SB(0, 0), cB, voffB); PG8_STAGE(PG8_SA(0, 0), cA, voffA); PG8_STAGE(PG8_SB(0, 1), cB + hstepB, voffB); PG8_STAGE(PG8_SA(0, 1), cA + hstepA, voffA);
        if (wr == 1) PG8_BAR;
        PG8_WAIT_V(4); PG8_BAR;
        PG8_STAGE(PG8_SB(1, 0), cB + kstep, voffB); PG8_STAGE(PG8_SA(1, 0), cA + kstep, voffA); PG8_STAGE(PG8_SB(1, 1), cB + hstepB + kstep, voffB);
        PG8_WAIT_V(6); PG8_BAR;
    }
    for (;;) {
        const bool has_next = S.next(ui + 1, nxt);
        const char* nA = has_next ? (const char*)g.A + (size_t)nxt.pm * tstepA : cA; const char* nB = has_next ? (const char*)g.Bt + (size_t)nxt.pn * tstepB : cB;
        for (int t = 0; t < nt; t += 2) {
            const bool last = (t == nt - 2);
            if constexpr (Epi::HAS_MID) { if (t == Epi::MID_T) E.mid(acc, cur, wr, wc, fr, fq, ShflDev{}); }
            const char* a1 = cA + (size_t)(t + 1) * kstep;
            const char* a2 = last ? nA : cA + (size_t)(t + 2) * kstep; const char* b2 = last ? nB : cB + (size_t)(t + 2) * kstep;
            const char* a3 = a2 + kstep; const char* b3 = b2 + kstep;
            if (last && has_next) S.a_ready(nxt);
            if constexpr (SP2) {
            PG8_LDB(B0, 0, 0); PG8_LDB(B1, 0, 1); PG8_SCHED; PG8_LDA(At, 0, 0); PG8_STAGE(PG8_SA(1, 1), a1 + hstepA, voffA);
            PG8_WAIT_V(8); PG8_WAIT_L(0); PG8_BAR; PG8_MMA(0, 0, At, B0); PG8_MMA(0, 1, At, B1); PG8_BAR; PG8_SCHED;
            PG8_LDA(At, 0, 1); PG8_STAGE(PG8_SB(0, 0), b2, voffB); PG8_STAGE(PG8_SB(0, 1), b2 + hstepB, voffB); PG8_STAGE(PG8_SA(0, 0), a2, voffA);
            PG8_WAIT_V(8); PG8_WAIT_L(0); PG8_BAR; PG8_MMA(1, 0, At, B0); PG8_MMA(1, 1, At, B1); PG8_BAR; PG8_SCHED;
            PG8_LDB(B0, 1, 0); PG8_LDB(B1, 1, 1); PG8_SCHED; PG8_LDA(At, 1, 0); PG8_STAGE(PG8_SA(0, 1), a2 + hstepA, voffA);
            PG8_WAIT_V(8); PG8_WAIT_L(0); PG8_BAR; PG8_MMA(0, 0, At, B0); PG8_MMA(0, 1, At, B1); PG8_BAR; PG8_SCHED;
            PG8_LDA(At, 1, 1); PG8_STAGE(PG8_SB(1, 0), b3, voffB); PG8_STAGE(PG8_SB(1, 1), b3 + hstepB, voffB); PG8_STAGE(PG8_SA(1, 0), a3, voffA);
            PG8_WAIT_V(8); PG8_WAIT_L(0); PG8_BAR; PG8_MMA(1, 0, At, B0); PG8_MMA(1, 1, At, B1); PG8_BAR; PG8_SCHED;
            } else {
            PG8_LDB(B0, 0, 0); PG8_SCHED; PG8_LDA(At, 0, 0); PG8_STAGE(PG8_SA(1, 1), a1 + hstepA, voffA);
            PG8_WAIT_L(8); PG8_BAR; PG8_WAIT_L(0); PG8_MMA(0, 0, At, B0); PG8_BAR; PG8_SCHED;
            PG8_LDB(B1, 0, 1); PG8_STAGE(PG8_SB(0, 0), b2, voffB);
            PG8_BAR; PG8_WAIT_L(0); PG8_MMA(0, 1, At, B1); PG8_BAR;
            PG8_LDA(At, 0, 1); PG8_STAGE(PG8_SA(0, 0), a2, voffA);
            PG8_BAR; PG8_WAIT_L(0); PG8_MMA(1, 0, At, B0); PG8_BAR; PG8_SCHED;
            PG8_STAGE(PG8_SB(0, 1), b2 + hstepB, voffB);
            PG8_WAIT_V(6); PG8_BAR; PG8_MMA(1, 1, At, B1); PG8_BAR;
            PG8_LDB(B0, 1, 0); PG8_SCHED; PG8_LDA(At, 1, 0); PG8_STAGE(PG8_SA(0, 1), a2 + hstepA, voffA);
            PG8_WAIT_L(8); PG8_BAR; PG8_WAIT_L(0); PG8_MMA(0, 0, At, B0); PG8_BAR; PG8_SCHED;
            PG8_LDB(B1, 1, 1); PG8_STAGE(PG8_SB(1, 0), b3, voffB);
            PG8_BAR; PG8_WAIT_L(0); PG8_MMA(0, 1, At, B1); PG8_BAR;
            PG8_LDA(At, 1, 1); PG8_STAGE(PG8_SA(1, 0), a3, voffA);
            PG8_BAR; PG8_WAIT_L(0); PG8_MMA(1, 0, At, B0); PG8_BAR; PG8_SCHED;
            PG8_STAGE(PG8_SB(1, 1), b3 + hstepB, voffB);
            PG8_WAIT_V(6); PG8_BAR; PG8_MMA(1, 1, At, B1); PG8_BAR;
            }
        }
        if constexpr (ALIGN_EPI) { if (wr == 0) PG8_BAR; }
        if constexpr (Epi::HAS_RS) {
            static_assert(ALIGN_EPI, "the extra barrier below assumes the two halves run their epilogues together");
            PG8_RS_COMMIT(ui & 1); PG8_WAIT_L(0); PG8_BAR;
            if (has_next) PG8_RS_ISSUE(nxt, (ui + 1) & 1);
        }
        if constexpr (!Epi::AFTER_DRAIN) { E(acc, cur, wr, wc, fr, fq, ShflDev{}, rsbuf + (ui & 1) * 256, (PG8_LAS float*)(lds + CSTBUF_OFF + (ui & 1) * 2048));
#ifdef EPI2X
            if (Epi::EPI_ID == EPI2X) { asm volatile("" ::: "memory"); E(acc, cur, wr, wc, fr, fq, ShflDev{}, rsbuf + (ui & 1) * 256, (PG8_LAS float*)(lds + CSTBUF_OFF + (ui & 1) * 2048)); }
#endif
            S.done(cur); }
        if (!has_next) break;
        if constexpr (Epi::HAS_INIT) E.init(acc, nxt, wr, wc, fr, fq);
        else {
#pragma unroll
        for (int a = 0; a < 2; ++a)
#pragma unroll
            for (int b = 0; b < 2; ++b)
#pragma unroll
                for (int m = 0; m < 4; ++m)
#pragma unroll
                    for (int n = 0; n < 2; ++n) acc[a][b][m][n] = (f32x4){0.f, 0.f, 0.f, 0.f};
        }
        cur = nxt; cA = nA; cB = nB; ++ui;
        if constexpr (ALIGN_EPI) { if (wr == 1) PG8_BAR; }
    }
    PG8_WAIT_V(0);
    if constexpr (!ALIGN_EPI) { if (wr == 0) PG8_BAR; }
    PG8_BAR;
#undef PG8_RS_ISSUE
#undef PG8_RS_COMMIT
#undef PG8_SA
#undef PG8_SB
#undef PG8_STAGE
#undef PG8_LDA
#undef PG8_LDB
#undef PG8_MMA
#undef PG8_WAIT_V
#undef PG8_WAIT_L
#undef PG8_BAR
#undef PG8_SCHED
}

constexpr int NWAVES = 8;
#ifndef MK_PER_PHASE
#define MK_PER_PHASE 0
#endif
constexpr int N_PHASES = 7 * NLAYER + 2;

constexpr size_t MiB = 1u << 20;
constexpr size_t WS_CTL = 0, CTL_ZERO_BYTES = 64 * 1024;
constexpr size_t WS_SS0 = 1 * MiB, WS_SS1 = 2 * MiB;
constexpr size_t WS_WB = 3 * MiB;
constexpr size_t WB_WIN = 0, WB_WAB = WB_WIN + (size_t)NIN * D, WB_WO = WB_WAB + (size_t)D * D, WB_WUP = WB_WO + (size_t)D * D, WB_WDN = WB_WUP + (size_t)NUP * D,
                 WB_WPG = WB_WDN + (size_t)D * DFF, WB_WPL = WB_WPG + (size_t)D * D, WB_END = WB_WPL + (size_t)D * PLE;
static_assert(WB_END * 2 == 32 * MiB, "weight copies fill 32 MiB");
constexpr size_t WS_PB = 35 * MiB;
constexpr size_t WS_XB = 44 * MiB;
constexpr size_t WS_ACT = 77 * MiB;
constexpr size_t WS_AGLU = WS_ACT, WS_CV = WS_ACT + 16 * MiB, WS_BS = WS_ACT + 32 * MiB, WS_GR = WS_ACT + 48 * MiB, WS_GB = WS_ACT + 80 * MiB,
                 WS_A2S = WS_ACT + 112 * MiB, WS_E = WS_ACT + 144 * MiB, WS_END = WS_ACT + 176 * MiB;
constexpr size_t WS_MG = WS_AGLU;
constexpr size_t WS_F = WS_ACT;
constexpr size_t WS_XB2 = WS_A2S;
static_assert(WS_END <= 256 * MiB && WS_F + (size_t)M * DFF * 2 <= WS_A2S && WS_XB + (size_t)(M + 256) * D * 2 <= WS_ACT, "d_ws map");
constexpr size_t OUT_XB2 = 0, OUT_WB1 = 32 * MiB;
static_assert(NLAYER == 2, "one layer's weight copies live in d_ws, the other's in d_out");
constexpr int CW_BAR = 4096;

constexpr int RING_OFF = 0, RING_BYTES = 131072;
constexpr int LDSCTL_OFF = RING_BYTES, MISC_OFF = LDSCTL_OFF + 320;
constexpr int LDS_BYTES = 155648;
static_assert(MISC_OFF + 128 <= RSBUF_OFF && RSBUF_OFF >= LDSCTL_OFF && RSBUF_OFF + 2 * 256 * 4 <= RSRAW_OFF && RSRAW_OFF + 16384 <= CSTBUF_OFF && CSTBUF_OFF + 2 * 2048 <= LDS_BYTES, "LDS map");

#define XB_TMO      128
#define XB_XCNT(j)  (256  + 64 * (j))
#define XB_XSUB(j)  (1280 + 64 * (j))
#define XB_XGEN(j)  (2304 + 64 * (j))
#define XB_TOP      3328
#define XB_TOPGEN   3392
#define XCD_BAR_WORDS 3456
#define XL_SUB(j)   (3456 + 64 * (j))
#define XL_GEN(j)   (4480 + 64 * (j))
#define XB_SPIN_CAP (1u << 18)

__device__ __forceinline__ unsigned xb_ld(unsigned* p)              { return __hip_atomic_load(p, __ATOMIC_RELAXED, __HIP_MEMORY_SCOPE_AGENT); }
__device__ __forceinline__ unsigned xb_add(unsigned* p, unsigned v) { return __hip_atomic_fetch_add(p, v, __ATOMIC_RELAXED, __HIP_MEMORY_SCOPE_AGENT); }
__device__ __forceinline__ unsigned xb_xcc_id() { return (unsigned)__builtin_amdgcn_s_getreg((3 << 11) | 20) & 0xFu; }
#define XB_SPIN(cond, bar) do { unsigned _sp = 0; while (cond) { __builtin_amdgcn_s_sleep(1); \
    if ((++_sp & 255u) == 0u) { if (xb_ld(&(bar)[XB_TMO])) break; if (_sp > XB_SPIN_CAP) { atomicAdd(&(bar)[XB_TMO], 1u); break; } } } } while (0)

struct XcdBarrier {
    unsigned* bar; unsigned x;
    volatile LAS unsigned* st;
};

__device__ __forceinline__ XcdBarrier xcd_barrier_post(unsigned* bar, volatile LAS unsigned* st) {
    XcdBarrier b; b.bar = bar; b.x = xb_xcc_id(); b.st = st;
    if (threadIdx.x == 0) st[2] = xb_add(&bar[XB_XCNT(b.x)], 1u);
    return b;
}
__device__ __forceinline__ void xcd_barrier_complete(unsigned* bar, unsigned x, unsigned& nloc, unsigned& nx, unsigned& bal) {
    const unsigned G = gridDim.x * gridDim.y * gridDim.z;
    unsigned sum, cnt, mine, even, sp = 0u;
    for (;;) {
        sum = 0u; cnt = 0u; mine = 0u; even = 1u;
#pragma unroll
        for (unsigned j = 0; j < 16; ++j) { const unsigned c = xb_ld(&bar[XB_XCNT(j)]); sum += c; cnt += (c > 0u) ? 1u : 0u; mine = (j == x) ? c : mine; even &= (c == 0u || c * 8u == G) ? 1u : 0u; }
        if (sum == G) break;
        __builtin_amdgcn_s_sleep(1);
        if ((++sp & 255u) == 0u) { if (xb_ld(&bar[XB_TMO])) break; if (sp > XB_SPIN_CAP) { atomicAdd(&bar[XB_TMO], 1u); break; } }
    }
    nloc = mine > 0u ? mine : 1u; nx = cnt > 0u ? cnt : 1u;
    bal = (sum == G && cnt == 8u && even) ? 1u : 0u;
}

__device__ __forceinline__ void xcd_barrier_thread0(const XcdBarrier& b) {
    {
        unsigned* bar = b.bar;
        __builtin_amdgcn_s_waitcnt(0);
        unsigned nloc = b.st[0], nx = b.st[1];
        if (nloc == 0u) { unsigned bal; xcd_barrier_complete(bar, b.x, nloc, nx, bal); b.st[0] = nloc; b.st[1] = nx; b.st[3] = bal; }
        const unsigned old = xb_add(&bar[XB_XSUB(b.x)], 1u);
        const unsigned gen = old / nloc;
        if (old + 1u == (gen + 1u) * nloc) {
            __builtin_amdgcn_fence(__ATOMIC_RELEASE, "agent");
            asm volatile("s_waitcnt vmcnt(0)" ::: "memory");
            const unsigned og = xb_add(&bar[XB_TOP], 1u);
            const unsigned tg = og / nx;
            if (og + 1u == (tg + 1u) * nx) xb_add(&bar[XB_TOPGEN], 1u);
            else XB_SPIN(xb_ld(&bar[XB_TOPGEN]) == tg, bar);
            __builtin_amdgcn_fence(__ATOMIC_ACQUIRE, "agent");
            xb_add(&bar[XB_XGEN(b.x)], 1u);
            asm volatile("s_waitcnt vmcnt(0)" ::: "memory");
        } else {
            XB_SPIN(xb_ld(&bar[XB_XGEN(b.x)]) == gen, bar);
            __builtin_amdgcn_fence(__ATOMIC_ACQUIRE, "agent");
            asm volatile("s_waitcnt vmcnt(0)" ::: "memory");
        }
    }
}
__device__ __forceinline__ void xcc_barrier_thread0(const XcdBarrier& b) {
    unsigned* bar = b.bar;
    __builtin_amdgcn_s_waitcnt(0);
    const unsigned nloc = b.st[0];
    const unsigned old = xb_add(&bar[XL_SUB(b.x)], 1u);
    const unsigned gen = old / nloc;
    if (old + 1u == (gen + 1u) * nloc) xb_add(&bar[XL_GEN(b.x)], 1u);
    else XB_SPIN(xb_ld(&bar[XL_GEN(b.x)]) == gen, bar);
    __builtin_amdgcn_fence(__ATOMIC_ACQUIRE, "agent");
    asm volatile("s_waitcnt vmcnt(0)" ::: "memory");
}
__device__ __forceinline__ void xcd_barrier(const XcdBarrier& b) {
    asm volatile("s_waitcnt vmcnt(0)" ::: "memory");
    __syncthreads();
    if (threadIdx.x == 0) xcd_barrier_thread0(b);
    __syncthreads();
}

struct Frame {
    LAS unsigned char* lds;
    volatile LAS unsigned* MISC;
    gu32* ctl;
    int tid, lane, wave;
    int vcu, G;
    float* out; unsigned char* ws;
};
__device__ __forceinline__ float wave_sum(float v) {
#pragma unroll
    for (int o = 1; o < 64; o <<= 1) v += __shfl_xor(v, o, 64);
    return v;
}

#ifndef NT_SRC
#define NT_SRC 1
#endif
#if NT_SRC
#define NTLOAD(p) __builtin_nontemporal_load(p)
#else
#define NTLOAD(p) (*(p))
#endif
__device__ __forceinline__ void cv_item(const float* W, int N, const float* gk, bf16_t* WT, int ldt, int kofs, int drow, int kb, int nb, LAS float* scr, int lane) {
    const int k0 = 64 * kb, n0 = 32 * nb, kq = lane >> 3, n4 = (lane & 7) * 4;
    f32x4 v[8]; float sc[8];
#pragma unroll
    for (int i = 0; i < 8; ++i) { v[i] = NTLOAD((const GAS f32x4*)(W + (size_t)(k0 + 8 * i + kq) * N + n0 + n4)); sc[i] = gk ? gk[k0 + 8 * i + kq] : 1.0f; }
#pragma unroll
    for (int i = 0; i < 8; ++i) { LAS float* d = scr + (8 * i + kq) * 33 + n4; const f32x4 t = v[i] * sc[i]; d[0] = t[0]; d[1] = t[1]; d[2] = t[2]; d[3] = t[3]; }
    LDS_WAIT(); asm volatile("" ::: "memory");
    const int c = lane & 7;
#pragma unroll
    for (int j = 0; j < 4; ++j) { const int n = (lane >> 3) + 8 * j; const LAS float* s = scr + (8 * c) * 33 + n;
        u32x4 o; o.x = pk2(s[0 * 33], s[1 * 33]); o.y = pk2(s[2 * 33], s[3 * 33]); o.z = pk2(s[4 * 33], s[5 * 33]); o.w = pk2(s[6 * 33], s[7 * 33]);
        *(GAS u32x4*)(WT + (size_t)(drow + n) * ldt + kofs + k0 + 8 * c) = o; }
    LDS_WAIT(); asm volatile("" ::: "memory");
}
struct CvPtrs { const float *x, *p, *g_mix, *w_in, *w_a, *w_b, *w_o, *g_ffn, *w_up, *w_dn, *g_ple, *w_pl, *w_pg; };
__device__ __forceinline__ void cv_p(Frame& F, int layer, const float* p) {
    const GAS f32x4* src = (const GAS f32x4*)(p + (size_t)layer * M * PLE); GAS u32x2* dst = (GAS u32x2*)(F.ws + WS_PB);
    const int gt = F.vcu * (NWAVES * 64) + F.tid, NT = F.G * NWAVES * 64;
    for (int i = gt; i < M * PLE / 4; i += 4 * NT) {
        f32x4 v[4];
#pragma unroll
        for (int j = 0; j < 4; ++j) { const int ii = i + j * NT; v[j] = NTLOAD(src + (ii < M * PLE / 4 ? ii : i)); }
#pragma unroll
        for (int j = 0; j < 4; ++j) { const int ii = i + j * NT; if (ii < M * PLE / 4) dst[ii] = pk4(v[j]); }
    }
}
constexpr int CI_IN = (D / 64) * (NIN / 32), CI_A = (DC / 64) * (D / 32), CI_O = (D / 64) * (D / 32), CI_UP = (D / 64) * (NUP / 32), CI_DN = (DFF / 64) * (D / 32), CI_PL = (PLE / 64) * (D / 32);
constexpr int CV_NITEMS = CI_IN + 2 * CI_A + CI_O + CI_UP + CI_DN + CI_O + CI_PL;
constexpr int CV_BG0 = CI_IN, CV_BG0_N = CV_NITEMS - CI_IN - CI_PL;
constexpr int CV_BG_TOTAL = CV_BG0_N + (NLAYER - 1) * CV_NITEMS, CV_BG_PER = 1200, CV_BG_SLOTS = (CV_BG_TOTAL + CV_BG_PER - 1) / CV_BG_PER;
constexpr int cv_bg_done(int items) { return (items + CV_BG_PER - 1) / CV_BG_PER - 1; }
static_assert(cv_bg_done(2 * CI_A + CI_O) <= 1   && cv_bg_done(2 * CI_A + CI_O + CI_UP) <= 3   && cv_bg_done(2 * CI_A + CI_O + CI_UP + CI_DN) <= 4   && cv_bg_done(CV_BG0_N) <= 5
           && cv_bg_done(CV_BG0_N + CI_IN + CI_PL) <= 6   && cv_bg_done(CV_BG0_N + CI_IN + CI_PL + 2 * CI_A) <= 8   && cv_bg_done(CV_BG0_N + CI_IN + CI_PL + 2 * CI_A + CI_O) <= 9
           && cv_bg_done(CV_BG0_N + CI_IN + CI_PL + 2 * CI_A + CI_O + CI_UP) <= 10   && cv_bg_done(CV_BG0_N + CI_IN + CI_PL + 2 * CI_A + CI_O + CI_UP + CI_DN) <= 11   && cv_bg_done(CV_BG_TOTAL) <= 12  , "background conversion deadlines");
__device__ __forceinline__ void cv_dispatch(const CvPtrs& P, unsigned char* ws, float* out, int layer, int r, LAS float* scr, int lane) {
    bf16_t* WB = layer == 0 ? (bf16_t*)(ws + WS_WB) : (bf16_t*)((unsigned char*)out + OUT_WB1);
    if (r < CI_IN) { const int nblk = NIN / 32, kb = r / nblk, nb = r % nblk; cv_item(P.w_in + (size_t)layer * D * NIN, NIN, P.g_mix + layer * D, WB + WB_WIN, D, 0, win_dst(32 * nb), kb, nb, scr, lane); return; } r -= CI_IN;
    if (r < CI_A)  { const int nblk = D / 32, kb = r / nblk, nb = r % nblk; cv_item(P.w_a + (size_t)layer * DC * D, D, nullptr, WB + WB_WAB, D, 0, 32 * nb, kb, nb, scr, lane); return; } r -= CI_A;
    if (r < CI_A)  { const int nblk = D / 32, kb = r / nblk, nb = r % nblk; cv_item(P.w_b + (size_t)layer * DSC * D, D, nullptr, WB + WB_WAB, D, DC, 32 * nb, kb, nb, scr, lane); return; } r -= CI_A;
    if (r < CI_O)  { const int nblk = D / 32, kb = r / nblk, nb = r % nblk; cv_item(P.w_o + (size_t)layer * D * D, D, nullptr, WB + WB_WO, D, 0, 32 * nb, kb, nb, scr, lane); return; } r -= CI_O;
    if (r < CI_UP) { const int nblk = NUP / 32, kb = r / nblk, nb = r % nblk; cv_item(P.w_up + (size_t)layer * D * NUP, NUP, P.g_ffn + layer * D, WB + WB_WUP, D, 0, wup_dst(32 * nb), kb, nb, scr, lane); return; } r -= CI_UP;
    if (r < CI_DN) { const int nblk = D / 32, kb = r / nblk, nb = r % nblk; cv_item(P.w_dn + (size_t)layer * DFF * D, D, nullptr, WB + WB_WDN, DFF, 0, 32 * nb, kb, nb, scr, lane); return; } r -= CI_DN;
    if (r < CI_O)  { const int nblk = D / 32, kb = r / nblk, nb = r % nblk; cv_item(P.w_pg + (size_t)layer * D * D, D, P.g_ple + layer * D, WB + WB_WPG, D, 0, 32 * nb, kb, nb, scr, lane); return; } r -= CI_O;
    { const int nblk = D / 32, kb = r / nblk, nb = r % nblk; cv_item(P.w_pl + (size_t)layer * PLE * D, D, nullptr, WB + WB_WPL, PLE, 0, 32 * nb, kb, nb, scr, lane); }
}
__device__ __forceinline__ void cv_background(Frame& F, const CvPtrs& P, int s) {
    int tv = threadIdx.x; asm volatile("" : "+v"(tv));
    const int w = __builtin_amdgcn_readfirstlane(tv >> 6) - 1, lane = tv & 63, nbw = F.G * (NWAVES - 1);
    LAS float* scr = (LAS float*)(F.lds + RING_OFF + (w + 1) * 16384);
    const int hi = (s + 1) * CV_BG_PER < CV_BG_TOTAL ? (s + 1) * CV_BG_PER : CV_BG_TOTAL;
    for (int j = s * CV_BG_PER + F.vcu * (NWAVES - 1) + w; j < hi; j += nbw) {
        if (j < CV_BG0_N) cv_dispatch(P, F.ws, F.out, 0, CV_BG0 + j, scr, lane);
        else { const int jj = j - CV_BG0_N; cv_dispatch(P, F.ws, F.out, 1, jj < CI_IN ? jj : (jj < CI_IN + CI_PL ? CV_NITEMS - CI_PL + (jj - CI_IN) : jj - CI_PL), scr, lane); }
    }
}
__device__ __forceinline__ void xcd_barrier_cv(const XcdBarrier& b, Frame& F, const CvPtrs& P, int s, bool local) {
    asm volatile("s_waitcnt vmcnt(0)" ::: "memory");
    __syncthreads();
    if (threadIdx.x < 64) { if (threadIdx.x == 0) { if (local) xcc_barrier_thread0(b); else xcd_barrier_thread0(b); } }
    else if (s < CV_BG_SLOTS) cv_background(F, P, s);
    __syncthreads();
}
__device__ __forceinline__ void cv_phase(Frame& F, const CvPtrs& P) {
    LAS float* scr = (LAS float*)(F.lds + RING_OFF + F.wave * 16384);
    const int gw = F.vcu * NWAVES + F.wave, NGW = F.G * NWAVES;
    for (int it = gw; it < CI_IN + CI_PL; it += NGW) cv_dispatch(P, F.ws, F.out, 0, it < CI_IN ? it : CV_NITEMS - CI_PL + (it - CI_IN), scr, F.lane);
    cv_p(F, 0, P.p);
    for (int m0 = gw * 4; m0 < M; m0 += NGW * 4) {
        f32x4 v[4][4];
#pragma unroll
        for (int r = 0; r < 4; ++r)
#pragma unroll
            for (int j = 0; j < 4; ++j) v[r][j] = NTLOAD((const GAS f32x4*)(P.x + (size_t)(m0 + r) * D) + F.lane + 64 * j);
#pragma unroll
        for (int r = 0; r < 4; ++r) {
            GAS u32x2* o8 = (GAS u32x2*)(F.ws + WS_XB + (size_t)(m0 + r) * D * 2) + F.lane; float s = 0.f;
#pragma unroll
            for (int j = 0; j < 4; ++j) { const f32x4 t = v[r][j]; s += (t[0] * t[0] + t[1] * t[1]) + (t[2] * t[2] + t[3] * t[3]); o8[64 * j] = pk4(t); }
            s = wave_sum(s);
            if (F.lane < 16) ((GAS float*)(F.ws + WS_SS0))[(size_t)(m0 + r) * 16 + F.lane] = F.lane == 0 ? s : 0.f;
        }
    }
}

#ifndef CO_ROWS
#define CO_ROWS 16
#endif
constexpr int CO_R = CO_ROWS;
template <int S> struct CoStep {
    static __device__ __forceinline__ void run(f32x2 (&acc)[CO_R], const f32x2 (&w)[CKA], const unsigned (&in)[CO_R + CKA - 1], int t0) {
        const bool ok = t0 - (CKA - 1) + S >= 0;
        f32x2 a; a.x = ok ? bf_lo(in[S]) : 0.f; a.y = ok ? bf_hi(in[S]) : 0.f;
#pragma unroll
        for (int r = 0; r < CO_R; ++r) { const int k = S - r; if (k >= 0 && k < CKA) acc[r] += w[k] * a; }
        CoStep<S + 1>::run(acc, w, in, t0);
    }
};
template <> struct CoStep<CO_R + CKA - 1> { static __device__ __forceinline__ void run(f32x2 (&)[CO_R], const f32x2 (&)[CKA], const unsigned (&)[CO_R + CKA - 1], int) {} };
__device__ __forceinline__ void co_phase(Frame& F, int layer, const float* cwa_, const float* cba_, const float* lng_, const float* lnb_, const float* cwb_, const float* p_) {
    const int grp = F.tid >> 8, wv = (F.tid >> 6) & 3, c0 = wv * 128 + F.lane * 2;
    const float* cwa = cwa_ + (size_t)layer * CKA * DC; const float* cba = cba_ + layer * DC; const float* lng = lng_ + layer * DC; const float* lnb = lnb_ + layer * DC;
    const float* cwb = cwb_ + (size_t)layer * 3 * DSC;
    const GAS unsigned* AGLU = (const GAS unsigned*)(F.ws + WS_AGLU); const GAS unsigned* CVp = (const GAS unsigned*)(F.ws + WS_CV); const GAS unsigned* BSp = (const GAS unsigned*)(F.ws + WS_BS);
    GAS unsigned* A2S = (GAS unsigned*)(F.ws + WS_A2S);
    LAS f32x2* part = (LAS f32x2*)(F.lds + RING_OFF) + grp * (CO_R * 4);
    f32x2 w[CKA];
#pragma unroll
    for (int k = 0; k < CKA; ++k) w[k] = *(const f32x2*)(cwa + k * DC + c0);
    const f32x2 bias = *(const f32x2*)(cba + c0), lg = *(const f32x2*)(lng + c0), lb = *(const f32x2*)(lnb + c0);
    const f32x2 wb0 = *(const f32x2*)(cwb + c0), wb1 = *(const f32x2*)(cwb + DSC + c0), wb2 = *(const f32x2*)(cwb + 2 * DSC + c0);
    constexpr int NITEM = M / CO_R;
    const int ngrp = 2 * F.G;
    for (int it0 = 0; it0 < NITEM; it0 += ngrp) {
        const int it = it0 + F.vcu * 2 + grp; const bool live = it < NITEM;
        const int g0 = (live ? it : 0) * CO_R, t0 = g0 % SEQ;
        f32x2 acc[CO_R];
#pragma unroll
        for (int r = 0; r < CO_R; ++r) acc[r] = bias;
        {
            unsigned in[CO_R + CKA - 1];
#pragma unroll
            for (int s = 0; s < CO_R + CKA - 1; ++s) { const int gr = (t0 - (CKA - 1) + s >= 0) ? g0 - (CKA - 1) + s : g0; in[s] = AGLU[(size_t)gr * (DC / 2) + (c0 >> 1)]; }
            CoStep<0>::run(acc, w, in, t0);
        }
        {
            float vals[2 * CO_R];
#pragma unroll
            for (int r = 0; r < CO_R; ++r) { vals[r] = acc[r].x + acc[r].y; vals[CO_R + r] = acc[r].x * acc[r].x + acc[r].y * acc[r].y; }
#pragma unroll
            for (int half = CO_R, bit = 32; half >= 1; half >>= 1, bit >>= 1) {
                const bool up = (F.lane & bit) != 0;
#pragma unroll
                for (int i = 0; i < half; ++i) { const float send = up ? vals[i] : vals[i + half], keep = up ? vals[i + half] : vals[i]; vals[i] = keep + __shfl_xor(send, bit, 64); }
            }
            static_assert(CO_R == 16 || CO_R == 32, "the butterfly below ends with 2 (CO_R = 16) or 1 (CO_R = 32) lanes per value");
            const float tot = CO_R == 16 ? vals[0] + __shfl_xor(vals[0], 1, 64) : vals[0];
            const int idx = CO_R == 16 ? ((F.lane >> 1) & 31) : F.lane;
            if (CO_R == 32 || (F.lane & 1) == 0) ((LAS float*)part)[((idx & (CO_R - 1)) * 4 + wv) * 2 + (idx >= CO_R ? 1 : 0)] = tot;
        }
        __syncthreads();
#pragma unroll
        for (int r = 0; r < CO_R; ++r) {
            const f32x2 p0 = part[r * 4 + 0], p1 = part[r * 4 + 1], p2 = part[r * 4 + 2], p3 = part[r * 4 + 3];
            const float mean = ((p0.x + p1.x) + (p2.x + p3.x)) * (1.0f / DC), ex2 = ((p0.y + p1.y) + (p2.y + p3.y)) * (1.0f / DC);
            const float var = fmaxf(ex2 - mean * mean, 0.f), rstd = frsq(var + EPS);
            float y0 = (acc[r].x - mean) * rstd * lg.x + lb.x, y1 = (acc[r].y - mean) * rstd * lg.y + lb.y;
            y0 = y0 * sigm(y0); y1 = y1 * sigm(y1);
            if (live) A2S[(size_t)(g0 + r) * (D / 2) + (c0 >> 1)] = pk2(y0, y1);
        }
        {
            unsigned cvr[CO_R + 2], bsr[CO_R];
#pragma unroll
            for (int r = 0; r < CO_R + 2; ++r) { const int gr = (t0 - 2 + r >= 0) ? g0 - 2 + r : g0; cvr[r] = CVp[(size_t)gr * (DSC / 2) + (c0 >> 1)]; }
#pragma unroll
            for (int r = 0; r < CO_R; ++r) bsr[r] = BSp[(size_t)(g0 + r) * (DSC / 2) + (c0 >> 1)];
#pragma unroll
            for (int r = 0; r < CO_R; ++r) {
                const bool ok2 = t0 + r >= 2, ok1 = t0 + r >= 1;
                const f32x2 c2 = {ok2 ? bf_lo(cvr[r]) : 0.f, ok2 ? bf_hi(cvr[r]) : 0.f}, c1 = {ok1 ? bf_lo(cvr[r + 1]) : 0.f, ok1 ? bf_hi(cvr[r + 1]) : 0.f};
                const f32x2 cc = {bf_lo(cvr[r + 2]), bf_hi(cvr[r + 2])}, b = {bf_lo(bsr[r]), bf_hi(bsr[r])};
                const f32x2 o = b * (wb0 * c2 + wb1 * c1 + wb2 * cc);
                if (live) A2S[(size_t)(g0 + r) * (D / 2) + (DC >> 1) + (c0 >> 1)] = pk2(o.x, o.y);
            }
        }
        __syncthreads();
    }    if (layer + 1 < NLAYER) cv_p(F, layer + 1, p_);
}

__device__ __forceinline__ void final_phase(Frame& F, const float* g_final) {
    const int gw = F.vcu * NWAVES + F.wave, NGW = F.G * NWAVES;
    const float* SS = (const float*)(F.ws + ((NLAYER & 1) ? WS_SS1 : WS_SS0));
    const f32x4* gf = (const f32x4*)g_final + F.lane;
    f32x4 gv[4];
#pragma unroll
    for (int j = 0; j < 4; ++j) gv[j] = gf[64 * j];
    for (int m0 = gw * 4; m0 < M; m0 += NGW * 4) {
        u32x2 xv[4][4]; f32x4 sv[4][4];
#pragma unroll
        for (int r = 0; r < 4; ++r)
#pragma unroll
            for (int j = 0; j < 4; ++j) { xv[r][j] = NTLOAD((const GAS u32x2*)(F.ws + WS_XB2 + (size_t)(m0 + r) * D * 2) + F.lane + 64 * j); sv[r][j] = ((const f32x4*)(SS + (size_t)(m0 + r) * 16))[j]; }
#pragma unroll
        for (int r = 0; r < 4; ++r) {
            const float s = (hsum4(sv[r][0]) + hsum4(sv[r][1])) + (hsum4(sv[r][2]) + hsum4(sv[r][3])); const float rs = frsq(s * (1.0f / (float)D) + EPS);
            GAS f32x4* orow = (GAS f32x4*)(F.out + (size_t)(m0 + r) * D) + F.lane;
#pragma unroll
            for (int j = 0; j < 4; ++j) __builtin_nontemporal_store(unpk4(xv[r][j]) * rs * gv[j], orow + 64 * j);
        }
    }
}

struct Args { const float* in[22]; float* out; unsigned char* ws; int ph_lo, ph_hi, li, pad; };
__global__ void __launch_bounds__(NWAVES * 64, 2) fwd_kernel(Args args) {
    extern __shared__ __attribute__((aligned(16))) unsigned char lds[];
    Frame F;
    F.lds = (LAS unsigned char*)lds;
    F.MISC = (volatile LAS unsigned*)(F.lds + MISC_OFF);
    F.tid = threadIdx.x; F.lane = F.tid & 63; F.wave = __builtin_amdgcn_readfirstlane(F.tid >> 6);
    F.G = gridDim.x; { const int bx = blockIdx.x; F.vcu = (F.G % 8 == 0) ? (bx % 8) * (F.G / 8) + bx / 8 : bx; }
    unsigned char* ws = args.ws; F.ws = ws; F.out = args.out;
    F.ctl = (gu32*)(ws + WS_CTL);
    for (int u = F.tid; u < (LDS_BYTES - LDSCTL_OFF) / 4; u += NWAVES * 64) ((LAS unsigned*)(F.lds + LDSCTL_OFF))[u] = 0u;
    __syncthreads();
    XcdBarrier bar; bar.bar = (unsigned*)(F.ctl + CW_BAR); bar.x = 0; bar.st = nullptr;
    if (!MK_PER_PHASE) bar = xcd_barrier_post((unsigned*)(F.ctl + CW_BAR), F.MISC + 8);

    const int lo = args.ph_lo, hi = args.ph_hi;
#ifndef DUP_MASK
#define DUP_MASK 0u
#endif
#ifndef ALIGNM
#define ALIGNM true
#endif
#ifndef SP2V
#define SP2V true
#endif
#ifndef ALIGN1
#define ALIGN1 false
#endif
#ifndef NOSTORE
#define NOSTORE 0
#endif
#ifndef IN_REV
#define IN_REV 1
#endif
#ifndef NO_BG
#define NO_BG 0
#endif
    const int qlo = lo + __builtin_popcount((unsigned)DUP_MASK & ((1u << lo) - 1u)), qhi = hi + __builtin_popcount((unsigned)DUP_MASK & ((1u << hi) - 1u));
    for (int q = qlo; q < qhi; ++q) {
        int p = 0; while (p + 1 + __builtin_popcount((unsigned)DUP_MASK & ((1u << (p + 1)) - 1u)) <= q) ++p;
        const bool dupfirst = (((unsigned)DUP_MASK >> p) & 1u) && q == p + __builtin_popcount((unsigned)DUP_MASK & ((1u << p) - 1u));
        const int layer = p == 0 ? 0 : (p - 1) / 7, k = p == 0 ? 0 : (p - 1) % 7 + 1;
        { int tv = threadIdx.x; asm volatile("" : "+v"(tv)); F.tid = tv; F.lane = tv & 63; F.wave = __builtin_amdgcn_readfirstlane(tv >> 6); }
        int moff = MISC_OFF; asm volatile("" : "+s"(moff));
        const volatile LAS unsigned* mw = (const volatile LAS unsigned*)(F.lds + moff);
        const int bal = __builtin_amdgcn_readfirstlane((int)mw[11]);
        const int cid = bal ? __builtin_amdgcn_readfirstlane((int)mw[10]) * 8 + (int)bar.x : (int)blockIdx.x;
        F.vcu = (F.G % 8 == 0) ? (cid % 8) * (F.G / 8) + cid / 8 : cid;
        const bf16_t* WB = layer == 0 ? (const bf16_t*)(ws + WS_WB) : (const bf16_t*)((unsigned char*)F.out + OUT_WB1);
        float* SSa = (float*)(ws + ((layer & 1) ? WS_SS1 : WS_SS0));
        float* SSb = (float*)(ws + ((layer & 1) ? WS_SS0 : WS_SS1));
#ifndef PHMASK
#define PHMASK 0x1ff
#endif
        if (p == N_PHASES - 1) { if (PHMASK & 0x100) final_phase(F, args.in[21]); }
        else if (k == 0) { if (PHMASK & 1) { const CvPtrs P{args.in[0], args.in[1], args.in[2], args.in[3], args.in[9], args.in[11], args.in[12], args.in[13], args.in[14], args.in[17], args.in[18], args.in[19], args.in[20]}; cv_phase(F, P); } }
        else if (k == 1) { if (PHMASK & 2) {
#ifndef NO_EG
            {
                Gemm g{(const bf16_t*)(ws + WS_PB), WB + WB_WPL, PLE}; EgOrder S{F.G, cid};
                EpiE E{(bf16_t*)(ws + WS_E)};
                gemm_phase<EpiE, EgOrder, false, SP2V, false>(F.lds + RING_OFF, g, S, E);
            }
#endif
#ifndef NO_IN
            {
                Gemm g{layer == 0 ? (const bf16_t*)(ws + WS_XB) : (const bf16_t*)F.out, WB + WB_WIN, D};   StaticOrder S; S.init(M / BM, NIN / BM, F.G, cid, IN_REV);
                EpiIn E{SSa, args.in[4] + (size_t)layer * 2 * D, (bf16_t*)(ws + WS_AGLU), (bf16_t*)(ws + WS_CV), (bf16_t*)(ws + WS_BS), (bf16_t*)(ws + WS_GR), (bf16_t*)(ws + WS_GB)};
                gemm_phase<EpiIn, StaticOrder, ALIGNM, SP2V, false>(F.lds + RING_OFF, g, S, E);
            }
#endif
        } }
        else if (k == 2) { if (PHMASK & 4) co_phase(F, layer, args.in[5], args.in[6], args.in[7], args.in[8], args.in[10], args.in[1]); }
        else if (k == 3) { if (PHMASK & 8) {
            Gemm g{(const bf16_t*)(ws + WS_A2S), WB + WB_WAB, D}; StaticOrder S; S.init(M / BM, D / BM, F.G, cid);
            EpiMerge E{(const bf16_t*)(ws + WS_GR), (const bf16_t*)(ws + WS_GB), (bf16_t*)(ws + WS_MG)};
            gemm_phase<EpiMerge, StaticOrder, ALIGN1, SP2V, false>(F.lds + RING_OFF, g, S, E);
        } }
        else if (k == 4) { if (PHMASK & 16) {
            Gemm g{(const bf16_t*)(ws + WS_MG), WB + WB_WO, D}; StaticOrder S; S.init(M / BM, D / BM, F.G, cid);
            EpiRes<0> E{layer == 0 ? (const bf16_t*)(ws + WS_XB) : (const bf16_t*)F.out, dupfirst ? (bf16_t*)(ws + WS_A2S) : (bf16_t*)(ws + WS_XB), dupfirst ? (float*)(ws + 76 * MiB) : SSb, nullptr, nullptr, (dupfirst && NOSTORE) ? 1 : 0};
            gemm_phase<EpiRes<0>, StaticOrder, ALIGN1, SP2V, false>(F.lds + RING_OFF, g, S, E);
        } }
        else if (k == 5) { if (PHMASK & 32) {
#ifdef UP_STAGGER
            if (F.vcu & 1) { const unsigned long long t0_ = __builtin_amdgcn_s_memrealtime(); while (__builtin_amdgcn_s_memrealtime() - t0_ < (unsigned long long)(UP_STAGGER)) __builtin_amdgcn_s_sleep(8); }
#endif
            Gemm g{(const bf16_t*)(ws + WS_XB) - 2 * D, WB + WB_WUP, D}; StaticOrder S; S.init(NT_UP, NUP / BM, F.G, cid);
            EpiUp E{SSb, args.in[15] + (size_t)layer * 3 * DFF, args.in[16] + (size_t)layer * DFF, (bf16_t*)(ws + WS_F)};
            gemm_phase<EpiUp, StaticOrder, ALIGNM, SP2V, true>(F.lds + RING_OFF, g, S, E);
        } }
        else if (k == 6) { if (PHMASK & 64) {
            Gemm g{(const bf16_t*)(ws + WS_F), WB + WB_WDN, DFF}; StaticOrder S; S.init(M / BM, D / BM, F.G, cid);
            EpiRes<0> E{(const bf16_t*)(ws + WS_XB), dupfirst ? (bf16_t*)(ws + WS_A2S) : (bf16_t*)(ws + WS_XB), dupfirst ? (float*)(ws + 76 * MiB) : SSa, nullptr, nullptr, (dupfirst && NOSTORE) ? 1 : 0};
            gemm_phase<EpiRes<0>, StaticOrder, ALIGN1, SP2V, false>(F.lds + RING_OFF, g, S, E);
        } }
        else { if (PHMASK & 128) {
            Gemm g{(const bf16_t*)(ws + WS_XB), WB + WB_WPG, D}; StaticOrder S; S.init(M / BM, D / BM, F.G, cid);
            EpiRes<1> E{(const bf16_t*)(ws + WS_XB), layer == NLAYER - 1 ? (bf16_t*)(ws + WS_XB2) : (bf16_t*)F.out, SSb, SSa, (const bf16_t*)(ws + WS_E), 0};
            gemm_phase<EpiRes<1>, StaticOrder, ALIGN1, SP2V, false>(F.lds + RING_OFF, g, S, E);
        } }
        if (q + 1 < qhi) {
#ifndef XLOCAL
#define XLOCAL 1
#endif
            const bool local = XLOCAL && bal && !DUP_MASK && (k == 3 || k == 6);
            if (!NO_BG && (p < CV_BG_SLOTS || local) && !dupfirst) {
                const CvPtrs P{args.in[0], args.in[1], args.in[2], args.in[3], args.in[9], args.in[11], args.in[12], args.in[13], args.in[14], args.in[17], args.in[18], args.in[19], args.in[20]};
                xcd_barrier_cv(bar, F, P, p, local);
            } else xcd_barrier(bar);
        }
#ifdef BAR2X
        if (q + 1 < qhi) xcd_barrier(bar);
#endif
    }
}

extern "C" void kernel_launch(void* const* d_in, const int* in_sizes, int n_in, void* d_out, int out_size, void* d_ws, size_t ws_size, hipStream_t stream) {
    static int grid = 0;
    if (grid == 0) {
        if (n_in != 22 || in_sizes[0] != M * D || out_size != M * D || ws_size < WS_END) { fprintf(stderr, "kernel_launch: built for 22 inputs, x and out of %d floats, >= %zu bytes of workspace; got n_in %d, in0 %d, out %d, ws %zu; nothing launched\n", M * D, (size_t)WS_END, n_in, n_in > 0 ? in_sizes[0] : -1, out_size, ws_size); grid = -1; return; }
        int dev = 0, cus = 0, per_cu = 0;
        if (hipGetDevice(&dev) != hipSuccess || hipDeviceGetAttribute(&cus, hipDeviceAttributeMultiprocessorCount, dev) != hipSuccess) { fprintf(stderr, "kernel_launch: hipGetDevice / hipDeviceGetAttribute failed; nothing launched\n"); grid = -1; return; }
        if (hipFuncSetAttribute((const void*)fwd_kernel, hipFuncAttributeMaxDynamicSharedMemorySize, LDS_BYTES) != hipSuccess) { fprintf(stderr, "kernel_launch: hipFuncSetAttribute failed\n"); grid = -1; return; }
        if (hipOccupancyMaxActiveBlocksPerMultiprocessor(&per_cu, (const void*)fwd_kernel, NWAVES * 64, LDS_BYTES) != hipSuccess || per_cu < 1)
            fprintf(stderr, "kernel_launch: note: the occupancy query reports %d workgroups per CU\n", per_cu);
        (void)hipGetLastError();
        grid = cus;
    }
    if (grid < 0) return;
    if (hipMemsetAsync((char*)d_ws + WS_CTL, 0, CTL_ZERO_BYTES, stream) != hipSuccess) { fprintf(stderr, "kernel_launch: hipMemsetAsync of the control words failed; nothing launched\n"); return; }
    Args a{};
    for (int i = 0; i < 22; ++i) a.in[i] = (const float*)d_in[i];
    a.out = (float*)d_out; a.ws = (unsigned char*)d_ws;
    const int nl = MK_PER_PHASE ? N_PHASES : 1;
    for (int li = 0; li < nl; ++li) {
        a.ph_lo = MK_PER_PHASE ? li : 0; a.ph_hi = MK_PER_PHASE ? li + 1 : N_PHASES; a.li = li;
        hipLaunchKernelGGL(fwd_kernel, dim3(grid), dim3(NWAVES * 64), LDS_BYTES, stream, a);
        const hipError_t le = hipPeekAtLastError();
        if (le != hipSuccess) { fprintf(stderr, "kernel_launch: launch %d failed: %s (grid %d x %d threads, %d B LDS)\n", li, hipGetErrorName(le), grid, NWAVES * 64, LDS_BYTES); break; }
    }
}
#endif
```
